# Optimizing an MI355X kernel written in HIP

```python
import jax, jax.numpy as jnp
from jax import lax
import numpy as np

D_MODEL = 4096
BATCH = 2
SEQ = 8192
DEPTH = 1

GRID_W = 64
PLE_DIM = 256
HEAD_DIM = 128
N_Q_HEADS = 16
N_KV_HEADS = 4
Q_PER_KV = N_Q_HEADS // N_KV_HEADS
ATTN_DIM = N_Q_HEADS * HEAD_DIM
KV_DIM = N_KV_HEADS * HEAD_DIM
Q_BLOCK = 128
ROPE_THETA = 10000.0
HG_HEADS = 16
HG_KEY_DIM = 128
HG_VAL_DIM = 128
HG_QK_DIM = HG_HEADS * HG_KEY_DIM
HG_V_DIM = HG_HEADS * HG_VAL_DIM
HG_CHUNK = 64
IN_SIZES = (ATTN_DIM, KV_DIM, KV_DIM, HG_QK_DIM, HG_QK_DIM, HG_QK_DIM, HG_V_DIM, HG_V_DIM)
IN_COLS = sum(IN_SIZES)
D_FF = 11008
CONV_WIDTH = 3
RMS_EPS = 1e-6
LN_EPS = 1e-5
DN_ALPHA = (2.0 * DEPTH) ** 0.25
DN_BETA = (8.0 * DEPTH) ** -0.25

kernel_name = "hybrid_gqa_hgrn2_deepnorm_encoder"


def rms_norm(x, gain):
    xf = x.astype(jnp.float32)
    y = xf * lax.rsqrt(jnp.mean(xf * xf, axis=-1, keepdims=True) + RMS_EPS)
    return y * gain.astype(jnp.float32)


def layer_norm(x, g, b):
    xf = x.astype(jnp.float32)
    mu = jnp.mean(xf, axis=-1, keepdims=True)
    var = jnp.mean(jnp.square(xf - mu), axis=-1, keepdims=True)
    y = (xf - mu) * lax.rsqrt(var + LN_EPS) * g.astype(jnp.float32) + b.astype(jnp.float32)
    return y.astype(x.dtype)


def axial_rope_tables(seq_len):
    rows = seq_len // GRID_W
    row = jnp.repeat(jnp.arange(rows), GRID_W).astype(jnp.float32)
    col = jnp.tile(jnp.arange(GRID_W), rows).astype(jnp.float32)
    sec = HEAD_DIM // 2
    inv = ROPE_THETA ** (-jnp.arange(0, sec, 2, dtype=jnp.float32) / sec)
    ang_r = row[:, None] * inv[None, :]
    ang_c = col[:, None] * inv[None, :]
    ang = jnp.concatenate([ang_r, ang_r, ang_c, ang_c], axis=-1)
    return jnp.cos(ang), jnp.sin(ang)


def apply_axial_rope(x, cos, sin):
    xs = x.reshape(x.shape[:-1] + (2, 2, HEAD_DIM // 4))
    rot = jnp.stack([-xs[..., 1, :], xs[..., 0, :]], axis=-2).reshape(x.shape)
    return x * cos[None, :, None, :] + rot * sin[None, :, None, :]


def gqa_axial_attention(q, k, v, cos, sin, q_gain, k_gain):
    B, S, _ = q.shape
    q = apply_axial_rope(rms_norm(q.reshape(B, S, N_Q_HEADS, HEAD_DIM), q_gain), cos, sin).astype(v.dtype)
    k = apply_axial_rope(rms_norm(k.reshape(B, S, N_KV_HEADS, HEAD_DIM), k_gain), cos, sin).astype(v.dtype)
    v = v.reshape(B, S, N_KV_HEADS, HEAD_DIM)
    n_blk = S // Q_BLOCK
    qb = q.reshape(B, n_blk, Q_BLOCK, N_KV_HEADS, Q_PER_KV, HEAD_DIM).transpose(1, 0, 3, 4, 2, 5)
    scale = HEAD_DIM ** -0.5

    def block(q_blk):
        s = jnp.einsum('bhgqd,bkhd->bhgqk', q_blk, k, preferred_element_type=jnp.float32) * scale
        pr = jax.nn.softmax(s, axis=-1).astype(v.dtype)
        return jnp.einsum('bhgqk,bkhd->bqhgd', pr, v)

    o = lax.map(block, qb)
    return o.transpose(1, 0, 2, 3, 4, 5).reshape(B, S, ATTN_DIM)


def hgrn2_chunk_scan(q, k, v, logf):
    B, S, H, dk = q.shape
    dv = v.shape[-1]
    C = HG_CHUNK
    N = S // C
    q, k, v, g = (t.reshape(B, N, C, H, t.shape[-1]) for t in (q, k, v, logf))
    b = jnp.cumsum(g, axis=2)
    b_ref = b[:, :, C // 2 - 1:C // 2]
    q_in = q * jnp.exp(b - b_ref)
    k_in = k * jnp.exp(b_ref - b)
    A = jnp.einsum('bnthd,bnshd->bnhts', q_in, k_in)
    A = jnp.where(jnp.tril(jnp.ones((C, C), dtype=bool)), A, 0.0)
    o_intra = jnp.einsum('bnhts,bnshe->bnthe', A, v)
    b_last = b[:, :, -1:]
    U = jnp.einsum('bnshd,bnshe->bnhde', k * jnp.exp(b_last - b), v)
    decay = jnp.exp(b[:, :, -1])

    def step(state, inp):
        dec, u = inp
        return dec[..., None] * state + u, state

    _, s_before = lax.scan(step, jnp.zeros((B, H, dk, dv), jnp.float32),
                           (decay.transpose(1, 0, 2, 3), U.transpose(1, 0, 2, 3, 4)))
    s_before = s_before.transpose(1, 0, 2, 3, 4)
    o_inter = jnp.einsum('bnthd,bnhde->bnthe', q * jnp.exp(b), s_before)
    return (o_intra + o_inter).reshape(B, S, H, dv)


def hgrn2_bidirectional(q_raw, zf_raw, zb_raw, i_raw, g_raw, lb_fwd, lb_bwd, norm_gain):
    B, S, _ = q_raw.shape
    heads = lambda t, d: t.astype(jnp.float32).reshape(B, S, HG_HEADS, d)
    q = jax.nn.silu(heads(q_raw, HG_KEY_DIM))
    v = heads(i_raw, HG_VAL_DIM)

    def gates(z_raw, lb):
        z = heads(z_raw, HG_KEY_DIM)
        lb = lb.reshape(HG_HEADS, HG_KEY_DIM)
        logf = jnp.logaddexp(jnp.log(lb), jnp.log1p(-lb) + jax.nn.log_sigmoid(z))
        return (1.0 - lb) * jax.nn.sigmoid(-z), logf

    k_f, g_f = gates(zf_raw, lb_fwd)
    k_b, g_b = gates(zb_raw, lb_bwd)
    flip = lambda t: jnp.flip(t, axis=1)
    o = hgrn2_chunk_scan(q, k_f, v, g_f) + flip(hgrn2_chunk_scan(flip(q), flip(k_b), flip(v), flip(g_b)))
    o = rms_norm(o, norm_gain.reshape(HG_HEADS, HG_VAL_DIM)).reshape(B, S, HG_V_DIM)
    return (o * jax.nn.silu(g_raw.astype(jnp.float32))).astype(q_raw.dtype)


def setup_inputs(seed: int = 0) -> dict:
    key = jax.random.key(seed)
    ks = jax.random.split(key, 24)
    nrm = lambda k, shape, scale: jax.random.normal(k, shape, jnp.float32) * scale
    gain = lambda k, shape: 1.0 + 0.01 * jax.random.normal(k, shape, jnp.float32)
    L, D = DEPTH, D_MODEL
    return {
        "x": nrm(ks[0], (BATCH, SEQ, D), 1.0),
        "p": nrm(ks[1], (L, BATCH, SEQ, PLE_DIM), 1.0),
        "w_in": nrm(ks[2], (L, D, IN_COLS), D ** -0.5),
        "q_norm": gain(ks[3], (L, HEAD_DIM)),
        "k_norm": gain(ks[4], (L, HEAD_DIM)),
        "lb_logits": nrm(ks[5], (2, L + 1, HG_QK_DIM), 0.5),
        "hg_norm": gain(ks[6], (L, HG_V_DIM)),
        "w_pa": nrm(ks[7], (L, ATTN_DIM, D), ATTN_DIM ** -0.5 * DN_BETA),
        "w_pb": nrm(ks[8], (L, HG_V_DIM, D), HG_V_DIM ** -0.5 * DN_BETA),
        "w_gate": nrm(ks[9], (L, D, 2 * D), D ** -0.5),
        "b_gate": nrm(ks[10], (L, 2 * D), 0.01),
        "w_o": nrm(ks[11], (L, D, D), D ** -0.5 * DN_BETA),
        "ln1_g": gain(ks[12], (L, D)),
        "ln1_b": nrm(ks[13], (L, D), 0.01),
        "w_up": nrm(ks[14], (L, D, 2 * D_FF), D ** -0.5),
        "conv_w": nrm(ks[15], (L, CONV_WIDTH, D_FF), CONV_WIDTH ** -0.5),
        "conv_b": nrm(ks[16], (L, D_FF), 0.01),
        "w_down": nrm(ks[17], (L, D_FF, D), D_FF ** -0.5 * DN_BETA),
        "ln2_g": gain(ks[18], (L, D)),
        "ln2_b": nrm(ks[19], (L, D), 0.01),
        "w_pg": nrm(ks[20], (L, D, D), D ** -0.5),
        "w_ple": nrm(ks[21], (L, PLE_DIM, D), PLE_DIM ** -0.5),
    }


def reference(x, p, w_in, q_norm, k_norm, lb_logits, hg_norm, w_pa, w_pb, w_gate, b_gate, w_o,
              ln1_g, ln1_b, w_up, conv_w, conv_b, w_down, ln2_g, ln2_b, w_pg, w_ple):
    B, S, _ = x.shape
    cos, sin = axial_rope_tables(S)
    lb_all = jnp.cumsum(jax.nn.softmax(lb_logits.astype(jnp.float32), axis=1), axis=1)
    split_at = np.cumsum(IN_SIZES)[:-1].tolist()
    for i in range(DEPTH):
        proj = x @ w_in[i]
        qa, ka, va, qh, zf, zb, ih, gh = jnp.split(proj, split_at, axis=-1)
        y_attn = gqa_axial_attention(qa, ka, va, cos, sin, q_norm[i], k_norm[i])
        y_hgrn = hgrn2_bidirectional(qh, zf, zb, ih, gh, lb_all[0, i], lb_all[1, i], hg_norm[i])
        g_attn, g_hgrn = jnp.split(jax.nn.sigmoid(x @ w_gate[i] + b_gate[i]), 2, axis=-1)
        mixed = (g_attn * (y_attn @ w_pa[i]) + g_hgrn * (y_hgrn @ w_pb[i])) @ w_o[i]
        x = layer_norm(DN_ALPHA * x + mixed, ln1_g[i], ln1_b[i])
        u, gpre = jnp.split(x @ w_up[i], 2, axis=-1)
        gp = jnp.pad(gpre, ((0, 0), (1, 1), (0, 0)))
        gconv = (gp[:, :-2] * conv_w[i, 0] + gp[:, 1:-1] * conv_w[i, 1]
                 + gp[:, 2:] * conv_w[i, 2] + conv_b[i])
        ffn = (jax.nn.silu(gconv) * u) @ w_down[i]
        x = layer_norm(DN_ALPHA * x + ffn, ln2_g[i], ln2_b[i])
        x = x + jax.nn.sigmoid(x @ w_pg[i]) * (p[i] @ w_ple[i])
    return x
```

```cpp
#include <hip/hip_runtime.h>
#include <cstdio>
#include <cstdint>
namespace pg8 {
#define PG8_LAS __attribute__((address_space(3)))
typedef unsigned short bf16_t;
typedef short bf16x8 __attribute__((ext_vector_type(8)));
typedef float f32x4 __attribute__((ext_vector_type(4)));
typedef unsigned u32x4 __attribute__((ext_vector_type(4)));
constexpr int BM = 256, BK = 64, HALF = 128, HTB = HALF * BK * 2  , STAGE_BYTES = 8 * HTB, NXCD = 8, WGM = 8;

__host__ __device__ __forceinline__ int lds_byte(int r, int c) { const int st = (r >> 4) * 2 + (c >> 5), rr = r & 15, cc = c & 31, ob = rr * 64 + cc * 2; return st * 1024 + (ob ^ (((ob >> 9) & 1) << 5)); }
__host__ __device__ __forceinline__ void stage_rc(int b, int& R, int& C) { const int st = b / 1024, sb = b % 1024, swz = sb ^ (((sb >> 9) & 1) << 5); R = (st >> 1) * 16 + swz / 64; C = (st & 1) * 32 + (swz % 64) / 2; }
__host__ __device__ __forceinline__ int perm32(int rho) { const int n = rho >> 4, i = rho & 15; return 8 * (i >> 2) + 4 * n + (i & 3); }

struct Unit { int pm, pn; };
struct Gemm { const bf16_t* A; const bf16_t* Bt; int M, N, K; };

struct StaticOrder {
    int nM, nN, nwg, G, c;
    __host__ __device__ void init(int M, int N, int G_, int c_) { nM = M / BM; nN = N / BM; nwg = nM * nN; G = G_; c = c_; }
    __host__ __device__ bool next(int i, Unit& u) const {
        const long L = (long)i * G + c; if (L >= nwg) return false;
        int wgid = (int)L; { const int q = nwg / NXCD, r = nwg % NXCD, xcd = wgid % NXCD, off = wgid / NXCD; wgid = (xcd < r ? xcd * (q + 1) : r * (q + 1) + (xcd - r) * q) + off; }
        const int nig = WGM * nN, gid = wgid / nig, fm = gid * WGM, gsz = (nM - fm) < WGM ? (nM - fm) : WGM;
        u.pm = fm + ((wgid % nig) % gsz); u.pn = (wgid % nig) / gsz; return true;
    }
    __device__ __forceinline__ void a_ready(const Unit&) const {}
    __device__ __forceinline__ void done(const Unit&) const {}
};
__device__ __forceinline__ unsigned cvt_pk_bf16(float lo, float hi) { unsigned r; asm volatile("v_cvt_pk_bf16_f32 %0, %1, %2" : "=v"(r) : "v"(lo), "v"(hi)); return r; }
typedef unsigned u32x2 __attribute__((ext_vector_type(2)));
__device__ __forceinline__ float bf_lo(unsigned w) { return __uint_as_float(w << 16); }
__device__ __forceinline__ float bf_hi(unsigned w) { return __uint_as_float(w & 0xffff0000u); }
__device__ __forceinline__ float sigmoid_f(float v) { return __builtin_amdgcn_rcpf(1.0f + __expf(-v)); }

struct EpiBf16 {
    static constexpr bool PERM = true, AFTER_DRAIN = false;
    bf16_t* O; int ldc; int split_cols; size_t split_stride;
    __device__ __forceinline__ void operator()(const f32x4 (&acc)[2][2][4][2], const Unit& u, int wr, int wc, int fr, int fq) const {
        const int row0 = u.pm * BM + wr * 64 + fr; int colt = u.pn * BM; bf16_t* base = O;
        if (split_cols) { const int t = colt / split_cols; base += (size_t)t * split_stride; colt -= t * split_cols; }
        const int col0 = colt + wc * 32 + 8 * fq;
#pragma unroll
        for (int ai = 0; ai < 2; ++ai)
#pragma unroll
            for (int m = 0; m < 4; ++m) { bf16_t* rowp = base + (size_t)(row0 + ai * HALF + m * 16) * ldc + col0;
#pragma unroll
                for (int bj = 0; bj < 2; ++bj) { const f32x4 v0 = acc[ai][bj][m][0], v1 = acc[ai][bj][m][1];
                    u32x4 w; w.x = cvt_pk_bf16(v0[0], v0[1]); w.y = cvt_pk_bf16(v0[2], v0[3]); w.z = cvt_pk_bf16(v1[0], v1[1]); w.w = cvt_pk_bf16(v1[2], v1[3]);
                    *(u32x4*)(rowp + bj * HALF) = w; } }
    }
};
struct EpiProj {
    static constexpr bool PERM = true, AFTER_DRAIN = false;
    bf16_t *QA, *KA, *VA, *QH, *ZF, *ZB, *IH, *GH, *GATE; const float* bgate;
    __device__ __forceinline__ void operator()(const f32x4 (&acc)[2][2][4][2], const Unit& u, int wr, int wc, int fr, int fq) const {
        const int row0 = u.pm * BM + wr * 64 + fr; int colt = u.pn * BM; bf16_t* base; int ldc = 2048; int act = 0; const float* bias = nullptr;
        if (colt < 2048) { base = QA; }
        else if (colt < 2560) { base = KA; ldc = 512; colt -= 2048; }
        else if (colt < 3072) { base = VA; ldc = 512; colt -= 2560; }
        else if (colt < 5120) { base = QH; colt -= 3072; act = 1; }
        else if (colt < 7168) { base = ZF; colt -= 5120; }
        else if (colt < 9216) { base = ZB; colt -= 7168; }
        else if (colt < 11264) { base = IH; colt -= 9216; }
        else if (colt < 13312) { base = GH; colt -= 11264; act = 1; }
        else { base = GATE; ldc = 8192; colt -= 13312; act = 2; bias = bgate; }
        const int col0 = colt + wc * 32 + 8 * fq;
        f32x4 bv[2][2];
#pragma unroll
        for (int bj = 0; bj < 2; ++bj)
#pragma unroll
            for (int n = 0; n < 2; ++n) bv[bj][n] = bias ? *(const f32x4*)(bias + col0 + bj * HALF + 4 * n) : (f32x4){0.f, 0.f, 0.f, 0.f};
#pragma unroll
        for (int ai = 0; ai < 2; ++ai)
#pragma unroll
            for (int m = 0; m < 4; ++m) { bf16_t* rowp = base + (size_t)(row0 + ai * HALF + m * 16) * ldc + col0;
#pragma unroll
                for (int bj = 0; bj < 2; ++bj) { f32x4 v0 = acc[ai][bj][m][0] + bv[bj][0], v1 = acc[ai][bj][m][1] + bv[bj][1];
                    if (act != 0) {
#pragma unroll
                        for (int j = 0; j < 4; ++j) { const float s0 = sigmoid_f(v0[j]), s1 = sigmoid_f(v1[j]); v0[j] = (act == 1) ? v0[j] * s0 : s0; v1[j] = (act == 1) ? v1[j] * s1 : s1; } }
                    u32x4 w; w.x = cvt_pk_bf16(v0[0], v0[1]); w.y = cvt_pk_bf16(v0[2], v0[3]); w.z = cvt_pk_bf16(v1[0], v1[1]); w.w = cvt_pk_bf16(v1[2], v1[3]);
                    *(u32x4*)(rowp + bj * HALF) = w; } }
    }
};
struct EpiGateMulF32 {
    static constexpr bool PERM = false, AFTER_DRAIN = false;
    float* out; int ldc; const bf16_t* gate; int ldg; int goff;
    __device__ __forceinline__ void operator()(const f32x4 (&acc)[2][2][4][2], const Unit& u, int wr, int wc, int fr, int fq) const {
        const int row0 = u.pm * BM + wr * 64 + fr, col0 = u.pn * BM + wc * 32 + 4 * fq;
#pragma unroll
        for (int ai = 0; ai < 2; ++ai)
#pragma unroll
            for (int m = 0; m < 4; ++m) { const int row = row0 + ai * HALF + m * 16; float* rowp = out + (size_t)row * ldc + col0;
#pragma unroll
                for (int bj = 0; bj < 2; ++bj)
#pragma unroll
                    for (int n = 0; n < 2; ++n) { f32x4 v = acc[ai][bj][m][n];
                        if (gate) { const u32x2 gw = *(const u32x2*)(gate + (size_t)row * ldg + goff + col0 + bj * HALF + n * 16);
                            v = v * (f32x4){bf_lo(gw.x), bf_hi(gw.x), bf_lo(gw.y), bf_hi(gw.y)}; }
                        *(f32x4*)(rowp + bj * HALF + n * 16) = v; } }
    }
};
struct EpiGateAddBf16 {
    static constexpr bool PERM = true, AFTER_DRAIN = false;
    bf16_t* O; const float* T; int ldc; const bf16_t* gate; int ldg; int goff;
    __device__ __forceinline__ void operator()(const f32x4 (&acc)[2][2][4][2], const Unit& u, int wr, int wc, int fr, int fq) const {
        const int row0 = u.pm * BM + wr * 64 + fr, col0 = u.pn * BM + wc * 32 + 8 * fq;
#pragma unroll
        for (int ai = 0; ai < 2; ++ai)
#pragma unroll
            for (int m = 0; m < 4; ++m) { const int row = row0 + ai * HALF + m * 16;
#pragma unroll
                for (int bj = 0; bj < 2; ++bj) { const size_t off = (size_t)row * ldc + col0 + bj * HALF;
                    const u32x4 gw = *(const u32x4*)(gate + (size_t)row * ldg + goff + col0 + bj * HALF);
                    const f32x4 t0 = *(const f32x4*)(T + off), t1 = *(const f32x4*)(T + off + 4);
                    const f32x4 v0 = t0 + acc[ai][bj][m][0] * (f32x4){bf_lo(gw.x), bf_hi(gw.x), bf_lo(gw.y), bf_hi(gw.y)};
                    const f32x4 v1 = t1 + acc[ai][bj][m][1] * (f32x4){bf_lo(gw.z), bf_hi(gw.z), bf_lo(gw.w), bf_hi(gw.w)};
                    u32x4 w; w.x = cvt_pk_bf16(v0[0], v0[1]); w.y = cvt_pk_bf16(v0[2], v0[3]); w.z = cvt_pk_bf16(v1[0], v1[1]); w.w = cvt_pk_bf16(v1[2], v1[3]);
                    *(u32x4*)(O + off) = w; } }
    }
};
struct EpiAxpyF32 {
    static constexpr bool PERM = false, AFTER_DRAIN = false;
    const float* base; float* out; int ldc; float alpha;
    __device__ __forceinline__ void operator()(const f32x4 (&acc)[2][2][4][2], const Unit& u, int wr, int wc, int fr, int fq) const {
        const int row0 = u.pm * BM + wr * 64 + fr, col0 = u.pn * BM + wc * 32 + 4 * fq;
#pragma unroll
        for (int ai = 0; ai < 2; ++ai)
#pragma unroll
            for (int m = 0; m < 4; ++m) { const size_t off = (size_t)(row0 + ai * HALF + m * 16) * ldc + col0;
#pragma unroll
                for (int bj = 0; bj < 2; ++bj)
#pragma unroll
                    for (int n = 0; n < 2; ++n) { const f32x4 bs = *(const f32x4*)(base + off + bj * HALF + n * 16);
                        *(f32x4*)(out + off + bj * HALF + n * 16) = bs * alpha + acc[ai][bj][m][n]; }
                asm volatile("" ::: "memory"); }
    }
};
struct EpiFinal {
    static constexpr bool PERM = false, AFTER_DRAIN = false;
    float* out; const float* pe; int ldc;
    __device__ __forceinline__ void operator()(const f32x4 (&acc)[2][2][4][2], const Unit& u, int wr, int wc, int fr, int fq) const {
        const int row0 = u.pm * BM + wr * 64 + fr, col0 = u.pn * BM + wc * 32 + 4 * fq;
#pragma unroll
        for (int ai = 0; ai < 2; ++ai)
#pragma unroll
            for (int m = 0; m < 4; ++m) { const size_t off = (size_t)(row0 + ai * HALF + m * 16) * ldc + col0;
#pragma unroll
                for (int bj = 0; bj < 2; ++bj)
#pragma unroll
                    for (int n = 0; n < 2; ++n) { const f32x4 xs = *(const f32x4*)(out + off + bj * HALF + n * 16), pv = *(const f32x4*)(pe + off + bj * HALF + n * 16);
                        const f32x4 a = acc[ai][bj][m][n]; f32x4 o;
#pragma unroll
                        for (int j = 0; j < 4; ++j) o[j] = xs[j] + sigmoid_f(a[j]) * pv[j];
                        *(f32x4*)(out + off + bj * HALF + n * 16) = o; }
                asm volatile("" ::: "memory"); }
    }
};
template <class Epi, class Sched, bool ALIGN_EPI = false, bool SP2 = false>
__device__ __forceinline__ void gemm_phase(PG8_LAS unsigned char* lds, const Gemm g, const Sched& S, const Epi& E) {
    const int tid = threadIdx.x, wid = __builtin_amdgcn_readfirstlane(tid >> 6), lane = tid & 63, wr = wid >> 2, wc = wid & 3, fr = lane & 15, fq = lane >> 4;
    const int K = g.K, nt = K / BK;
    unsigned voffA[2], voffB[2];
#pragma unroll
    for (int i = 0; i < 2; ++i) { int R, C; stage_rc(tid * 16 + i * 8192, R, C); const int Rb = Epi::PERM ? ((R & ~31) + perm32(R & 31)) : R;
        voffA[i] = (unsigned)(R * K + C) * 2u; voffB[i] = (unsigned)(Rb * K + C) * 2u; }
    const size_t kstep = (size_t)(BK * 2);
    const size_t hstep = (size_t)HALF * K * 2;
    const size_t tstep = 2 * hstep;
    const unsigned ldsw = (unsigned)wid * 1024u;
    const int aoff = lds_byte(wr * 64 + fr, fq * 8), boff = lds_byte(wc * 32 + fr, fq * 8);
#define PG8_SA(b, h) (((b) * 2 + (h)) * HTB)
#define PG8_SB(b, h) ((4 + (b) * 2 + (h)) * HTB)
#define PG8_STAGE(bufoff, gbase, voff) do { _Pragma("unroll") for (int _i = 0; _i < 2; ++_i) \
        __builtin_amdgcn_global_load_lds((const unsigned*)((const char*)(gbase) + (voff)[_i]), (PG8_LAS unsigned*)(lds + (bufoff) + ldsw + _i * 8192), 16, 0, 0); } while (0)
#define PG8_LDA(dst, b, h) do { _Pragma("unroll") for (int m = 0; m < 4; ++m) _Pragma("unroll") for (int k = 0; k < 2; ++k) dst[m][k] = *(const PG8_LAS bf16x8*)(lds + PG8_SA(b, h) + aoff + m * 2048 + k * 1024); } while (0)
#define PG8_LDB(dst, b, h) do { _Pragma("unroll") for (int n = 0; n < 2; ++n) _Pragma("unroll") for (int k = 0; k < 2; ++k) dst[n][k] = *(const PG8_LAS bf16x8*)(lds + PG8_SB(b, h) + boff + n * 2048 + k * 1024); } while (0)
#define PG8_MMA(ai, bj, At, Bt) do { __builtin_amdgcn_s_setprio(1); _Pragma("unroll") for (int m = 0; m < 4; ++m) _Pragma("unroll") for (int n = 0; n < 2; ++n) _Pragma("unroll") for (int k = 0; k < 2; ++k) \
        acc[ai][bj][m][n] = __builtin_amdgcn_mfma_f32_16x16x32_bf16(Bt[n][k], At[m][k], acc[ai][bj][m][n], 0, 0, 0); __builtin_amdgcn_s_setprio(0); } while (0)
#define PG8_WAIT_V(n) asm volatile("s_waitcnt vmcnt(" #n ")" ::: "memory")
#define PG8_WAIT_L(n) asm volatile("s_waitcnt lgkmcnt(" #n ")" ::: "memory")
#define PG8_BAR __builtin_amdgcn_s_barrier()
#define PG8_SCHED __builtin_amdgcn_sched_barrier(0)
    Unit cur, nxt; int ui = 0;
    if (!S.next(0, cur)) return;
    f32x4 acc[2][2][4][2];
#pragma unroll
    for (int a = 0; a < 2; ++a)
#pragma unroll
        for (int b = 0; b < 2; ++b)
#pragma unroll
            for (int m = 0; m < 4; ++m)
#pragma unroll
                for (int n = 0; n < 2; ++n) acc[a][b][m][n] = (f32x4){0.f, 0.f, 0.f, 0.f};
    bf16x8 At[4][2], B0[2][2], B1[2][2];
    const char* cA = (const char*)g.A + (size_t)cur.pm * tstep; const char* cB = (const char*)g.Bt + (size_t)cur.pn * tstep;
    S.a_ready(cur);
    if constexpr (SP2) {
        PG8_STAGE(PG8_SB(0, 0), cB, voffB); PG8_STAGE(PG8_SB(0, 1), cB + hstep, voffB); PG8_STAGE(PG8_SA(0, 0), cA, voffA); PG8_STAGE(PG8_SA(0, 1), cA + hstep, voffA);
        if (wr == 1) PG8_BAR;
        PG8_WAIT_V(2); PG8_BAR;
        PG8_STAGE(PG8_SB(1, 0), cB + kstep, voffB); PG8_STAGE(PG8_SA(1, 0), cA + kstep, voffA); PG8_STAGE(PG8_SB(1, 1), cB + hstep + kstep, voffB);
        PG8_WAIT_V(6); PG8_BAR;
    } else {
        PG8_STAGE(PG8_SB(0, 0), cB, voffB); PG8_STAGE(PG8_SA(0, 0), cA, voffA); PG8_STAGE(PG8_SB(0, 1), cB + hstep, voffB); PG8_STAGE(PG8_SA(0, 1), cA + hstep, voffA);
        if (wr == 1) PG8_BAR;
        PG8_WAIT_V(4); PG8_BAR;
        PG8_STAGE(PG8_SB(1, 0), cB + kstep, voffB); PG8_STAGE(PG8_SA(1, 0), cA + kstep, voffA); PG8_STAGE(PG8_SB(1, 1), cB + hstep + kstep, voffB);
        PG8_WAIT_V(6); PG8_BAR;
    }
    for (;;) {
        const bool has_next = S.next(ui + 1, nxt);
        const char* nA = has_next ? (const char*)g.A + (size_t)nxt.pm * tstep : cA; const char* nB = has_next ? (const char*)g.Bt + (size_t)nxt.pn * tstep : cB;
        for (int t = 0; t < nt; t += 2) {
            const bool last = (t == nt - 2);
            const char* a1 = cA + (size_t)(t + 1) * kstep;
            const char* a2 = last ? nA : cA + (size_t)(t + 2) * kstep; const char* b2 = last ? nB : cB + (size_t)(t + 2) * kstep;
            const char* a3 = a2 + kstep; const char* b3 = b2 + kstep;
            if (last && has_next) S.a_ready(nxt);
            if constexpr (SP2) {
            PG8_LDB(B0, 0, 0); PG8_LDB(B1, 0, 1); PG8_SCHED; PG8_LDA(At, 0, 0); PG8_STAGE(PG8_SA(1, 1), a1 + hstep, voffA);
            PG8_WAIT_V(8); PG8_WAIT_L(0); PG8_BAR; PG8_MMA(0, 0, At, B0); PG8_MMA(0, 1, At, B1); PG8_BAR; PG8_SCHED;
            PG8_LDA(At, 0, 1); PG8_STAGE(PG8_SB(0, 0), b2, voffB); PG8_STAGE(PG8_SB(0, 1), b2 + hstep, voffB); PG8_STAGE(PG8_SA(0, 0), a2, voffA);
            PG8_WAIT_V(8); PG8_WAIT_L(0); PG8_BAR; PG8_MMA(1, 0, At, B0); PG8_MMA(1, 1, At, B1); PG8_BAR; PG8_SCHED;
            PG8_LDB(B0, 1, 0); PG8_LDB(B1, 1, 1); PG8_SCHED; PG8_LDA(At, 1, 0); PG8_STAGE(PG8_SA(0, 1), a2 + hstep, voffA);
            PG8_WAIT_V(8); PG8_WAIT_L(0); PG8_BAR; PG8_MMA(0, 0, At, B0); PG8_MMA(0, 1, At, B1); PG8_BAR; PG8_SCHED;
            PG8_LDA(At, 1, 1); PG8_STAGE(PG8_SB(1, 0), b3, voffB); PG8_STAGE(PG8_SB(1, 1), b3 + hstep, voffB); PG8_STAGE(PG8_SA(1, 0), a3, voffA);
            PG8_WAIT_V(8); PG8_WAIT_L(0); PG8_BAR; PG8_MMA(1, 0, At, B0); PG8_MMA(1, 1, At, B1); PG8_BAR; PG8_SCHED;
            } else {
            PG8_LDB(B0, 0, 0); PG8_SCHED; PG8_LDA(At, 0, 0); PG8_STAGE(PG8_SA(1, 1), a1 + hstep, voffA);
            PG8_WAIT_L(8); PG8_BAR; PG8_WAIT_L(0); PG8_MMA(0, 0, At, B0); PG8_BAR; PG8_SCHED;
            PG8_LDB(B1, 0, 1); PG8_STAGE(PG8_SB(0, 0), b2, voffB);
            PG8_BAR; PG8_WAIT_L(0); PG8_MMA(0, 1, At, B1); PG8_BAR;
            PG8_LDA(At, 0, 1); PG8_STAGE(PG8_SA(0, 0), a2, voffA);
            PG8_BAR; PG8_WAIT_L(0); PG8_MMA(1, 0, At, B0); PG8_BAR; PG8_SCHED;
            PG8_STAGE(PG8_SB(0, 1), b2 + hstep, voffB);
            PG8_WAIT_V(6); PG8_BAR; PG8_MMA(1, 1, At, B1); PG8_BAR;
            PG8_LDB(B0, 1, 0); PG8_SCHED; PG8_LDA(At, 1, 0); PG8_STAGE(PG8_SA(0, 1), a2 + hstep, voffA);
            PG8_WAIT_L(8); PG8_BAR; PG8_WAIT_L(0); PG8_MMA(0, 0, At, B0); PG8_BAR; PG8_SCHED;
            PG8_LDB(B1, 1, 1); PG8_STAGE(PG8_SB(1, 0), b3, voffB);
            PG8_BAR; PG8_WAIT_L(0); PG8_MMA(0, 1, At, B1); PG8_BAR;
            PG8_LDA(At, 1, 1); PG8_STAGE(PG8_SA(1, 0), a3, voffA);
            PG8_BAR; PG8_WAIT_L(0); PG8_MMA(1, 0, At, B0); PG8_BAR; PG8_SCHED;
            PG8_STAGE(PG8_SB(1, 1), b3 + hstep, voffB);
            PG8_WAIT_V(6); PG8_BAR; PG8_MMA(1, 1, At, B1); PG8_BAR;
            }
        }
        if constexpr (ALIGN_EPI) { if (wr == 0) PG8_BAR; }
        if constexpr (!Epi::AFTER_DRAIN) { E(acc, cur, wr, wc, fr, fq); S.done(cur); }
        if (!has_next) break;
#pragma unroll
        for (int a = 0; a < 2; ++a)
#pragma unroll
            for (int b = 0; b < 2; ++b)
#pragma unroll
                for (int m = 0; m < 4; ++m)
#pragma unroll
                    for (int n = 0; n < 2; ++n) acc[a][b][m][n] = (f32x4){0.f, 0.f, 0.f, 0.f};
        cur = nxt; cA = nA; cB = nB; ++ui;
        if constexpr (ALIGN_EPI) { if (wr == 1) PG8_BAR; }
    }
    PG8_WAIT_V(0);
    if constexpr (!ALIGN_EPI) { if (wr == 0) PG8_BAR; }
    PG8_BAR;
    if constexpr (Epi::AFTER_DRAIN) { E.fused(acc, cur, wr, wc, fr, fq, lds, wid, lane); S.done(cur); }
#undef PG8_SA
#undef PG8_SB
#undef PG8_STAGE
#undef PG8_LDA
#undef PG8_LDB
#undef PG8_MMA
#undef PG8_WAIT_V
#undef PG8_WAIT_L
#undef PG8_BAR
#undef PG8_SCHED
}
}
namespace attn {
typedef unsigned short bf16;
using bf16x8 = __attribute__((ext_vector_type(8))) short;
using s16x4  = __attribute__((ext_vector_type(4))) short;
using f32x16 = __attribute__((ext_vector_type(16))) float;
using u32x4  = __attribute__((ext_vector_type(4))) unsigned;
constexpr int   D = 128, NW = 8, QBLK = 32, KVBLK = 64;
constexpr float SCALE = 0.088388347648318440f;
constexpr float THR = 8.f;
constexpr int LDQ = 2048, LDK = 512, LDO = 2048;
constexpr size_t SHM_V = KVBLK * D * 2, SHM_K = KVBLK * D * 2, SHM_ATTN = 2 * SHM_V + 2 * SHM_K + NW * 64 * 4;
#define KSWZ(row, colB) ((row) * 256 + ((colB) ^ (((row) & 7) << 4)))
#define SBAR() __builtin_amdgcn_sched_barrier(0)
__device__ __forceinline__ int crow(int r, int hi) { return (r & 3) + 8 * (r >> 2) + 4 * hi; }
__device__ __forceinline__ unsigned cvtpk(float lo, float hi) { unsigned r; asm volatile("v_cvt_pk_bf16_f32 %0, %1, %2" : "=v"(r) : "v"(lo), "v"(hi)); return r; }
__device__ __forceinline__ void partialSM(f32x16& p0, f32x16& p1, float& m_reg, float& mn, float& alpha) {
  constexpr float C = SCALE * 1.4426950408889634f;
  float pmax = p0[0]; for (int r = 1; r < 16; ++r) pmax = fmaxf(pmax, p0[r]); for (int r = 0; r < 16; ++r) pmax = fmaxf(pmax, p1[r]);
  { auto rr = __builtin_amdgcn_permlane32_swap(__float_as_uint(pmax), __float_as_uint(pmax), false, false);
    pmax = fmaxf(__uint_as_float(rr[0]), __uint_as_float(rr[1])); }
  if (__builtin_expect(__all(pmax - m_reg <= THR / SCALE), 1)) { mn = m_reg; alpha = 1.f; }
  else { mn = fmaxf(m_reg, pmax); alpha = __builtin_amdgcn_exp2f((m_reg - mn) * C); m_reg = mn; }
  float mnC = -mn * C;
  for (int r = 0; r < 16; ++r) p0[r] = fmaf(p0[r], C, mnC); for (int r = 0; r < 16; ++r) p1[r] = fmaf(p1[r], C, mnC);
  for (int r = 0; r < 16; ++r) p0[r] = __builtin_amdgcn_exp2f(p0[r]);
}
__device__ __forceinline__ void finishSM(f32x16& p0, f32x16& p1, float alpha, float& l_reg, bf16x8& pa0, bf16x8& pa1, bf16x8& pa2, bf16x8& pa3) {
  for (int r = 0; r < 16; ++r) p1[r] = __builtin_amdgcn_exp2f(p1[r]);
  float ps = 0; for (int r = 0; r < 16; ++r) ps += p0[r]; for (int r = 0; r < 16; ++r) ps += p1[r];
  { auto rr = __builtin_amdgcn_permlane32_swap(__float_as_uint(ps), __float_as_uint(ps), false, false);
    ps = __uint_as_float(rr[0]) + __uint_as_float(rr[1]); }
  l_reg = l_reg * alpha + ps;
#define PK4(P, BASE, OUT) do { unsigned a0 = cvtpk(P[BASE + 0], P[BASE + 1]), a1 = cvtpk(P[BASE + 2], P[BASE + 3]);   \
    unsigned b0 = cvtpk(P[BASE + 4], P[BASE + 5]), b1 = cvtpk(P[BASE + 6], P[BASE + 7]);                              \
    auto r0 = __builtin_amdgcn_permlane32_swap(a0, b0, false, false); auto r1 = __builtin_amdgcn_permlane32_swap(a1, b1, false, false); \
    u32x4 w = {r0[0], r1[0], r0[1], r1[1]}; OUT = *reinterpret_cast<bf16x8*>(&w); } while (0)
  PK4(p0, 0, pa0); PK4(p0, 8, pa1); PK4(p1, 0, pa2); PK4(p1, 8, pa3);
#undef PK4
}
__device__ __forceinline__ void qkt(f32x16& p0, f32x16& p1, const bf16* Ks, const bf16x8* qr, int r32, int hi) {
  p0 = f32x16{}; p1 = f32x16{};
  for (int d0 = 0; d0 < 8; ++d0) { int cb = (d0 * 16 + hi * 8) * 2;
    bf16x8 b0 = *reinterpret_cast<const bf16x8*>((const char*)Ks + KSWZ(r32, cb));
    bf16x8 b1 = *reinterpret_cast<const bf16x8*>((const char*)Ks + KSWZ(32 + r32, cb));
    p0 = __builtin_amdgcn_mfma_f32_32x32x16_bf16(b0, qr[d0], p0, 0, 0, 0);
    p1 = __builtin_amdgcn_mfma_f32_32x32x16_bf16(b1, qr[d0], p1, 0, 0, 0); }
}
__device__ __forceinline__ int v_st(int k, int c) { const int kk = (k & ~0xC) | ((k & 4) << 1) | ((k & 8) >> 1); return ((kk >> 3) * 4 + (c >> 5)) * 512 + ((kk & 7) * 32 + (c & 31)) * 2; }
__device__ __forceinline__ int v_rd_base(int lane) { return ((lane & 3) << 3) | (((lane >> 2) & 3) << 6) | (((lane >> 4) & 1) << 5) | (((lane >> 5) & 1) << 8); }
constexpr int v_rd_off(int d0, int ks, int half) { return d0 * 512 + ks * 4096 + half * 2048; }
template <int OFF> __device__ __forceinline__ s16x4 tr_read(int vb) {
  s16x4 r; asm volatile("ds_read_b64_tr_b16 %0, %1 offset:%2" : "=&v"(r) : "v"(vb), "i"(OFF) : "memory"); return r;
}
template <int D0> __device__ __forceinline__ void pv_one(f32x16& od, int vb, bf16x8 pa0, bf16x8 pa1, bf16x8 pa2, bf16x8 pa3) {
  const s16x4 l0 = tr_read<v_rd_off(D0, 0, 0)>(vb), h0 = tr_read<v_rd_off(D0, 0, 1)>(vb), l1 = tr_read<v_rd_off(D0, 1, 0)>(vb), h1 = tr_read<v_rd_off(D0, 1, 1)>(vb);
  const s16x4 l2 = tr_read<v_rd_off(D0, 2, 0)>(vb), h2 = tr_read<v_rd_off(D0, 2, 1)>(vb), l3 = tr_read<v_rd_off(D0, 3, 0)>(vb), h3 = tr_read<v_rd_off(D0, 3, 1)>(vb);
  asm volatile("s_waitcnt lgkmcnt(0)" ::: "memory"); SBAR();
#define PK(L, H) (bf16x8){L[0], L[1], L[2], L[3], H[0], H[1], H[2], H[3]}
  od = __builtin_amdgcn_mfma_f32_32x32x16_bf16(pa0, PK(l0, h0), od, 0, 0, 0);
  od = __builtin_amdgcn_mfma_f32_32x32x16_bf16(pa1, PK(l1, h1), od, 0, 0, 0);
  od = __builtin_amdgcn_mfma_f32_32x32x16_bf16(pa2, PK(l2, h2), od, 0, 0, 0);
  od = __builtin_amdgcn_mfma_f32_32x32x16_bf16(pa3, PK(l3, h3), od, 0, 0, 0);
#undef PK
}
__device__ __forceinline__ void pv_d0(f32x16* o, int vb, bf16x8 pa0, bf16x8 pa1, bf16x8 pa2, bf16x8 pa3) {
  pv_one<0>(o[0], vb, pa0, pa1, pa2, pa3); pv_one<1>(o[1], vb, pa0, pa1, pa2, pa3); pv_one<2>(o[2], vb, pa0, pa1, pa2, pa3); pv_one<3>(o[3], vb, pa0, pa1, pa2, pa3);
}
__device__ __forceinline__ void attn_dense_body(const bf16* Qb, const bf16* __restrict__ Kh, const bf16* __restrict__ Vh, bf16* Ob, int seq, char* lds) {
  const int tid = threadIdx.x, wid = tid >> 6, lane = tid & 63, r32 = lane & 31, hi = lane >> 5;
  bf16* V_lds = (bf16*)lds; bf16* K_lds = (bf16*)(lds + 2 * SHM_V);
  float* ws = (float*)(lds + 2 * SHM_V + 2 * SHM_K) + wid * 64; float* li_l = ws; float* al_l = ws + 32;
  float m_reg = -1e30f, l_reg = 0; f32x16 o[4] = {}; bf16x8 qr[8];
  const bf16* Qw = Qb + (long)(wid * QBLK + r32) * LDQ + hi * 8;
#pragma unroll
  for (int d0 = 0; d0 < 8; ++d0) qr[d0] = *reinterpret_cast<const bf16x8*>(Qw + d0 * 16);
  const int sr = tid >> 4, sc = (tid & 15) * 8, vst0 = v_st(sr, sc), vst1 = v_st(32 + sr, sc);
  const int vb0 = (int)(uintptr_t)V_lds + v_rd_base(lane);
  struct { bf16x8 vs0, vs1, ks0, ks1; } sr_[2];
#define SLOAD(i, k0) do { sr_[i].vs0 = *reinterpret_cast<const bf16x8*>(&Vh[(long)((k0) + sr) * LDK + sc]); sr_[i].vs1 = *reinterpret_cast<const bf16x8*>(&Vh[(long)((k0) + 32 + sr) * LDK + sc]); \
    sr_[i].ks0 = *reinterpret_cast<const bf16x8*>(&Kh[(long)((k0) + sr) * LDK + sc]); sr_[i].ks1 = *reinterpret_cast<const bf16x8*>(&Kh[(long)((k0) + 32 + sr) * LDK + sc]); } while (0)
#define SWRITE(b, i) do { *(bf16x8*)((char*)V_lds + (b) * SHM_V + vst0) = sr_[i].vs0;          \
    *(bf16x8*)((char*)V_lds + (b) * SHM_V + vst1) = sr_[i].vs1; int kc = sc * 2;               \
    *(bf16x8*)((char*)K_lds + (b) * SHM_K + KSWZ(sr, kc)) = sr_[i].ks0;                       \
    *(bf16x8*)((char*)K_lds + (b) * SHM_K + KSWZ(32 + sr, kc)) = sr_[i].ks1; } while (0)
#define SWAIT() asm volatile("s_waitcnt vmcnt(4)" ::: "memory")
#define RESC(a) do { if (__any((a) < 1.f)) { if (hi == 0) al_l[r32] = (a); asm volatile("s_waitcnt lgkmcnt(0)" ::: "memory"); \
    for (int d = 0; d < 4; ++d) for (int r = 0; r < 16; ++r) o[d][r] *= al_l[crow(r, hi)]; } } while (0)
  f32x16 pA0, pA1, pB0, pB1; float mnA, mnB, alA, alB; bf16x8 pa0, pa1, pa2, pa3; const int NT = seq / KVBLK;
  constexpr int SE = 0, SO = 1;
  SLOAD(SE, 0); asm volatile("s_waitcnt vmcnt(0)" ::: "memory"); SWRITE(0, SE); __syncthreads();
  qkt(pA0, pA1, K_lds, qr, r32, hi); partialSM(pA0, pA1, m_reg, mnA, alA);
  SLOAD(SO, KVBLK); if (2 < NT) SLOAD(SE, 2 * KVBLK);
  SWAIT(); SWRITE(1, SO); __syncthreads();
  for (int j = 1; j + 1 < NT; j += 2) {
    SBAR(); qkt(pB0, pB1, (bf16*)((char*)K_lds + SHM_K), qr, r32, hi);
    finishSM(pA0, pA1, alA, l_reg, pa0, pa1, pa2, pa3); SBAR();
    SLOAD(SO, (j + 2) * KVBLK); SBAR();
    pv_d0(o, vb0, pa0, pa1, pa2, pa3); partialSM(pB0, pB1, m_reg, mnB, alB);
    __syncthreads(); SWAIT(); SWRITE(0, SE);
    RESC(alB); __syncthreads();
    SBAR(); qkt(pA0, pA1, K_lds, qr, r32, hi);
    finishSM(pB0, pB1, alB, l_reg, pa0, pa1, pa2, pa3); SBAR();
    if (j + 3 < NT) SLOAD(SE, (j + 3) * KVBLK); SBAR();
    pv_d0(o, vb0 + (int)SHM_V, pa0, pa1, pa2, pa3); partialSM(pA0, pA1, m_reg, mnA, alA);
    __syncthreads(); SWAIT(); SWRITE(1, SO);
    RESC(alA); __syncthreads();
  }
  SBAR(); qkt(pB0, pB1, (bf16*)((char*)K_lds + SHM_K), qr, r32, hi);
  finishSM(pA0, pA1, alA, l_reg, pa0, pa1, pa2, pa3); SBAR();
  pv_d0(o, vb0, pa0, pa1, pa2, pa3); partialSM(pB0, pB1, m_reg, mnB, alB);
  __syncthreads(); RESC(alB);
  finishSM(pB0, pB1, alB, l_reg, pa0, pa1, pa2, pa3); SBAR();
  pv_d0(o, vb0 + (int)SHM_V, pa0, pa1, pa2, pa3);
  if (hi == 0) li_l[r32] = l_reg; asm volatile("s_waitcnt lgkmcnt(0)" ::: "memory");
  float rli[16];
#pragma unroll
  for (int r = 0; r < 16; ++r) rli[r] = __builtin_amdgcn_rcpf(li_l[crow(r, hi)]);
  bf16* Ow = Ob + (long)(wid * QBLK) * LDO;
#pragma unroll
  for (int r = 0; r < 16; ++r) { int orow = crow(r, hi);
    for (int d0 = 0; d0 < 4; ++d0) { const float v = o[d0][r] * rli[r]; Ow[(long)orow * LDO + d0 * 32 + r32] = (bf16)(cvtpk(v, v) & 0xffffu); } }
  __syncthreads();
#undef SLOAD
#undef SWRITE
#undef SWAIT
#undef RESC
}
#undef KSWZ
#undef SBAR
}
constexpr int NWAVES = 8;
#ifndef MK_N_LAUNCHES
#define MK_N_LAUNCHES 1
#endif
constexpr int N_PHASES = 16;
constexpr int N_LAUNCHES = MK_N_LAUNCHES;
constexpr int BATCH = 2, SEQ = 8192, DM = 4096, M = BATCH * SEQ;
constexpr int ATTN_DIM = 2048, KV_DIM = 512, HQK = 2048, DFF = 11008, PLE = 256, NHG = 16, NQH = 16, NKVH = 4;
constexpr int N_IN = 13312, N1 = N_IN + 2 * DM;
constexpr float DN_ALPHA = 1.189207115002721f, LN_EPS = 1e-5f, RMS_EPS = 1e-6f;
constexpr int NCHUNK = M / 64;
constexpr size_t MiB = 1u << 20;
constexpr size_t WS_CTL = 0, CTL_ZERO_BYTES = 1 * MiB;
constexpr size_t WS_TAB = 1 * MiB;
constexpr size_t WS_RF = 2 * MiB, WS_WF = 4 * MiB, WS_RB = 6 * MiB, WS_WB = 8 * MiB;
constexpr size_t WS_BT1 = 10 * MiB;
constexpr size_t WS_WPA = 178 * MiB, WS_WPB = 194 * MiB, WS_WO = 210 * MiB;
constexpr size_t WS_XB = 242 * MiB, WS_MIX = 242 * MiB;
constexpr size_t WS_QA = 370 * MiB, WS_KA = 434 * MiB, WS_VA = 450 * MiB;
constexpr size_t WS_QF = 466 * MiB, WS_KF = 530 * MiB, WS_KB = 594 * MiB, WS_QB = 658 * MiB, WS_IH = 722 * MiB, WS_GH = 786 * MiB;
constexpr size_t WS_GATE = 850 * MiB;
constexpr size_t WS_WUP = 1106 * MiB, WS_WDN = 1278 * MiB, WS_END = 1364 * MiB;
constexpr size_t WS_WPG = 10 * MiB, WS_WPLE = 42 * MiB, WS_PB = 44 * MiB, WS_X1B = 52 * MiB, WS_UB = 180 * MiB, WS_GB = 524 * MiB, WS_PE = 524 * MiB;
static_assert(WS_WDN + (size_t)DM * DFF * 2 <= WS_END && WS_GB + (size_t)M * DFF * 2 <= WS_WUP && WS_X1B + (size_t)M * DM * 2 <= WS_UB, "ws map");
constexpr int CW_TMO = 0, CW_CODE = 1, CW_BAR = 4096;
constexpr int RING_BYTES = 131072, LDSCTL_OFF = RING_BYTES, MISC_OFF = LDSCTL_OFF + 320, LDS_BYTES = 147456;

#define GAS __attribute__((address_space(1)))
#define LAS __attribute__((address_space(3)))
typedef unsigned short bf16;
typedef unsigned v4u __attribute__((ext_vector_type(4)));
typedef unsigned v2u __attribute__((ext_vector_type(2)));
typedef float f32x4 __attribute__((ext_vector_type(4)));
typedef short bf16x8 __attribute__((ext_vector_type(8)));
typedef short s16x4 __attribute__((ext_vector_type(4)));
typedef GAS unsigned gu32;
#define RLX_AGENT __ATOMIC_RELAXED, __HIP_MEMORY_SCOPE_AGENT
#define LDS_WAIT() asm volatile("s_waitcnt lgkmcnt(0)" ::: "memory")
#define VM_WAIT() asm volatile("s_waitcnt vmcnt(0)" ::: "memory")
typedef float f32x2_t __attribute__((ext_vector_type(2))); typedef __bf16 bf16x2_t __attribute__((ext_vector_type(2)));
__device__ __forceinline__ unsigned pk2(float lo, float hi) { f32x2_t v = {lo, hi}; bf16x2_t b = __builtin_convertvector(v, bf16x2_t); return __builtin_bit_cast(unsigned, b); }
__device__ __forceinline__ float bflo(unsigned w) { return __uint_as_float(w << 16); }
__device__ __forceinline__ float bfhi(unsigned w) { return __uint_as_float(w & 0xffff0000u); }
__device__ __forceinline__ float sigm(float v) { return __builtin_amdgcn_rcpf(1.0f + __expf(-v)); }
#define XB_TMO      128
#define XB_XCNT(j)  (256  + 64 * (j))
#define XB_XSUB(j)  (1280 + 64 * (j))
#define XB_XGEN(j)  (2304 + 64 * (j))
#define XB_TOP      3328
#define XB_TOPGEN   3392
#define XCD_BAR_WORDS 3456
#define XB_SPIN_CAP (1u << 18)

__device__ __forceinline__ unsigned xb_ld(unsigned* p)              { return __hip_atomic_load(p, __ATOMIC_RELAXED, __HIP_MEMORY_SCOPE_AGENT); }
__device__ __forceinline__ unsigned xb_add(unsigned* p, unsigned v) { return __hip_atomic_fetch_add(p, v, __ATOMIC_RELAXED, __HIP_MEMORY_SCOPE_AGENT); }
__device__ __forceinline__ unsigned xb_xcc_id() { return (unsigned)__builtin_amdgcn_s_getreg((3 << 11) | 20) & 0xFu; }
#define XB_SPIN(cond, bar) do { unsigned _sp = 0; while (cond) { __builtin_amdgcn_s_sleep(1); \
    if ((++_sp & 255u) == 0u) { if (xb_ld(&(bar)[XB_TMO])) break; if (_sp > XB_SPIN_CAP) { atomicAdd(&(bar)[XB_TMO], 1u); break; } } } } while (0)

struct XcdBarrier {
    unsigned* bar; unsigned x;
    volatile LAS unsigned* st;
};

__device__ __forceinline__ XcdBarrier xcd_barrier_post(unsigned* bar, volatile LAS unsigned* st) {
    XcdBarrier b; b.bar = bar; b.x = xb_xcc_id(); b.st = st;
    if (threadIdx.x == 0) (void)xb_add(&bar[XB_XCNT(b.x)], 1u);
    return b;
}
__device__ __forceinline__ void xcd_barrier_complete(unsigned* bar, unsigned x, unsigned& nloc, unsigned& nx) {
    const unsigned G = gridDim.x * gridDim.y * gridDim.z;
    unsigned sum, cnt, mine, sp = 0u;
    for (;;) {
        sum = 0u; cnt = 0u; mine = 0u;
#pragma unroll
        for (unsigned j = 0; j < 16; ++j) { const unsigned c = xb_ld(&bar[XB_XCNT(j)]); sum += c; cnt += (c > 0u) ? 1u : 0u; mine = (j == x) ? c : mine; }
        if (sum == G) break;
        __builtin_amdgcn_s_sleep(1);
        if ((++sp & 255u) == 0u) { if (xb_ld(&bar[XB_TMO])) break; if (sp > XB_SPIN_CAP) { atomicAdd(&bar[XB_TMO], 1u); break; } }
    }
    nloc = mine > 0u ? mine : 1u; nx = cnt > 0u ? cnt : 1u;
}

__device__ __forceinline__ void xcd_barrier(const XcdBarrier& b) {
    asm volatile("s_waitcnt vmcnt(0)" ::: "memory");
    __syncthreads();
    if (threadIdx.x == 0) {
        unsigned* bar = b.bar;
        __builtin_amdgcn_s_waitcnt(0);
        unsigned nloc = b.st[0], nx = b.st[1];
        if (nloc == 0u) { xcd_barrier_complete(bar, b.x, nloc, nx); b.st[0] = nloc; b.st[1] = nx; }
        const unsigned old = xb_add(&bar[XB_XSUB(b.x)], 1u);
        const unsigned gen = old / nloc;
        if (old + 1u == (gen + 1u) * nloc) {
            __builtin_amdgcn_fence(__ATOMIC_RELEASE, "agent");
            asm volatile("s_waitcnt vmcnt(0)" ::: "memory");
            const unsigned og = xb_add(&bar[XB_TOP], 1u);
            const unsigned tg = og / nx;
            if (og + 1u == (tg + 1u) * nx) xb_add(&bar[XB_TOPGEN], 1u);
            else XB_SPIN(xb_ld(&bar[XB_TOPGEN]) == tg, bar);
            __builtin_amdgcn_fence(__ATOMIC_ACQUIRE, "agent");
            xb_add(&bar[XB_XGEN(b.x)], 1u);
            asm volatile("s_waitcnt vmcnt(0)" ::: "memory");
        } else {
            XB_SPIN(xb_ld(&bar[XB_XGEN(b.x)]) == gen, bar);
            __builtin_amdgcn_fence(__ATOMIC_ACQUIRE, "agent");
            asm volatile("s_waitcnt vmcnt(0)" ::: "memory");
        }
    }
    __syncthreads();
}
struct Frame {
    LAS unsigned char* lds;
    volatile LAS unsigned* MISC;
    gu32* ctl;
    int tid, lane, wave, vcu, G;
    unsigned char* ws; float* out;
};
__device__ __forceinline__ float wave_sum(float v) {
#pragma unroll
    for (int o = 1; o < 64; o <<= 1) v += __shfl_xor(v, o);
    return v;
}
__device__ __forceinline__ void p0_transpose_item(const float* W, int K, int N, bf16* WT, int row_off, LAS float* scr, int item, int lane) {
    const int nblk = N / 32, kb = item / nblk, nb = item % nblk, k0 = 64 * kb, n0 = 32 * nb;
#pragma unroll 8
    for (int i = 0; i < 32; ++i) { const int kk = 2 * i + (lane >> 5); scr[kk * 33 + (lane & 31)] = W[(size_t)(k0 + kk) * N + n0 + (lane & 31)]; }
    LDS_WAIT(); asm volatile("" ::: "memory");
    const int c = lane & 7;
#pragma unroll
    for (int j = 0; j < 4; ++j) { const int n = (lane >> 3) + 8 * j; const LAS float* s = scr + (8 * c) * 33 + n;
        v4u o; o.x = pk2(s[0 * 33], s[1 * 33]); o.y = pk2(s[2 * 33], s[3 * 33]); o.z = pk2(s[4 * 33], s[5 * 33]); o.w = pk2(s[6 * 33], s[7 * 33]);
        *(GAS v4u*)(WT + (size_t)(row_off + n0 + n) * K + k0 + 8 * c) = o; }
    LDS_WAIT(); asm volatile("" ::: "memory");
}
__device__ __forceinline__ void cvt_rows(Frame& F, const float* src, bf16* dst, size_t n8) {
    for (size_t i = (size_t)F.vcu * 512 + F.tid; i < n8; i += (size_t)F.G * 512) {
        const f32x4 a = *(const f32x4*)(src + i * 8), b = *(const f32x4*)(src + i * 8 + 4);
        v4u o; o.x = pk2(a.x, a.y); o.y = pk2(a.z, a.w); o.z = pk2(b.x, b.y); o.w = pk2(b.z, b.w);
        *(v4u*)(dst + i * 8) = o; }
}
struct In { const float *x, *p, *w_in, *q_norm, *k_norm, *lb_logits, *hg_norm, *w_pa, *w_pb, *w_gate, *b_gate, *w_o, *ln1_g, *ln1_b, *w_up, *conv_w, *conv_b, *w_down, *ln2_g, *ln2_b, *w_pg, *w_ple; };

__device__ __forceinline__ void p0_prologue(Frame& F, const In& I) {
    unsigned char* ws = F.ws;
    { float* tab = (float*)(ws + WS_TAB);
      for (int i = blockIdx.x * 512 + F.tid; i < 4096 + 4096; i += F.G * 512) {
          if (i < 4096) { const int pos = i >> 5, fi = i & 31; const float inv = powf(10000.0f, -(float)(2 * fi) / 64.0f); const float ang = (float)pos * inv; tab[i] = cosf(ang); tab[4096 + i] = sinf(ang); }
          else { const int j = i - 4096, dir = j >> 11, c = j & 2047; const float a = I.lb_logits[(dir * 2 + 0) * 2048 + c], b = I.lb_logits[(dir * 2 + 1) * 2048 + c];
                 tab[8192 + j] = 1.0f / (1.0f + expf(b - a)); } } }
    LAS float* scr = (LAS float*)(F.lds + F.wave * 16384);
    const int gw = F.vcu * NWAVES + F.wave, NGW = F.G * NWAVES;
    constexpr int I0 = (DM / 64) * (N_IN / 32), I1 = (DM / 64) * (2 * DM / 32), I2 = (ATTN_DIM / 64) * (DM / 32), I3 = I2, I4 = (DM / 64) * (DM / 32), I5 = (DM / 64) * (2 * DFF / 32), I6 = (DFF / 64) * (DM / 32);
    constexpr int NITEMS = I0 + I1 + I2 + I3 + I4 + I5 + I6;
    for (int it = gw; it < NITEMS; it += NGW) {
        int r = it;
        if (r < I0) { p0_transpose_item(I.w_in, DM, N_IN, (bf16*)(ws + WS_BT1), 0, scr, r, F.lane); continue; } r -= I0;
        if (r < I1) { p0_transpose_item(I.w_gate, DM, 2 * DM, (bf16*)(ws + WS_BT1), N_IN, scr, r, F.lane); continue; } r -= I1;
        if (r < I2) { p0_transpose_item(I.w_pa, ATTN_DIM, DM, (bf16*)(ws + WS_WPA), 0, scr, r, F.lane); continue; } r -= I2;
        if (r < I3) { p0_transpose_item(I.w_pb, HQK, DM, (bf16*)(ws + WS_WPB), 0, scr, r, F.lane); continue; } r -= I3;
        if (r < I4) { p0_transpose_item(I.w_o, DM, DM, (bf16*)(ws + WS_WO), 0, scr, r, F.lane); continue; } r -= I4;
        if (r < I5) { p0_transpose_item(I.w_up, DM, 2 * DFF, (bf16*)(ws + WS_WUP), 0, scr, r, F.lane); continue; } r -= I5;
        p0_transpose_item(I.w_down, DFF, DM, (bf16*)(ws + WS_WDN), 0, scr, r, F.lane);
    }
    cvt_rows(F, I.x, (bf16*)(ws + WS_XB), (size_t)M * DM / 8);
}
__device__ __forceinline__ void qk_prep(Frame& F, const In& I) {
    bf16* QA = (bf16*)(F.ws + WS_QA); bf16* KA = (bf16*)(F.ws + WS_KA); const float* tab = (const float*)(F.ws + WS_TAB);
    const int sub = F.lane & 15, e0 = sub * 8, e1 = e0 ^ 32, fi = e0 & 31;
    const float sgn = (sub & 4) ? 1.f : -1.f;
    for (int it = (F.vcu * 512 + F.tid) >> 4; it < M * 20; it += F.G * 32) {
        bf16* ptr; const float* gain; int row;
        if (it < M * 16) { row = it >> 4; ptr = QA + (size_t)row * 2048 + (it & 15) * 128; gain = I.q_norm; }
        else { const int i2 = it - M * 16; row = i2 >> 2; ptr = KA + (size_t)row * 512 + (i2 & 3) * 128; gain = I.k_norm; }
        const v4u xv = *(const v4u*)(ptr + e0);
        v4u pv; pv.x = __shfl_xor(xv.x, 4); pv.y = __shfl_xor(xv.y, 4); pv.z = __shfl_xor(xv.z, 4); pv.w = __shfl_xor(xv.w, 4);
        const float x[8] = {bflo(xv.x), bfhi(xv.x), bflo(xv.y), bfhi(xv.y), bflo(xv.z), bfhi(xv.z), bflo(xv.w), bfhi(xv.w)};
        const float px[8] = {bflo(pv.x), bfhi(pv.x), bflo(pv.y), bfhi(pv.y), bflo(pv.z), bfhi(pv.z), bflo(pv.w), bfhi(pv.w)};
        float ss = 0.f;
#pragma unroll
        for (int j = 0; j < 8; ++j) ss += x[j] * x[j];
        ss += __shfl_xor(ss, 1); ss += __shfl_xor(ss, 2); ss += __shfl_xor(ss, 4); ss += __shfl_xor(ss, 8);
        const float rstd = 1.0f / sqrtf(ss * (1.0f / 128.0f) + RMS_EPS);
        const int t = row & (SEQ - 1), pos = (e0 < 64) ? (t >> 6) : (t & 63);
        const f32x4 c0 = *(const f32x4*)(tab + pos * 32 + fi), c1 = *(const f32x4*)(tab + pos * 32 + fi + 4);
        const f32x4 s0 = *(const f32x4*)(tab + 4096 + pos * 32 + fi), s1 = *(const f32x4*)(tab + 4096 + pos * 32 + fi + 4);
        const f32x4 g0 = *(const f32x4*)(gain + e0), g1 = *(const f32x4*)(gain + e0 + 4), h0 = *(const f32x4*)(gain + e1), h1 = *(const f32x4*)(gain + e1 + 4);
        float o[8];
#pragma unroll
        for (int j = 0; j < 8; ++j) { const float cj = j < 4 ? c0[j & 3] : c1[j & 3], sj = j < 4 ? s0[j & 3] : s1[j & 3], gj = j < 4 ? g0[j & 3] : g1[j & 3], hj = j < 4 ? h0[j & 3] : h1[j & 3];
            o[j] = (x[j] * rstd * gj) * cj + sgn * (px[j] * rstd * hj) * sj; }
        v4u w; w.x = pk2(o[0], o[1]); w.y = pk2(o[2], o[3]); w.z = pk2(o[4], o[5]); w.w = pk2(o[6], o[7]);
        *(v4u*)(ptr + e0) = w;
    }
}
__device__ __forceinline__ void h1_pass(Frame& F) {
    unsigned char* ws = F.ws; const float* tab = (const float*)(ws + WS_TAB);
    bf16* QF = (bf16*)(ws + WS_QF); bf16* KF = (bf16*)(ws + WS_KF); bf16* KB = (bf16*)(ws + WS_KB); bf16* QB = (bf16*)(ws + WS_QB);
    typedef float f2 __attribute__((ext_vector_type(2)));
    const int p = F.tid & 255, h = F.tid >> 8;
    for (int it = F.vcu; it < NCHUNK * 4; it += F.G) {
        const int c = it >> 2, cg = it & 3, col = cg * 512 + 2 * p; const size_t base = (size_t)(c * 64 + 32 * h) * 2048 + col; const size_t vecidx = (size_t)c * 2048 + col;
        const float lbf0 = tab[8192 + col], lbf1 = tab[8192 + col + 1], lbb0 = tab[8192 + 2048 + col], lbb1 = tab[8192 + 2048 + col + 1];
        float TF0 = 0.f, TF1 = 0.f, TB0 = 0.f, TB1 = 0.f;
        { const bf16* zf = KF + base; const bf16* zb = KB + base;
#pragma unroll 4
          for (int j = 0; j < 32; ++j) { const unsigned a = *(const unsigned*)zf, b = *(const unsigned*)zb; zf += 2048; zb += 2048;
              TF0 += __logf(lbf0 + (1.f - lbf0) * sigm(bflo(a))); TF1 += __logf(lbf1 + (1.f - lbf1) * sigm(bfhi(a)));
              TB0 += __logf(lbb0 + (1.f - lbb0) * sigm(bflo(b))); TB1 += __logf(lbb1 + (1.f - lbb1) * sigm(bfhi(b))); } }
        { float* vf = (float*)(ws + (h == 0 ? WS_RF : WS_WF)) + vecidx; float* vb = (float*)(ws + (h == 1 ? WS_RB : WS_WB)) + vecidx;
          *(f2*)vf = (f2){__expf(TF0), __expf(TF1)}; *(f2*)vb = (f2){__expf(TB0), __expf(TB1)}; }
        float PF0 = 0.f, PF1 = 0.f, PB0 = 0.f, PB1 = 0.f;
        { bf16* qf = QF + base; bf16* kf = KF + base; bf16* kb = KB + base; bf16* qb = QB + base;
#pragma unroll 2
          for (int j = 0; j < 32; ++j) {
              const unsigned qq = *(const unsigned*)qf, a = *(const unsigned*)kf, b = *(const unsigned*)kb;
              const float q0 = bflo(qq), q1 = bfhi(qq);
              const float ff0 = lbf0 + (1.f - lbf0) * sigm(bflo(a)), ff1 = lbf1 + (1.f - lbf1) * sigm(bfhi(a));
              const float fb0 = lbb0 + (1.f - lbb0) * sigm(bflo(b)), fb1 = lbb1 + (1.f - lbb1) * sigm(bfhi(b));
              const float lf0 = __logf(ff0), lf1 = __logf(ff1), lb0 = __logf(fb0), lb1 = __logf(fb1);
              PF0 += lf0; PF1 += lf1; PB0 += lb0; PB1 += lb1;
              float xf0 = (h == 0) ? (PF0 - TF0) : PF0, xf1 = (h == 0) ? (PF1 - TF1) : PF1;
              float xb0 = (h == 1) ? (lb0 - PB0) : (TB0 - PB0 + lb0), xb1 = (h == 1) ? (lb1 - PB1) : (TB1 - PB1 + lb1);
              xf0 = fminf(fmaxf(xf0, -80.f), 80.f); xf1 = fminf(fmaxf(xf1, -80.f), 80.f); xb0 = fminf(fmaxf(xb0, -80.f), 80.f); xb1 = fminf(fmaxf(xb1, -80.f), 80.f);
              const float EF0 = __expf(xf0), EF1 = __expf(xf1), EB0 = __expf(xb0), EB1 = __expf(xb1);
              *(unsigned*)qf = pk2(q0 * EF0, q1 * EF1);
              *(unsigned*)kf = pk2((1.f - ff0) * __builtin_amdgcn_rcpf(EF0), (1.f - ff1) * __builtin_amdgcn_rcpf(EF1));
              *(unsigned*)qb = pk2(q0 * EB0, q1 * EB1);
              *(unsigned*)kb = pk2((1.f - fb0) * __builtin_amdgcn_rcpf(EB0), (1.f - fb1) * __builtin_amdgcn_rcpf(EB1));
              qf += 2048; kf += 2048; kb += 2048; qb += 2048; } }
    }
}
__device__ __forceinline__ void p2_small_converts(Frame& F, const In& I) {
    LAS float* scr = (LAS float*)(F.lds + F.wave * 16384);
    const int gw = F.vcu * NWAVES + F.wave, NGW = F.G * NWAVES;
    constexpr int J0 = (DM / 64) * (DM / 32), J1 = (PLE / 64) * (DM / 32);
    for (int it = gw; it < J0 + J1; it += NGW) {
        if (it < J0) p0_transpose_item(I.w_pg, DM, DM, (bf16*)(F.ws + WS_WPG), 0, scr, it, F.lane);
        else p0_transpose_item(I.w_ple, PLE, DM, (bf16*)(F.ws + WS_WPLE), 0, scr, it - J0, F.lane);
    }
    cvt_rows(F, I.p, (bf16*)(F.ws + WS_PB), (size_t)M * PLE / 8);
}
typedef short v4i16_t __attribute__((ext_vector_type(4)));
__device__ __forceinline__ unsigned offb(unsigned row, unsigned ch) { return 256u * row + 16u * (ch ^ (((row & 3u) << 2) | ((row >> 2) & 3u))); }
__device__ __forceinline__ s16x4 vtr(const LAS unsigned char* p) { return __builtin_bit_cast(s16x4, __builtin_amdgcn_ds_read_tr16_b64_v4i16((LAS v4i16_t*)p)); }
#define MFMA16(a, b, c) __builtin_amdgcn_mfma_f32_16x16x32_bf16((a), (b), (c), 0, 0, 0)
template <int DIR>
__device__ __forceinline__ void scan_unit(Frame& F, const bf16* QIN, const bf16* KIN, const bf16* VV, bf16* OO, const float* RV, const float* WV, int b, int h) {
    LAS unsigned char* lds = F.lds;
    const int tid = F.tid, lane = F.lane, wid = F.wave, l15 = lane & 15, g = lane >> 4;
    constexpr int BUFSZ = 3 * 16384 + 1024, AM_OFF = 2 * BUFSZ;
    static_assert(AM_OFF + 8192 <= RING_BYTES, "scan LDS");
    int so[2]; size_t go[2];
#pragma unroll
    for (int j = 0; j < 2; ++j) { const int c = tid + 512 * j, row = c >> 4, ch = c & 15; so[j] = (row >> 5) * 8192 + (int)offb(row & 31, ch); go[j] = (size_t)row * 2048 + h * 128 + ch * 8; }
    f32x4 S[8];
#pragma unroll
    for (int i = 0; i < 8; ++i) S[i] = (f32x4){0.f, 0.f, 0.f, 0.f};
    v4u rq[2], rk[2], rv[2]; f32x4 rw = (f32x4){0.f, 0.f, 0.f, 0.f};
#define SCAN_LOAD(n) do { const size_t rb_ = (size_t)(b * SEQ + 64 * (n)) * 2048; \
        _Pragma("unroll") for (int j = 0; j < 2; ++j) { rq[j] = *(const v4u*)(QIN + rb_ + go[j]); rk[j] = *(const v4u*)(KIN + rb_ + go[j]); rv[j] = *(const v4u*)(VV + rb_ + go[j]); } \
        if (tid < 64) rw = *(const f32x4*)((tid < 32 ? RV : WV) + (size_t)(b * 128 + (n)) * 2048 + h * 128 + 4 * (tid & 31)); } while (0)
    SCAN_LOAD(DIR == 0 ? 0 : 127);
    const LAS unsigned char* AM = lds + AM_OFF;
    const int tq = l15 >> 2, tp = lane & 3;
    for (int it = 0; it < 128; ++it) {
        const int n = (DIR == 0) ? it : 127 - it;
        LAS unsigned char* bufp = lds + (it & 1) * BUFSZ;
#pragma unroll
        for (int j = 0; j < 2; ++j) { *(LAS v4u*)(bufp + so[j]) = rq[j]; *(LAS v4u*)(bufp + 16384 + so[j]) = rk[j]; *(LAS v4u*)(bufp + 32768 + so[j]) = rv[j]; }
        if (tid < 64) *(LAS f32x4*)(bufp + 49152 + tid * 16) = rw;
        if (it + 1 < 128) SCAN_LOAD((DIR == 0) ? it + 1 : 126 - it);
        __syncthreads();
        const LAS unsigned char* Qi = bufp; const LAS unsigned char* Ki = bufp + 16384; const LAS unsigned char* Vi = bufp + 32768;
        const LAS float* rI = (const LAS float*)(bufp + 49152); const LAS float* wI = rI + 128;
        { const int ti = wid >> 1, sj0 = (wid & 1) * 2, qrow = 16 * ti + l15, kr0 = 16 * sj0 + l15, kr1 = kr0 + 16;
          f32x4 a0 = (f32x4){0.f, 0.f, 0.f, 0.f}, a1 = a0;
#pragma unroll
          for (int ks = 0; ks < 4; ++ks) { const unsigned ch = 4 * ks + g;
              const bf16x8 qf = *(const LAS bf16x8*)(Qi + (qrow >> 5) * 8192 + offb(qrow & 31, ch));
              const bf16x8 k0 = *(const LAS bf16x8*)(Ki + (kr0 >> 5) * 8192 + offb(kr0 & 31, ch));
              const bf16x8 k1 = *(const LAS bf16x8*)(Ki + (kr1 >> 5) * 8192 + offb(kr1 & 31, ch));
              a0 = MFMA16(k0, qf, a0); a1 = MFMA16(k1, qf, a1); }
          const int t = qrow;
#pragma unroll
          for (int tl = 0; tl < 2; ++tl) { f32x4 v = tl ? a1 : a0; const int sbase = 16 * (sj0 + tl) + 4 * g;
#pragma unroll
              for (int i = 0; i < 4; ++i) { const int s = sbase + i; const bool keep = (DIR == 0) ? (s <= t) : (s >= t); v[i] = keep ? v[i] : 0.f; }
              v2u w2; w2.x = pk2(v[0], v[1]); w2.y = pk2(v[2], v[3]);
              *(LAS v2u*)(lds + AM_OFF + t * 128 + ((((sbase >> 3)) ^ (t & 7)) << 4) + 8 * (g & 1)) = w2; } }
        __syncthreads();
        bf16x8 vf[2];
#pragma unroll
        for (int ks = 0; ks < 2; ++ks) { const LAS unsigned char* tb = Vi + ks * 8192;
            const s16x4 lo = vtr(tb + offb(8 * g + tq, 2 * wid + (tp >> 1)) + 8 * (tp & 1)), hi = vtr(tb + offb(8 * g + 4 + tq, 2 * wid + (tp >> 1)) + 8 * (tp & 1));
            vf[ks] = (bf16x8){lo[0], lo[1], lo[2], lo[3], hi[0], hi[1], hi[2], hi[3]}; }
        f32x4 ao[4];
#pragma unroll
        for (int tt = 0; tt < 4; ++tt) ao[tt] = (f32x4){0.f, 0.f, 0.f, 0.f};
#pragma unroll
        for (int tt = 0; tt < 4; ++tt) { const int t = 16 * tt + l15;
#pragma unroll
            for (int ks = 0; ks < 2; ++ks) { const bf16x8 af = *(const LAS bf16x8*)(AM + t * 128 + (((4 * ks + g) ^ (t & 7)) << 4)); ao[tt] = MFMA16(vf[ks], af, ao[tt]); } }
#pragma unroll
        for (int ks = 0; ks < 4; ++ks) {
            const f32x4 r0 = *(const LAS f32x4*)(rI + 32 * ks + 4 * g), r1 = *(const LAS f32x4*)(rI + 32 * ks + 16 + 4 * g);
            const f32x4 s0 = S[2 * ks] * r0, s1 = S[2 * ks + 1] * r1;
            v4u sw; sw.x = pk2(s0[0], s0[1]); sw.y = pk2(s0[2], s0[3]); sw.z = pk2(s1[0], s1[1]); sw.w = pk2(s1[2], s1[3]);
            const bf16x8 sf = __builtin_bit_cast(bf16x8, sw);
#pragma unroll
            for (int tt = 0; tt < 4; ++tt) { const int t = 16 * tt + l15; const LAS unsigned char* qb = Qi + (t >> 5) * 8192;
                const v2u qa = *(const LAS v2u*)(qb + offb(t & 31, 4 * ks + (g >> 1)) + 8 * (g & 1)), qc = *(const LAS v2u*)(qb + offb(t & 31, 4 * ks + 2 + (g >> 1)) + 8 * (g & 1));
                v4u qw; qw.x = qa.x; qw.y = qa.y; qw.z = qc.x; qw.w = qc.y;
                ao[tt] = MFMA16(sf, __builtin_bit_cast(bf16x8, qw), ao[tt]); } }
        { bf16* op = OO + (size_t)(b * SEQ + 64 * n + l15) * 2048 + h * 128 + 16 * wid + 4 * g;
#pragma unroll
          for (int tt = 0; tt < 4; ++tt) { v2u w2; w2.x = pk2(ao[tt][0], ao[tt][1]); w2.y = pk2(ao[tt][2], ao[tt][3]); *(v2u*)(op + (size_t)(16 * tt) * 2048) = w2; } }
#pragma unroll
        for (int dt = 0; dt < 8; ++dt) { f32x4 T = (f32x4){0.f, 0.f, 0.f, 0.f};
#pragma unroll
            for (int ks = 0; ks < 2; ++ks) { const LAS unsigned char* tb = Ki + ks * 8192;
                const s16x4 lo = vtr(tb + offb(8 * g + tq, 2 * dt + (tp >> 1)) + 8 * (tp & 1)), hi = vtr(tb + offb(8 * g + 4 + tq, 2 * dt + (tp >> 1)) + 8 * (tp & 1));
                const bf16x8 kt = (bf16x8){lo[0], lo[1], lo[2], lo[3], hi[0], hi[1], hi[2], hi[3]};
                T = MFMA16(kt, vf[ks], T); }
            const f32x4 rr = *(const LAS f32x4*)(rI + 16 * dt + 4 * g), ww = *(const LAS f32x4*)(wI + 16 * dt + 4 * g);
            S[dt] = (rr * ww) * S[dt] + ww * T; }
    }
    __syncthreads();
#undef SCAN_LOAD
}
__device__ __forceinline__ void combine_pass(Frame& F, const In& I) {
    bf16* OF = (bf16*)(F.ws + WS_QF); const bf16* OB = (const bf16*)(F.ws + WS_QB); const bf16* GH = (const bf16*)(F.ws + WS_GH);
    const int sub = F.lane & 15, e0 = sub * 8;
    for (int it = (F.vcu * 512 + F.tid) >> 4; it < M * 16; it += F.G * 32) {
        const int row = it >> 4, head = it & 15; const size_t off = (size_t)row * 2048 + head * 128 + e0;
        const v4u a = *(const v4u*)(OF + off), bq = *(const v4u*)(OB + off), gq = *(const v4u*)(GH + off);
        float o[8] = {bflo(a.x) + bflo(bq.x), bfhi(a.x) + bfhi(bq.x), bflo(a.y) + bflo(bq.y), bfhi(a.y) + bfhi(bq.y), bflo(a.z) + bflo(bq.z), bfhi(a.z) + bfhi(bq.z), bflo(a.w) + bflo(bq.w), bfhi(a.w) + bfhi(bq.w)};
        const float gg[8] = {bflo(gq.x), bfhi(gq.x), bflo(gq.y), bfhi(gq.y), bflo(gq.z), bfhi(gq.z), bflo(gq.w), bfhi(gq.w)};
        float ss = 0.f;
#pragma unroll
        for (int j = 0; j < 8; ++j) ss += o[j] * o[j];
        ss += __shfl_xor(ss, 1); ss += __shfl_xor(ss, 2); ss += __shfl_xor(ss, 4); ss += __shfl_xor(ss, 8);
        const float rstd = 1.0f / sqrtf(ss * (1.0f / 128.0f) + RMS_EPS);
        const f32x4 n0 = *(const f32x4*)(I.hg_norm + head * 128 + e0), n1 = *(const f32x4*)(I.hg_norm + head * 128 + e0 + 4);
#pragma unroll
        for (int j = 0; j < 8; ++j) o[j] = o[j] * rstd * (j < 4 ? n0[j & 3] : n1[j & 3]) * gg[j];
        v4u w; w.x = pk2(o[0], o[1]); w.y = pk2(o[2], o[3]); w.z = pk2(o[4], o[5]); w.w = pk2(o[6], o[7]);
        *(v4u*)(OF + off) = w;
    }
}
__device__ __forceinline__ void ln_pass(Frame& F, float* X, bf16* XB, const float* gam, const float* bet) {
    const int gw = F.vcu * NWAVES + F.wave, NGW = F.G * NWAVES;
    for (int m = gw; m < M; m += NGW) {
        f32x4* xr = (f32x4*)(X + (size_t)m * DM) + F.lane;
        f32x4 v[16]; float s = 0.f;
#pragma unroll
        for (int j = 0; j < 16; ++j) { v[j] = xr[64 * j]; s += (v[j].x + v[j].y) + (v[j].z + v[j].w); }
        const float mean = wave_sum(s) * (1.f / DM); float s2 = 0.f;
#pragma unroll
        for (int j = 0; j < 16; ++j) { v[j] = v[j] - mean; s2 += (v[j].x * v[j].x + v[j].y * v[j].y) + (v[j].z * v[j].z + v[j].w * v[j].w); }
        const float rstd = 1.f / sqrtf(wave_sum(s2) * (1.f / DM) + LN_EPS);
        v2u* o8 = (v2u*)(XB + (size_t)m * DM) + F.lane;
#pragma unroll
        for (int j = 0; j < 16; ++j) { const f32x4 gg = *((const f32x4*)gam + F.lane + 64 * j), bb = *((const f32x4*)bet + F.lane + 64 * j);
            const f32x4 y = v[j] * rstd * gg + bb; xr[64 * j] = y; v2u w; w.x = pk2(y.x, y.y); w.y = pk2(y.z, y.w); o8[64 * j] = w; }
    }
}
__device__ __forceinline__ void conv_pass(Frame& F, const In& I) {
    bf16* U = (bf16*)(F.ws + WS_UB); const bf16* Gp = (const bf16*)(F.ws + WS_GB);
    constexpr int NCG = DFF / 8, NIT = (M / 32) * NCG;
    for (int it = F.vcu * 512 + F.tid; it < NIT; it += F.G * 512) {
        const int r = it / NCG, cg = it - r * NCG, c0 = cg * 8, t0 = r * 32, tl = t0 & (SEQ - 1);
        float w0[8], w1[8], w2[8], bb[8];
#pragma unroll
        for (int j = 0; j < 8; ++j) { w0[j] = I.conv_w[c0 + j]; w1[j] = I.conv_w[DFF + c0 + j]; w2[j] = I.conv_w[2 * DFF + c0 + j]; bb[j] = I.conv_b[c0 + j]; }
        const v4u zero = (v4u){0u, 0u, 0u, 0u};
        v4u gp = (tl == 0) ? zero : *(const v4u*)(Gp + (size_t)(t0 - 1) * DFF + c0);
        v4u gc = *(const v4u*)(Gp + (size_t)t0 * DFF + c0);
        for (int j = 0; j < 32; ++j) {
            const v4u gn = (tl + j == SEQ - 1) ? zero : *(const v4u*)(Gp + (size_t)(t0 + j + 1) * DFF + c0);
            const v4u uu = *(const v4u*)(U + (size_t)(t0 + j) * DFF + c0);
            const unsigned gpa[4] = {gp.x, gp.y, gp.z, gp.w}, gca[4] = {gc.x, gc.y, gc.z, gc.w}, gna[4] = {gn.x, gn.y, gn.z, gn.w}, ua[4] = {uu.x, uu.y, uu.z, uu.w};
            unsigned ow[4];
#pragma unroll
            for (int q = 0; q < 4; ++q) {
                const float a0 = bflo(gpa[q]) * w0[2 * q] + bflo(gca[q]) * w1[2 * q] + bflo(gna[q]) * w2[2 * q] + bb[2 * q];
                const float a1 = bfhi(gpa[q]) * w0[2 * q + 1] + bfhi(gca[q]) * w1[2 * q + 1] + bfhi(gna[q]) * w2[2 * q + 1] + bb[2 * q + 1];
                ow[q] = pk2(a0 * sigm(a0) * bflo(ua[q]), a1 * sigm(a1) * bfhi(ua[q])); }
            *(v4u*)(U + (size_t)(t0 + j) * DFF + c0) = (v4u){ow[0], ow[1], ow[2], ow[3]};
            gp = gc; gc = gn;
        }
    }
}
struct Args { In in; float* out; unsigned char* ws; int ph_lo, ph_hi, li, pad; };
__global__ void __launch_bounds__(NWAVES * 64, 2) mk_fwd(Args args) {
    extern __shared__ __attribute__((aligned(16))) unsigned char lds[];
    Frame F;
    F.lds = (LAS unsigned char*)lds;
    F.MISC = (volatile LAS unsigned*)(F.lds + MISC_OFF);
    F.tid = threadIdx.x; F.lane = F.tid & 63; F.wave = __builtin_amdgcn_readfirstlane(F.tid >> 6);
    F.G = gridDim.x; { const int bx = blockIdx.x; F.vcu = (F.G % 8 == 0) ? (bx % 8) * (F.G / 8) + bx / 8 : bx; }
    F.ws = args.ws; F.out = args.out;
    F.ctl = (gu32*)(args.ws + WS_CTL);
    const In& I = args.in;
    unsigned char* ws = args.ws;
    for (int u = F.tid; u < (LDS_BYTES - LDSCTL_OFF) / 4; u += NWAVES * 64) ((LAS unsigned*)(F.lds + LDSCTL_OFF))[u] = 0u;
    __syncthreads();
    XcdBarrier bar; bar.bar = (unsigned*)(F.ctl + CW_BAR); bar.x = 0; bar.st = nullptr;
    if (N_LAUNCHES == 1) bar = xcd_barrier_post((unsigned*)(F.ctl + CW_BAR), F.MISC + 8);
#define GRID_BAR() do { if (N_LAUNCHES == 1) xcd_barrier(bar); } while (0)
    const int lo = args.ph_lo, hi = args.ph_hi;
#ifndef PH_MASK
#define PH_MASK 0xFFFF
#endif
#define IN(k) ((((PH_MASK) >> (k)) & 1) && lo <= (k) && (k) < hi)
#define BOTH(k) (IN(k) && IN((k) + 1))
    bf16* const BT1 = (bf16*)(ws + WS_BT1); bf16* const XB = (bf16*)(ws + WS_XB);
    bf16* const QA = (bf16*)(ws + WS_QA); bf16* const KA = (bf16*)(ws + WS_KA); bf16* const VA = (bf16*)(ws + WS_VA);
    bf16* const QF = (bf16*)(ws + WS_QF); bf16* const KF = (bf16*)(ws + WS_KF); bf16* const KB = (bf16*)(ws + WS_KB); bf16* const QB = (bf16*)(ws + WS_QB);
    bf16* const IH = (bf16*)(ws + WS_IH); bf16* const GH = (bf16*)(ws + WS_GH); bf16* const GATE = (bf16*)(ws + WS_GATE);
    bf16* const MIX = (bf16*)(ws + WS_MIX); bf16* const X1B = (bf16*)(ws + WS_X1B); bf16* const UB = (bf16*)(ws + WS_UB); float* const PE = (float*)(ws + WS_PE);

    if (IN(0)) { p0_prologue(F, I); if (BOTH(0)) GRID_BAR(); }
    if (IN(1)) {
        pg8::Gemm g{XB, BT1, M, N1, DM}; pg8::StaticOrder S; S.init(M, N1, F.G, (int)blockIdx.x);
        pg8::EpiProj E{QA, KA, VA, QF, KF, KB, IH, GH, GATE, I.b_gate};
        pg8::gemm_phase<pg8::EpiProj, pg8::StaticOrder, true, true>(F.lds, g, S, E);
        if (BOTH(1)) GRID_BAR();
    }
    if (IN(2)) { qk_prep(F, I); h1_pass(F); p2_small_converts(F, I); if (BOTH(2)) GRID_BAR(); }
    if (IN(3)) {
        if (blockIdx.x < 64) { const int u = blockIdx.x, dir = u >> 5, b = (u >> 4) & 1, h = u & 15;
            if (dir == 0) scan_unit<0>(F, QF, KF, IH, QF, (const float*)(ws + WS_RF), (const float*)(ws + WS_WF), b, h);
            else          scan_unit<1>(F, QB, KB, IH, QB, (const float*)(ws + WS_RB), (const float*)(ws + WS_WB), b, h); }
        if (BOTH(3)) GRID_BAR();
    }
    if (IN(4)) {
        for (int u = F.vcu; u < 1024; u += F.G) { const int gI = u >> 7, r = u & 127, b = gI >> 2, kvh = gI & 3, qh = kvh * 4 + (r >> 5), qb = r & 31;
            const size_t qoff = (size_t)(b * SEQ + qb * 256) * 2048 + qh * 128, koff = (size_t)(b * SEQ) * 512 + kvh * 128;
            attn::attn_dense_body(QA + qoff, KA + koff, VA + koff, QA + qoff, SEQ, (char*)lds); }
        if (BOTH(4)) GRID_BAR();
    }
    if (IN(5)) { combine_pass(F, I); if (BOTH(5)) GRID_BAR(); }
    if (IN(6)) {
        pg8::Gemm g{QA, (bf16*)(ws + WS_WPA), M, DM, ATTN_DIM}; pg8::StaticOrder S; S.init(M, DM, F.G, (int)blockIdx.x);
        pg8::EpiGateMulF32 E{F.out, DM, GATE, 2 * DM, 0};
        pg8::gemm_phase<pg8::EpiGateMulF32, pg8::StaticOrder, true, true>(F.lds, g, S, E);
        if (BOTH(6)) GRID_BAR();
    }
    if (IN(7)) {
        pg8::Gemm g{QF, (bf16*)(ws + WS_WPB), M, DM, HQK}; pg8::StaticOrder S; S.init(M, DM, F.G, (int)blockIdx.x);
        pg8::EpiGateAddBf16 E{MIX, F.out, DM, GATE, 2 * DM, DM};
        pg8::gemm_phase<pg8::EpiGateAddBf16, pg8::StaticOrder, true, true>(F.lds, g, S, E);
        if (BOTH(7)) GRID_BAR();
    }
    if (IN(8)) {
        pg8::Gemm g{MIX, (bf16*)(ws + WS_WO), M, DM, DM}; pg8::StaticOrder S; S.init(M, DM, F.G, (int)blockIdx.x);
        pg8::EpiAxpyF32 E{I.x, F.out, DM, DN_ALPHA};
        pg8::gemm_phase<pg8::EpiAxpyF32, pg8::StaticOrder, true, true>(F.lds, g, S, E);
        if (BOTH(8)) GRID_BAR();
    }
    if (IN(9)) { ln_pass(F, F.out, X1B, I.ln1_g, I.ln1_b); if (BOTH(9)) GRID_BAR(); }
    if (IN(10)) {
        pg8::Gemm g{X1B, (bf16*)(ws + WS_WUP), M, 2 * DFF, DM}; pg8::StaticOrder S; S.init(M, 2 * DFF, F.G, (int)blockIdx.x);
        pg8::EpiBf16 E{UB, DFF, DFF, (size_t)M * DFF};
        pg8::gemm_phase<pg8::EpiBf16, pg8::StaticOrder, true, true>(F.lds, g, S, E);
        if (BOTH(10)) GRID_BAR();
    }
    if (IN(11)) { conv_pass(F, I); if (BOTH(11)) GRID_BAR(); }
    if (IN(12)) {
        pg8::Gemm g{UB, (bf16*)(ws + WS_WDN), M, DM, DFF}; pg8::StaticOrder S; S.init(M, DM, F.G, (int)blockIdx.x);
        pg8::EpiAxpyF32 E{F.out, F.out, DM, DN_ALPHA};
        pg8::gemm_phase<pg8::EpiAxpyF32, pg8::StaticOrder, true, true>(F.lds, g, S, E);
        if (BOTH(12)) GRID_BAR();
    }
    if (IN(13)) { ln_pass(F, F.out, X1B, I.ln2_g, I.ln2_b); if (BOTH(13)) GRID_BAR(); }
    if (IN(14)) {
        pg8::Gemm g{(bf16*)(ws + WS_PB), (bf16*)(ws + WS_WPLE), M, DM, PLE}; pg8::StaticOrder S; S.init(M, DM, F.G, (int)blockIdx.x);
        pg8::EpiGateMulF32 E{PE, DM, nullptr, 0, 0};
        pg8::gemm_phase<pg8::EpiGateMulF32, pg8::StaticOrder, true, true>(F.lds, g, S, E);
        if (BOTH(14)) GRID_BAR();
    }
    if (IN(15)) {
        pg8::Gemm g{X1B, (bf16*)(ws + WS_WPG), M, DM, DM}; pg8::StaticOrder S; S.init(M, DM, F.G, (int)blockIdx.x);
        pg8::EpiFinal E{F.out, PE, DM};
        pg8::gemm_phase<pg8::EpiFinal, pg8::StaticOrder, true, true>(F.lds, g, S, E);
    }
#undef IN
#undef BOTH
#undef GRID_BAR
}

extern "C" void kernel_launch(void* const* d_in, const int* in_sizes, int n_in, void* d_out, int out_size, void* d_ws, size_t ws_size, hipStream_t stream) {
    static int grid = 0;
    if (grid == 0) {
        if (n_in != 22 || in_sizes[0] != M * DM || out_size != M * DM || ws_size < WS_END) { fprintf(stderr, "kernel_launch: shape mismatch n_in %d in0 %d out %d ws %zu (need %zu)\n", n_in, n_in > 0 ? in_sizes[0] : -1, out_size, ws_size, (size_t)WS_END); grid = -1; return; }
        int dev = 0, cus = 0, per_cu = 0;
        if (hipGetDevice(&dev) != hipSuccess || hipDeviceGetAttribute(&cus, hipDeviceAttributeMultiprocessorCount, dev) != hipSuccess) { grid = -1; return; }
        if (hipFuncSetAttribute((const void*)mk_fwd, hipFuncAttributeMaxDynamicSharedMemorySize, LDS_BYTES) != hipSuccess) { fprintf(stderr, "kernel_launch: hipFuncSetAttribute failed\n"); grid = -1; return; }
        if (hipOccupancyMaxActiveBlocksPerMultiprocessor(&per_cu, (const void*)mk_fwd, NWAVES * 64, LDS_BYTES) != hipSuccess || per_cu < 1) fprintf(stderr, "kernel_launch: occupancy query says %d\n", per_cu);
        (void)hipGetLastError();
        grid = cus;
        if (grid != 256) { fprintf(stderr, "kernel_launch: expected 256 CUs, got %d\n", grid); }
    }
    if (grid < 0) return;
    (void)hipMemsetAsync((char*)d_ws + WS_CTL, 0, CTL_ZERO_BYTES, stream);
    Args a{};
    const float** ip = (const float**)&a.in;
    for (int i = 0; i < 22; ++i) ip[i] = (const float*)d_in[i];
    a.out = (float*)d_out; a.ws = (unsigned char*)d_ws; a.pad = 0;
    if (N_LAUNCHES == 1) { a.ph_lo = 0; a.ph_hi = N_PHASES; a.li = 0; hipLaunchKernelGGL(mk_fwd, dim3(grid), dim3(NWAVES * 64), LDS_BYTES, stream, a); }
    else for (int li = 0; li < N_PHASES; ++li) { a.ph_lo = li; a.ph_hi = li + 1; a.li = li; hipLaunchKernelGGL(mk_fwd, dim3(grid), dim3(NWAVES * 64), LDS_BYTES, stream, a); }
    const hipError_t le = hipPeekAtLastError();
    if (le != hipSuccess) fprintf(stderr, "kernel_launch: launch failed: %s\n", hipGetErrorName(le));
}
```

```cpp
#include <hip/hip_runtime.h>
#include <cstdio>
#include <cstdint>
namespace pg8 {
#define PG8_LAS __attribute__((address_space(3)))
typedef unsigned short bf16_t;
typedef short bf16x8 __attribute__((ext_vector_type(8)));
typedef float f32x4 __attribute__((ext_vector_type(4)));
typedef unsigned u32x4 __attribute__((ext_vector_type(4)));
constexpr int BM = 256, BK = 64, HALF = 128, HTB = HALF * BK * 2  , STAGE_BYTES = 8 * HTB, NXCD = 8, WGM = 8;

__host__ __device__ __forceinline__ int lds_byte(int r, int c) { const int st = (r >> 4) * 2 + (c >> 5), rr = r & 15, cc = c & 31, ob = rr * 64 + cc * 2; return st * 1024 + (ob ^ (((ob >> 9) & 1) << 5)); }
__host__ __device__ __forceinline__ void stage_rc(int b, int& R, int& C) { const int st = b / 1024, sb = b % 1024, swz = sb ^ (((sb >> 9) & 1) << 5); R = (st >> 1) * 16 + swz / 64; C = (st & 1) * 32 + (swz % 64) / 2; }
__host__ __device__ __forceinline__ int perm32(int rho) { const int n = rho >> 4, i = rho & 15; return 8 * (i >> 2) + 4 * n + (i & 3); }

struct Unit { int pm, pn; };
struct Gemm { const bf16_t* A; const bf16_t* Bt; int M, N, K; };

struct StaticOrder {
    int nM, nN, nwg, G, c;
    __host__ __device__ void init(int M, int N, int G_, int c_) { nM = M / BM; nN = N / BM; nwg = nM * nN; G = G_; c = c_; }
    __host__ __device__ bool next(int i, Unit& u) const {
        const long L = (long)i * G + c; if (L >= nwg) return false;
        int wgid = (int)L; { const int q = nwg / NXCD, r = nwg % NXCD, xcd = wgid % NXCD, off = wgid / NXCD; wgid = (xcd < r ? xcd * (q + 1) : r * (q + 1) + (xcd - r) * q) + off; }
        const int nig = WGM * nN, gid = wgid / nig, fm = gid * WGM, gsz = (nM - fm) < WGM ? (nM - fm) : WGM;
        u.pm = fm + ((wgid % nig) % gsz); u.pn = (wgid % nig) / gsz; return true;
    }
    __device__ __forceinline__ void a_ready(const Unit&) const {}
    __device__ __forceinline__ void done(const Unit&) const {}
};

struct SplitOrder {
    int c;
    __host__ __device__ bool next(int i, Unit& u) const {
        int L;
        if (c < 64) { if (i >= 5) return false; L = 768 + i * 256 + c; }
        else { if (i >= 9) return false; L = (i < 4) ? i * 192 + (c - 64) : 768 + (i - 4) * 256 + c; }
        const int wgid = (L % NXCD) * 256 + L / NXCD;
        const int gid = wgid / 256, fm = gid * WGM, rem = wgid % 256;
        u.pm = fm + rem % WGM; u.pn = rem / WGM; return true;
    }
    __device__ __forceinline__ void a_ready(const Unit&) const {}
    __device__ __forceinline__ void done(const Unit&) const {}
};
__device__ __forceinline__ unsigned cvt_pk_bf16(float lo, float hi) { unsigned r; asm volatile("v_cvt_pk_bf16_f32 %0, %1, %2" : "=v"(r) : "v"(lo), "v"(hi)); return r; }
typedef unsigned u32x2 __attribute__((ext_vector_type(2)));
__device__ __forceinline__ float bf_lo(unsigned w) { return __uint_as_float(w << 16); }
__device__ __forceinline__ float bf_hi(unsigned w) { return __uint_as_float(w & 0xffff0000u); }
__device__ __forceinline__ float sigmoid_f(float v) { return __builtin_amdgcn_rcpf(1.0f + __expf(-v)); }

struct EpiBf16 {
    static constexpr bool PERM = true, AFTER_DRAIN = false;
    bf16_t* O; int ldc; int split_cols; size_t split_stride;
    __device__ __forceinline__ void operator()(const f32x4 (&acc)[2][2][4][2], const Unit& u, int wr, int wc, int fr, int fq) const {
        const int row0 = u.pm * BM + wr * 64 + fr; int colt = u.pn * BM; bf16_t* base = O;
        if (split_cols) { const int t = colt / split_cols; base += (size_t)t * split_stride; colt -= t * split_cols; }
        const int col0 = colt + wc * 32 + 8 * fq;
#pragma unroll
        for (int ai = 0; ai < 2; ++ai)
#pragma unroll
            for (int m = 0; m < 4; ++m) { bf16_t* rowp = base + (size_t)(row0 + ai * HALF + m * 16) * ldc + col0;
#pragma unroll
                for (int bj = 0; bj < 2; ++bj) { const f32x4 v0 = acc[ai][bj][m][0], v1 = acc[ai][bj][m][1];
                    u32x4 w; w.x = cvt_pk_bf16(v0[0], v0[1]); w.y = cvt_pk_bf16(v0[2], v0[3]); w.z = cvt_pk_bf16(v1[0], v1[1]); w.w = cvt_pk_bf16(v1[2], v1[3]);
                    *(u32x4*)(rowp + bj * HALF) = w; } }
    }
};
struct EpiProj {
    static constexpr bool PERM = true, AFTER_DRAIN = false;
    bf16_t *QA, *KA, *VA, *QH, *ZF, *ZB, *IH, *GH, *GATE; const float* bgate; int col_base;
    __device__ __forceinline__ void operator()(const f32x4 (&acc)[2][2][4][2], const Unit& u, int wr, int wc, int fr, int fq) const {
        const int row0 = u.pm * BM + wr * 64 + fr; int colt = u.pn * BM + col_base; bf16_t* base; int ldc = 2048; int act = 0; const float* bias = nullptr;
        if (colt < 2048) { base = QA; }
        else if (colt < 2560) { base = KA; ldc = 512; colt -= 2048; }
        else if (colt < 3072) { base = VA; ldc = 512; colt -= 2560; }
        else if (colt < 5120) { base = QH; colt -= 3072; act = 1; }
        else if (colt < 7168) { base = ZF; colt -= 5120; }
        else if (colt < 9216) { base = ZB; colt -= 7168; }
        else if (colt < 11264) { base = IH; colt -= 9216; }
        else if (colt < 13312) { base = GH; colt -= 11264; act = 1; }
        else { base = GATE; ldc = 8192; colt -= 13312; act = 2; bias = bgate; }
        const int col0 = colt + wc * 32 + 8 * fq;
        f32x4 bv[2][2];
#pragma unroll
        for (int bj = 0; bj < 2; ++bj)
#pragma unroll
            for (int n = 0; n < 2; ++n) bv[bj][n] = bias ? *(const f32x4*)(bias + col0 + bj * HALF + 4 * n) : (f32x4){0.f, 0.f, 0.f, 0.f};
#pragma unroll
        for (int ai = 0; ai < 2; ++ai)
#pragma unroll
            for (int m = 0; m < 4; ++m) { bf16_t* rowp = base + (size_t)(row0 + ai * HALF + m * 16) * ldc + col0;
#pragma unroll
                for (int bj = 0; bj < 2; ++bj) { f32x4 v0 = acc[ai][bj][m][0] + bv[bj][0], v1 = acc[ai][bj][m][1] + bv[bj][1];
                    if (act != 0) {
#pragma unroll
                        for (int j = 0; j < 4; ++j) { const float s0 = sigmoid_f(v0[j]), s1 = sigmoid_f(v1[j]); v0[j] = (act == 1) ? v0[j] * s0 : s0; v1[j] = (act == 1) ? v1[j] * s1 : s1; } }
                    u32x4 w; w.x = cvt_pk_bf16(v0[0], v0[1]); w.y = cvt_pk_bf16(v0[2], v0[3]); w.z = cvt_pk_bf16(v1[0], v1[1]); w.w = cvt_pk_bf16(v1[2], v1[3]);
                    *(u32x4*)(rowp + bj * HALF) = w; } }
    }
};
struct EpiGateMulF32 {
    static constexpr bool PERM = false, AFTER_DRAIN = false;
    float* out; int ldc; const bf16_t* gate; int ldg; int goff;
    __device__ __forceinline__ void operator()(const f32x4 (&acc)[2][2][4][2], const Unit& u, int wr, int wc, int fr, int fq) const {
        const int row0 = u.pm * BM + wr * 64 + fr, col0 = u.pn * BM + wc * 32 + 4 * fq;
#pragma unroll
        for (int ai = 0; ai < 2; ++ai)
#pragma unroll
            for (int m = 0; m < 4; ++m) { const int row = row0 + ai * HALF + m * 16; float* rowp = out + (size_t)row * ldc + col0;
#pragma unroll
                for (int bj = 0; bj < 2; ++bj)
#pragma unroll
                    for (int n = 0; n < 2; ++n) { f32x4 v = acc[ai][bj][m][n];
                        if (gate) { const u32x2 gw = *(const u32x2*)(gate + (size_t)row * ldg + goff + col0 + bj * HALF + n * 16);
                            v = v * (f32x4){bf_lo(gw.x), bf_hi(gw.x), bf_lo(gw.y), bf_hi(gw.y)}; }
                        *(f32x4*)(rowp + bj * HALF + n * 16) = v; } }
    }
};
struct EpiGateMulBf16 {
    static constexpr bool PERM = true, AFTER_DRAIN = false;
    bf16_t* O; int ldc; const bf16_t* gate; int ldg; int goff;
    __device__ __forceinline__ void operator()(const f32x4 (&acc)[2][2][4][2], const Unit& u, int wr, int wc, int fr, int fq) const {
        const int row0 = u.pm * BM + wr * 64 + fr, col0 = u.pn * BM + wc * 32 + 8 * fq;
#pragma unroll
        for (int ai = 0; ai < 2; ++ai)
#pragma unroll
            for (int m = 0; m < 4; ++m) { const int row = row0 + ai * HALF + m * 16;
#pragma unroll
                for (int bj = 0; bj < 2; ++bj) { const size_t off = (size_t)row * ldc + col0 + bj * HALF;
                    const u32x4 gw = *(const u32x4*)(gate + (size_t)row * ldg + goff + col0 + bj * HALF);
                    const f32x4 v0 = acc[ai][bj][m][0] * (f32x4){bf_lo(gw.x), bf_hi(gw.x), bf_lo(gw.y), bf_hi(gw.y)};
                    const f32x4 v1 = acc[ai][bj][m][1] * (f32x4){bf_lo(gw.z), bf_hi(gw.z), bf_lo(gw.w), bf_hi(gw.w)};
                    u32x4 w; w.x = cvt_pk_bf16(v0[0], v0[1]); w.y = cvt_pk_bf16(v0[2], v0[3]); w.z = cvt_pk_bf16(v1[0], v1[1]); w.w = cvt_pk_bf16(v1[2], v1[3]);
                    *(u32x4*)(O + off) = w; } }
    }
};
struct EpiGateAddBf16 {
    static constexpr bool PERM = true, AFTER_DRAIN = false;
    bf16_t* O; const bf16_t* T; int ldc; const bf16_t* gate; int ldg; int goff;
    __device__ __forceinline__ void operator()(const f32x4 (&acc)[2][2][4][2], const Unit& u, int wr, int wc, int fr, int fq) const {
        const int row0 = u.pm * BM + wr * 64 + fr, col0 = u.pn * BM + wc * 32 + 8 * fq;
#pragma unroll
        for (int ai = 0; ai < 2; ++ai)
#pragma unroll
            for (int m = 0; m < 4; ++m) { const int row = row0 + ai * HALF + m * 16;
#pragma unroll
                for (int bj = 0; bj < 2; ++bj) { const size_t off = (size_t)row * ldc + col0 + bj * HALF;
                    const u32x4 gw = *(const u32x4*)(gate + (size_t)row * ldg + goff + col0 + bj * HALF);
                    const u32x4 tw = *(const u32x4*)(T + off);
                    const f32x4 t0 = (f32x4){bf_lo(tw.x), bf_hi(tw.x), bf_lo(tw.y), bf_hi(tw.y)}, t1 = (f32x4){bf_lo(tw.z), bf_hi(tw.z), bf_lo(tw.w), bf_hi(tw.w)};
                    const f32x4 v0 = t0 + acc[ai][bj][m][0] * (f32x4){bf_lo(gw.x), bf_hi(gw.x), bf_lo(gw.y), bf_hi(gw.y)};
                    const f32x4 v1 = t1 + acc[ai][bj][m][1] * (f32x4){bf_lo(gw.z), bf_hi(gw.z), bf_lo(gw.w), bf_hi(gw.w)};
                    u32x4 w; w.x = cvt_pk_bf16(v0[0], v0[1]); w.y = cvt_pk_bf16(v0[2], v0[3]); w.z = cvt_pk_bf16(v1[0], v1[1]); w.w = cvt_pk_bf16(v1[2], v1[3]);
                    *(u32x4*)(O + off) = w; } }
    }
};
struct EpiAxpyF32 {
    static constexpr bool PERM = false, AFTER_DRAIN = false;
    const float* base; float* out; int ldc; float alpha;
    __device__ __forceinline__ void operator()(const f32x4 (&acc)[2][2][4][2], const Unit& u, int wr, int wc, int fr, int fq) const {
        const int row0 = u.pm * BM + wr * 64 + fr, col0 = u.pn * BM + wc * 32 + 4 * fq;
#pragma unroll
        for (int ai = 0; ai < 2; ++ai)
#pragma unroll
            for (int m = 0; m < 4; ++m) { const size_t off = (size_t)(row0 + ai * HALF + m * 16) * ldc + col0;
#pragma unroll
                for (int bj = 0; bj < 2; ++bj)
#pragma unroll
                    for (int n = 0; n < 2; ++n) { const f32x4 bs = *(const f32x4*)(base + off + bj * HALF + n * 16);
                        *(f32x4*)(out + off + bj * HALF + n * 16) = bs * alpha + acc[ai][bj][m][n]; }
                asm volatile("" ::: "memory"); }
    }
};
struct EpiFinal {
    static constexpr bool PERM = false, AFTER_DRAIN = false;
    float* out; const float* pe; int ldc;
    __device__ __forceinline__ void operator()(const f32x4 (&acc)[2][2][4][2], const Unit& u, int wr, int wc, int fr, int fq) const {
        const int row0 = u.pm * BM + wr * 64 + fr, col0 = u.pn * BM + wc * 32 + 4 * fq;
#pragma unroll
        for (int ai = 0; ai < 2; ++ai)
#pragma unroll
            for (int m = 0; m < 4; ++m) { const size_t off = (size_t)(row0 + ai * HALF + m * 16) * ldc + col0;
#pragma unroll
                for (int bj = 0; bj < 2; ++bj)
#pragma unroll
                    for (int n = 0; n < 2; ++n) { const f32x4 xs = *(const f32x4*)(out + off + bj * HALF + n * 16), pv = *(const f32x4*)(pe + off + bj * HALF + n * 16);
                        const f32x4 a = acc[ai][bj][m][n]; f32x4 o;
#pragma unroll
                        for (int j = 0; j < 4; ++j) o[j] = xs[j] + sigmoid_f(a[j]) * pv[j];
                        *(f32x4*)(out + off + bj * HALF + n * 16) = o; }
                asm volatile("" ::: "memory"); }
    }
};
template <class Epi, class Sched, bool ALIGN_EPI = false, bool SP2 = false>
__device__ __forceinline__ void gemm_phase(PG8_LAS unsigned char* lds, const Gemm g, const Sched& S, const Epi& E) {
    const int tid = threadIdx.x, wid = __builtin_amdgcn_readfirstlane(tid >> 6), lane = tid & 63, wr = wid >> 2, wc = wid & 3, fr = lane & 15, fq = lane >> 4;
    const int K = g.K, nt = K / BK;
    unsigned voffA[2], voffB[2];
#pragma unroll
    for (int i = 0; i < 2; ++i) { int R, C; stage_rc(tid * 16 + i * 8192, R, C); const int Rb = Epi::PERM ? ((R & ~31) + perm32(R & 31)) : R;
        voffA[i] = (unsigned)(R * K + C) * 2u; voffB[i] = (unsigned)(Rb * K + C) * 2u; }
    const size_t kstep = (size_t)(BK * 2);
    const size_t hstep = (size_t)HALF * K * 2;
    const size_t tstep = 2 * hstep;
    const unsigned ldsw = (unsigned)wid * 1024u;
    const int aoff = lds_byte(wr * 64 + fr, fq * 8), boff = lds_byte(wc * 32 + fr, fq * 8);
#define PG8_SA(b, h) (((b) * 2 + (h)) * HTB)
#define PG8_SB(b, h) ((4 + (b) * 2 + (h)) * HTB)
#define PG8_STAGE(bufoff, gbase, voff) do { _Pragma("unroll") for (int _i = 0; _i < 2; ++_i) \
        __builtin_amdgcn_global_load_lds((const unsigned*)((const char*)(gbase) + (voff)[_i]), (PG8_LAS unsigned*)(lds + (bufoff) + ldsw + _i * 8192), 16, 0, 0); } while (0)
#define PG8_LDA(dst, b, h) do { _Pragma("unroll") for (int m = 0; m < 4; ++m) _Pragma("unroll") for (int k = 0; k < 2; ++k) dst[m][k] = *(const PG8_LAS bf16x8*)(lds + PG8_SA(b, h) + aoff + m * 2048 + k * 1024); } while (0)
#define PG8_LDB(dst, b, h) do { _Pragma("unroll") for (int n = 0; n < 2; ++n) _Pragma("unroll") for (int k = 0; k < 2; ++k) dst[n][k] = *(const PG8_LAS bf16x8*)(lds + PG8_SB(b, h) + boff + n * 2048 + k * 1024); } while (0)
#define PG8_MMA(ai, bj, At, Bt) do { __builtin_amdgcn_s_setprio(1); _Pragma("unroll") for (int m = 0; m < 4; ++m) _Pragma("unroll") for (int n = 0; n < 2; ++n) _Pragma("unroll") for (int k = 0; k < 2; ++k) \
        acc[ai][bj][m][n] = __builtin_amdgcn_mfma_f32_16x16x32_bf16(Bt[n][k], At[m][k], acc[ai][bj][m][n], 0, 0, 0); __builtin_amdgcn_s_setprio(0); } while (0)
#define PG8_WAIT_V(n) asm volatile("s_waitcnt vmcnt(" #n ")" ::: "memory")
#define PG8_WAIT_L(n) asm volatile("s_waitcnt lgkmcnt(" #n ")" ::: "memory")
#define PG8_BAR __builtin_amdgcn_s_barrier()
#define PG8_SCHED __builtin_amdgcn_sched_barrier(0)
    Unit cur, nxt; int ui = 0;
    if (!S.next(0, cur)) return;
    f32x4 acc[2][2][4][2];
#pragma unroll
    for (int a = 0; a < 2; ++a)
#pragma unroll
        for (int b = 0; b < 2; ++b)
#pragma unroll
            for (int m = 0; m < 4; ++m)
#pragma unroll
                for (int n = 0; n < 2; ++n) acc[a][b][m][n] = (f32x4){0.f, 0.f, 0.f, 0.f};
    bf16x8 At[4][2], B0[2][2], B1[2][2];
    const char* cA = (const char*)g.A + (size_t)cur.pm * tstep; const char* cB = (const char*)g.Bt + (size_t)cur.pn * tstep;
    S.a_ready(cur);
    if constexpr (SP2) {
        PG8_STAGE(PG8_SB(0, 0), cB, voffB); PG8_STAGE(PG8_SB(0, 1), cB + hstep, voffB); PG8_STAGE(PG8_SA(0, 0), cA, voffA); PG8_STAGE(PG8_SA(0, 1), cA + hstep, voffA);
        if (wr == 1) PG8_BAR;
        PG8_WAIT_V(2); PG8_BAR;
        PG8_STAGE(PG8_SB(1, 0), cB + kstep, voffB); PG8_STAGE(PG8_SA(1, 0), cA + kstep, voffA); PG8_STAGE(PG8_SB(1, 1), cB + hstep + kstep, voffB);
        PG8_WAIT_V(6); PG8_BAR;
    } else {
        PG8_STAGE(PG8_SB(0, 0), cB, voffB); PG8_STAGE(PG8_SA(0, 0), cA, voffA); PG8_STAGE(PG8_SB(0, 1), cB + hstep, voffB); PG8_STAGE(PG8_SA(0, 1), cA + hstep, voffA);
        if (wr == 1) PG8_BAR;
        PG8_WAIT_V(4); PG8_BAR;
        PG8_STAGE(PG8_SB(1, 0), cB + kstep, voffB); PG8_STAGE(PG8_SA(1, 0), cA + kstep, voffA); PG8_STAGE(PG8_SB(1, 1), cB + hstep + kstep, voffB);
        PG8_WAIT_V(6); PG8_BAR;
    }
    for (;;) {
        const bool has_next = S.next(ui + 1, nxt);
        const char* nA = has_next ? (const char*)g.A + (size_t)nxt.pm * tstep : cA; const char* nB = has_next ? (const char*)g.Bt + (size_t)nxt.pn * tstep : cB;
        for (int t = 0; t < nt; t += 2) {
            const bool last = (t == nt - 2);
            const char* a1 = cA + (size_t)(t + 1) * kstep;
            const char* a2 = last ? nA : cA + (size_t)(t + 2) * kstep; const char* b2 = last ? nB : cB + (size_t)(t + 2) * kstep;
            const char* a3 = a2 + kstep; const char* b3 = b2 + kstep;
            if (last && has_next) S.a_ready(nxt);
            if constexpr (SP2) {
            PG8_LDB(B0, 0, 0); PG8_LDB(B1, 0, 1); PG8_SCHED; PG8_LDA(At, 0, 0); PG8_STAGE(PG8_SA(1, 1), a1 + hstep, voffA);
            PG8_WAIT_V(8); PG8_WAIT_L(0); PG8_BAR; PG8_MMA(0, 0, At, B0); PG8_MMA(0, 1, At, B1); PG8_BAR; PG8_SCHED;
            PG8_LDA(At, 0, 1); PG8_STAGE(PG8_SB(0, 0), b2, voffB); PG8_STAGE(PG8_SB(0, 1), b2 + hstep, voffB); PG8_STAGE(PG8_SA(0, 0), a2, voffA);
            PG8_WAIT_V(8); PG8_WAIT_L(0); PG8_BAR; PG8_MMA(1, 0, At, B0); PG8_MMA(1, 1, At, B1); PG8_BAR; PG8_SCHED;
            PG8_LDB(B0, 1, 0); PG8_LDB(B1, 1, 1); PG8_SCHED; PG8_LDA(At, 1, 0); PG8_STAGE(PG8_SA(0, 1), a2 + hstep, voffA);
            PG8_WAIT_V(8); PG8_WAIT_L(0); PG8_BAR; PG8_MMA(0, 0, At, B0); PG8_MMA(0, 1, At, B1); PG8_BAR; PG8_SCHED;
            PG8_LDA(At, 1, 1); PG8_STAGE(PG8_SB(1, 0), b3, voffB); PG8_STAGE(PG8_SB(1, 1), b3 + hstep, voffB); PG8_STAGE(PG8_SA(1, 0), a3, voffA);
            PG8_WAIT_V(8); PG8_WAIT_L(0); PG8_BAR; PG8_MMA(1, 0, At, B0); PG8_MMA(1, 1, At, B1); PG8_BAR; PG8_SCHED;
            } else {
            PG8_LDB(B0, 0, 0); PG8_SCHED; PG8_LDA(At, 0, 0); PG8_STAGE(PG8_SA(1, 1), a1 + hstep, voffA);
            PG8_WAIT_L(8); PG8_BAR; PG8_WAIT_L(0); PG8_MMA(0, 0, At, B0); PG8_BAR; PG8_SCHED;
            PG8_LDB(B1, 0, 1); PG8_STAGE(PG8_SB(0, 0), b2, voffB);
            PG8_BAR; PG8_WAIT_L(0); PG8_MMA(0, 1, At, B1); PG8_BAR;
            PG8_LDA(At, 0, 1); PG8_STAGE(PG8_SA(0, 0), a2, voffA);
            PG8_BAR; PG8_WAIT_L(0); PG8_MMA(1, 0, At, B0); PG8_BAR; PG8_SCHED;
            PG8_STAGE(PG8_SB(0, 1), b2 + hstep, voffB);
            PG8_WAIT_V(6); PG8_BAR; PG8_MMA(1, 1, At, B1); PG8_BAR;
            PG8_LDB(B0, 1, 0); PG8_SCHED; PG8_LDA(At, 1, 0); PG8_STAGE(PG8_SA(0, 1), a2 + hstep, voffA);
            PG8_WAIT_L(8); PG8_BAR; PG8_WAIT_L(0); PG8_MMA(0, 0, At, B0); PG8_BAR; PG8_SCHED;
            PG8_LDB(B1, 1, 1); PG8_STAGE(PG8_SB(1, 0), b3, voffB);
            PG8_BAR; PG8_WAIT_L(0); PG8_MMA(0, 1, At, B1); PG8_BAR;
            PG8_LDA(At, 1, 1); PG8_STAGE(PG8_SA(1, 0), a3, voffA);
            PG8_BAR; PG8_WAIT_L(0); PG8_MMA(1, 0, At, B0); PG8_BAR; PG8_SCHED;
            PG8_STAGE(PG8_SB(1, 1), b3 + hstep, voffB);
            PG8_WAIT_V(6); PG8_BAR; PG8_MMA(1, 1, At, B1); PG8_BAR;
            }
        }
        if constexpr (ALIGN_EPI) { if (wr == 0) PG8_BAR; }
        if constexpr (!Epi::AFTER_DRAIN) { E(acc, cur, wr, wc, fr, fq); S.done(cur); }
        if (!has_next) break;
#pragma unroll
        for (int a = 0; a < 2; ++a)
#pragma unroll
            for (int b = 0; b < 2; ++b)
#pragma unroll
                for (int m = 0; m < 4; ++m)
#pragma unroll
                    for (int n = 0; n < 2; ++n) acc[a][b][m][n] = (f32x4){0.f, 0.f, 0.f, 0.f};
        cur = nxt; cA = nA; cB = nB; ++ui;
        if constexpr (ALIGN_EPI) { if (wr == 1) PG8_BAR; }
    }
    PG8_WAIT_V(0);
    if constexpr (!ALIGN_EPI) { if (wr == 0) PG8_BAR; }
    PG8_BAR;
    if constexpr (Epi::AFTER_DRAIN) { E.fused(acc, cur, wr, wc, fr, fq, lds, wid, lane); S.done(cur); }
#undef PG8_SA
#undef PG8_SB
#undef PG8_STAGE
#undef PG8_LDA
#undef PG8_LDB
#undef PG8_MMA
#undef PG8_WAIT_V
#undef PG8_WAIT_L
#undef PG8_BAR
#undef PG8_SCHED
}
}
namespace attn {
typedef unsigned short bf16;
using bf16x8 = __attribute__((ext_vector_type(8))) short;
using s16x4  = __attribute__((ext_vector_type(4))) short;
using f32x16 = __attribute__((ext_vector_type(16))) float;
using u32x4  = __attribute__((ext_vector_type(4))) unsigned;
constexpr int   D = 128, NW = 8, QBLK = 32, KVBLK = 64;
constexpr float SCALE = 0.088388347648318440f;
constexpr float THR = 8.f;
constexpr int LDQ = 2048, LDK = 512, LDO = 2048;
constexpr size_t SHM_V = KVBLK * D * 2, SHM_K = KVBLK * D * 2, SHM_ATTN = 2 * SHM_V + 2 * SHM_K + NW * 64 * 4;
#define KSWZ(row, colB) ((row) * 256 + ((colB) ^ (((row) & 7) << 4)))
#define SBAR() __builtin_amdgcn_sched_barrier(0)
__device__ __forceinline__ int crow(int r, int hi) { return (r & 3) + 8 * (r >> 2) + 4 * hi; }
__device__ __forceinline__ unsigned cvtpk(float lo, float hi) { unsigned r; asm volatile("v_cvt_pk_bf16_f32 %0, %1, %2" : "=v"(r) : "v"(lo), "v"(hi)); return r; }
__device__ __forceinline__ void partialSM(f32x16& p0, f32x16& p1, float& m_reg, float& mn, float& alpha) {
  constexpr float C = SCALE * 1.4426950408889634f;
  float pmax = p0[0]; for (int r = 1; r < 16; ++r) pmax = fmaxf(pmax, p0[r]); for (int r = 0; r < 16; ++r) pmax = fmaxf(pmax, p1[r]);
  { auto rr = __builtin_amdgcn_permlane32_swap(__float_as_uint(pmax), __float_as_uint(pmax), false, false);
    pmax = fmaxf(__uint_as_float(rr[0]), __uint_as_float(rr[1])); }
  if (__builtin_expect(__all(pmax - m_reg <= THR / SCALE), 1)) { mn = m_reg; alpha = 1.f; }
  else { mn = fmaxf(m_reg, pmax); alpha = __builtin_amdgcn_exp2f((m_reg - mn) * C); m_reg = mn; }
  float mnC = -mn * C;
  for (int r = 0; r < 16; ++r) p0[r] = fmaf(p0[r], C, mnC); for (int r = 0; r < 16; ++r) p1[r] = fmaf(p1[r], C, mnC);
  for (int r = 0; r < 16; ++r) p0[r] = __builtin_amdgcn_exp2f(p0[r]);
}
__device__ __forceinline__ void finishSM(f32x16& p0, f32x16& p1, float alpha, float& l_reg, bf16x8& pa0, bf16x8& pa1, bf16x8& pa2, bf16x8& pa3) {
  for (int r = 0; r < 16; ++r) p1[r] = __builtin_amdgcn_exp2f(p1[r]);
  float ps = 0; for (int r = 0; r < 16; ++r) ps += p0[r]; for (int r = 0; r < 16; ++r) ps += p1[r];
  { auto rr = __builtin_amdgcn_permlane32_swap(__float_as_uint(ps), __float_as_uint(ps), false, false);
    ps = __uint_as_float(rr[0]) + __uint_as_float(rr[1]); }
  l_reg = l_reg * alpha + ps;
#define PK4(P, BASE, OUT) do { unsigned a0 = cvtpk(P[BASE + 0], P[BASE + 1]), a1 = cvtpk(P[BASE + 2], P[BASE + 3]);   \
    unsigned b0 = cvtpk(P[BASE + 4], P[BASE + 5]), b1 = cvtpk(P[BASE + 6], P[BASE + 7]);                              \
    auto r0 = __builtin_amdgcn_permlane32_swap(a0, b0, false, false); auto r1 = __builtin_amdgcn_permlane32_swap(a1, b1, false, false); \
    u32x4 w = {r0[0], r1[0], r0[1], r1[1]}; OUT = *reinterpret_cast<bf16x8*>(&w); } while (0)
  PK4(p0, 0, pa0); PK4(p0, 8, pa1); PK4(p1, 0, pa2); PK4(p1, 8, pa3);
#undef PK4
}
__device__ __forceinline__ void qkt(f32x16& p0, f32x16& p1, const bf16* Ks, const bf16x8* qr, int r32, int hi) {
  p0 = f32x16{}; p1 = f32x16{};
  for (int d0 = 0; d0 < 8; ++d0) { int cb = (d0 * 16 + hi * 8) * 2;
    bf16x8 b0 = *reinterpret_cast<const bf16x8*>((const char*)Ks + KSWZ(r32, cb));
    bf16x8 b1 = *reinterpret_cast<const bf16x8*>((const char*)Ks + KSWZ(32 + r32, cb));
    p0 = __builtin_amdgcn_mfma_f32_32x32x16_bf16(b0, qr[d0], p0, 0, 0, 0);
    p1 = __builtin_amdgcn_mfma_f32_32x32x16_bf16(b1, qr[d0], p1, 0, 0, 0); }
}
__device__ __forceinline__ int v_st(int k, int c) { const int kk = (k & ~0xC) | ((k & 4) << 1) | ((k & 8) >> 1); return ((kk >> 3) * 4 + (c >> 5)) * 512 + ((kk & 7) * 32 + (c & 31)) * 2; }
__device__ __forceinline__ int v_rd_base(int lane) { return ((lane & 3) << 3) | (((lane >> 2) & 3) << 6) | (((lane >> 4) & 1) << 5) | (((lane >> 5) & 1) << 8); }
constexpr int v_rd_off(int d0, int ks, int half) { return d0 * 512 + ks * 4096 + half * 2048; }
template <int OFF> __device__ __forceinline__ s16x4 tr_read(int vb) {
  s16x4 r; asm volatile("ds_read_b64_tr_b16 %0, %1 offset:%2" : "=&v"(r) : "v"(vb), "i"(OFF) : "memory"); return r;
}
template <int D0> __device__ __forceinline__ void pv_one(f32x16& od, int vb, bf16x8 pa0, bf16x8 pa1, bf16x8 pa2, bf16x8 pa3) {
  const s16x4 l0 = tr_read<v_rd_off(D0, 0, 0)>(vb), h0 = tr_read<v_rd_off(D0, 0, 1)>(vb), l1 = tr_read<v_rd_off(D0, 1, 0)>(vb), h1 = tr_read<v_rd_off(D0, 1, 1)>(vb);
  const s16x4 l2 = tr_read<v_rd_off(D0, 2, 0)>(vb), h2 = tr_read<v_rd_off(D0, 2, 1)>(vb), l3 = tr_read<v_rd_off(D0, 3, 0)>(vb), h3 = tr_read<v_rd_off(D0, 3, 1)>(vb);
  asm volatile("s_waitcnt lgkmcnt(0)" ::: "memory"); SBAR();
#define PK(L, H) (bf16x8){L[0], L[1], L[2], L[3], H[0], H[1], H[2], H[3]}
  od = __builtin_amdgcn_mfma_f32_32x32x16_bf16(pa0, PK(l0, h0), od, 0, 0, 0);
  od = __builtin_amdgcn_mfma_f32_32x32x16_bf16(pa1, PK(l1, h1), od, 0, 0, 0);
  od = __builtin_amdgcn_mfma_f32_32x32x16_bf16(pa2, PK(l2, h2), od, 0, 0, 0);
  od = __builtin_amdgcn_mfma_f32_32x32x16_bf16(pa3, PK(l3, h3), od, 0, 0, 0);
#undef PK
}
__device__ __forceinline__ void pv_d0(f32x16* o, int vb, bf16x8 pa0, bf16x8 pa1, bf16x8 pa2, bf16x8 pa3) {
  pv_one<0>(o[0], vb, pa0, pa1, pa2, pa3); pv_one<1>(o[1], vb, pa0, pa1, pa2, pa3); pv_one<2>(o[2], vb, pa0, pa1, pa2, pa3); pv_one<3>(o[3], vb, pa0, pa1, pa2, pa3);
}
__device__ __forceinline__ void attn_dense_body(const bf16* Qb, const bf16* __restrict__ Kh, const bf16* __restrict__ Vh, bf16* Ob, int seq, char* lds) {
  const int tid = threadIdx.x, wid = tid >> 6, lane = tid & 63, r32 = lane & 31, hi = lane >> 5;
  bf16* V_lds = (bf16*)lds; bf16* K_lds = (bf16*)(lds + 2 * SHM_V);
  float* ws = (float*)(lds + 2 * SHM_V + 2 * SHM_K) + wid * 64; float* li_l = ws; float* al_l = ws + 32;
  float m_reg = -1e30f, l_reg = 0; f32x16 o[4] = {}; bf16x8 qr[8];
  const bf16* Qw = Qb + (long)(wid * QBLK + r32) * LDQ + hi * 8;
#pragma unroll
  for (int d0 = 0; d0 < 8; ++d0) qr[d0] = *reinterpret_cast<const bf16x8*>(Qw + d0 * 16);
  const int sr = tid >> 4, sc = (tid & 15) * 8, vst0 = v_st(sr, sc), vst1 = v_st(32 + sr, sc);
  const int vb0 = (int)(uintptr_t)V_lds + v_rd_base(lane);
  struct { bf16x8 vs0, vs1, ks0, ks1; } sr_[2];
#define SLOAD(i, k0) do { sr_[i].vs0 = *reinterpret_cast<const bf16x8*>(&Vh[(long)((k0) + sr) * LDK + sc]); sr_[i].vs1 = *reinterpret_cast<const bf16x8*>(&Vh[(long)((k0) + 32 + sr) * LDK + sc]); \
    sr_[i].ks0 = *reinterpret_cast<const bf16x8*>(&Kh[(long)((k0) + sr) * LDK + sc]); sr_[i].ks1 = *reinterpret_cast<const bf16x8*>(&Kh[(long)((k0) + 32 + sr) * LDK + sc]); } while (0)
#define SWRITE(b, i) do { *(bf16x8*)((char*)V_lds + (b) * SHM_V + vst0) = sr_[i].vs0;          \
    *(bf16x8*)((char*)V_lds + (b) * SHM_V + vst1) = sr_[i].vs1; int kc = sc * 2;               \
    *(bf16x8*)((char*)K_lds + (b) * SHM_K + KSWZ(sr, kc)) = sr_[i].ks0;                       \
    *(bf16x8*)((char*)K_lds + (b) * SHM_K + KSWZ(32 + sr, kc)) = sr_[i].ks1; } while (0)
#define SWAIT() asm volatile("s_waitcnt vmcnt(4)" ::: "memory")
#define RESC(a) do { if (__any((a) < 1.f)) { if (hi == 0) al_l[r32] = (a); asm volatile("s_waitcnt lgkmcnt(0)" ::: "memory"); \
    for (int d = 0; d < 4; ++d) for (int r = 0; r < 16; ++r) o[d][r] *= al_l[crow(r, hi)]; } } while (0)
  f32x16 pA0, pA1, pB0, pB1; float mnA, mnB, alA, alB; bf16x8 pa0, pa1, pa2, pa3; const int NT = seq / KVBLK;
  constexpr int SE = 0, SO = 1;
  SLOAD(SE, 0); asm volatile("s_waitcnt vmcnt(0)" ::: "memory"); SWRITE(0, SE); __syncthreads();
  qkt(pA0, pA1, K_lds, qr, r32, hi); partialSM(pA0, pA1, m_reg, mnA, alA);
  SLOAD(SO, KVBLK); if (2 < NT) SLOAD(SE, 2 * KVBLK);
  SWAIT(); SWRITE(1, SO); __syncthreads();
  for (int j = 1; j + 1 < NT; j += 2) {
    SBAR(); qkt(pB0, pB1, (bf16*)((char*)K_lds + SHM_K), qr, r32, hi);
    finishSM(pA0, pA1, alA, l_reg, pa0, pa1, pa2, pa3); SBAR();
    SLOAD(SO, (j + 2) * KVBLK); SBAR();
    pv_d0(o, vb0, pa0, pa1, pa2, pa3); partialSM(pB0, pB1, m_reg, mnB, alB);
    __syncthreads(); SWAIT(); SWRITE(0, SE);
    RESC(alB); __syncthreads();
    SBAR(); qkt(pA0, pA1, K_lds, qr, r32, hi);
    finishSM(pB0, pB1, alB, l_reg, pa0, pa1, pa2, pa3); SBAR();
    if (j + 3 < NT) SLOAD(SE, (j + 3) * KVBLK); SBAR();
    pv_d0(o, vb0 + (int)SHM_V, pa0, pa1, pa2, pa3); partialSM(pA0, pA1, m_reg, mnA, alA);
    __syncthreads(); SWAIT(); SWRITE(1, SO);
    RESC(alA); __syncthreads();
  }
  SBAR(); qkt(pB0, pB1, (bf16*)((char*)K_lds + SHM_K), qr, r32, hi);
  finishSM(pA0, pA1, alA, l_reg, pa0, pa1, pa2, pa3); SBAR();
  pv_d0(o, vb0, pa0, pa1, pa2, pa3); partialSM(pB0, pB1, m_reg, mnB, alB);
  __syncthreads(); RESC(alB);
  finishSM(pB0, pB1, alB, l_reg, pa0, pa1, pa2, pa3); SBAR();
  pv_d0(o, vb0 + (int)SHM_V, pa0, pa1, pa2, pa3);
  if (hi == 0) li_l[r32] = l_reg; asm volatile("s_waitcnt lgkmcnt(0)" ::: "memory");
  float rli[16];
#pragma unroll
  for (int r = 0; r < 16; ++r) rli[r] = __builtin_amdgcn_rcpf(li_l[crow(r, hi)]);
  bf16* Ow = Ob + (long)(wid * QBLK) * LDO;
#pragma unroll
  for (int r = 0; r < 16; ++r) { int orow = crow(r, hi);
    for (int d0 = 0; d0 < 4; ++d0) { const float v = o[d0][r] * rli[r]; Ow[(long)orow * LDO + d0 * 32 + r32] = (bf16)(cvtpk(v, v) & 0xffffu); } }
  __syncthreads();
#undef SLOAD
#undef SWRITE
#undef SWAIT
#undef RESC
}
#undef KSWZ
#undef SBAR
}
constexpr int NWAVES = 8;
#ifndef MK_N_LAUNCHES
#define MK_N_LAUNCHES 1
#endif
constexpr int N_PHASES = 16;
constexpr int N_LAUNCHES = MK_N_LAUNCHES;
constexpr int BATCH = 2, SEQ = 8192, DM = 4096, M = BATCH * SEQ;
constexpr int ATTN_DIM = 2048, KV_DIM = 512, HQK = 2048, DFF = 11008, PLE = 256, NHG = 16, NQH = 16, NKVH = 4;
constexpr int N_IN = 13312, N1 = N_IN + 2 * DM;
constexpr float DN_ALPHA = 1.189207115002721f, LN_EPS = 1e-5f, RMS_EPS = 1e-6f;
constexpr int NCHUNK = M / 64;
constexpr size_t MiB = 1u << 20;
constexpr size_t WS_CTL = 0, CTL_ZERO_BYTES = 1 * MiB;
constexpr size_t WS_TAB = 1 * MiB;
constexpr size_t WS_RF = 2 * MiB, WS_WF = 4 * MiB, WS_RB = 6 * MiB, WS_WB = 8 * MiB;
constexpr size_t WS_BT1 = 10 * MiB;
constexpr size_t WS_WPA = 178 * MiB, WS_WPB = 194 * MiB, WS_WO = 210 * MiB;
constexpr size_t WS_XB = 242 * MiB, WS_MIX = 242 * MiB;
constexpr size_t WS_QA = 370 * MiB, WS_KA = 434 * MiB, WS_VA = 450 * MiB;
constexpr size_t WS_QF = 466 * MiB, WS_KF = 530 * MiB, WS_KB = 594 * MiB, WS_QB = 658 * MiB, WS_IH = 722 * MiB, WS_GH = 786 * MiB;
constexpr size_t WS_GATE = 850 * MiB;
constexpr size_t WS_WUP = 1106 * MiB, WS_WDN = 1278 * MiB, WS_END = 1364 * MiB;
constexpr size_t WS_WPG = 10 * MiB, WS_WPLE = 42 * MiB, WS_PB = 44 * MiB, WS_X1B = 52 * MiB, WS_UB = 180 * MiB, WS_GB = 524 * MiB, WS_PE = 524 * MiB;
static_assert(WS_WDN + (size_t)DM * DFF * 2 <= WS_END && WS_GB + (size_t)M * DFF * 2 <= WS_WUP && WS_X1B + (size_t)M * DM * 2 <= WS_UB, "ws map");
constexpr int CW_TMO = 0, CW_CODE = 1, CW_BAR = 4096;
constexpr int RING_BYTES = 131072, LDSCTL_OFF = RING_BYTES, MISC_OFF = LDSCTL_OFF + 320, LDS_BYTES = 147456;

#define GAS __attribute__((address_space(1)))
#define LAS __attribute__((address_space(3)))
typedef unsigned short bf16;
typedef unsigned v4u __attribute__((ext_vector_type(4)));
typedef unsigned v2u __attribute__((ext_vector_type(2)));
typedef float f32x4 __attribute__((ext_vector_type(4)));
typedef short bf16x8 __attribute__((ext_vector_type(8)));
typedef short s16x4 __attribute__((ext_vector_type(4)));
typedef GAS unsigned gu32;
#define RLX_AGENT __ATOMIC_RELAXED, __HIP_MEMORY_SCOPE_AGENT
#define LDS_WAIT() asm volatile("s_waitcnt lgkmcnt(0)" ::: "memory")
#define VM_WAIT() asm volatile("s_waitcnt vmcnt(0)" ::: "memory")
typedef float f32x2_t __attribute__((ext_vector_type(2))); typedef __bf16 bf16x2_t __attribute__((ext_vector_type(2)));
__device__ __forceinline__ unsigned pk2(float lo, float hi) { f32x2_t v = {lo, hi}; bf16x2_t b = __builtin_convertvector(v, bf16x2_t); return __builtin_bit_cast(unsigned, b); }
__device__ __forceinline__ float bflo(unsigned w) { return __uint_as_float(w << 16); }
__device__ __forceinline__ float bfhi(unsigned w) { return __uint_as_float(w & 0xffff0000u); }
__device__ __forceinline__ float sigm(float v) { return __builtin_amdgcn_rcpf(1.0f + __expf(-v)); }
#define XB_TMO      128
#define XB_XCNT(j)  (256  + 64 * (j))
#define XB_XSUB(j)  (1280 + 64 * (j))
#define XB_XGEN(j)  (2304 + 64 * (j))
#define XB_TOP      3328
#define XB_TOPGEN   3392
#define XCD_BAR_WORDS 3456
#define XB_SPIN_CAP (1u << 18)

__device__ __forceinline__ unsigned xb_ld(unsigned* p)              { return __hip_atomic_load(p, __ATOMIC_RELAXED, __HIP_MEMORY_SCOPE_AGENT); }
__device__ __forceinline__ unsigned xb_add(unsigned* p, unsigned v) { return __hip_atomic_fetch_add(p, v, __ATOMIC_RELAXED, __HIP_MEMORY_SCOPE_AGENT); }
__device__ __forceinline__ unsigned xb_xcc_id() { return (unsigned)__builtin_amdgcn_s_getreg((3 << 11) | 20) & 0xFu; }
#define XB_SPIN(cond, bar) do { unsigned _sp = 0; while (cond) { __builtin_amdgcn_s_sleep(1); \
    if ((++_sp & 255u) == 0u) { if (xb_ld(&(bar)[XB_TMO])) break; if (_sp > XB_SPIN_CAP) { atomicAdd(&(bar)[XB_TMO], 1u); break; } } } } while (0)

struct XcdBarrier {
    unsigned* bar; unsigned x;
    volatile LAS unsigned* st;
};

__device__ __forceinline__ XcdBarrier xcd_barrier_post(unsigned* bar, volatile LAS unsigned* st) {
    XcdBarrier b; b.bar = bar; b.x = xb_xcc_id(); b.st = st;
    if (threadIdx.x == 0) (void)xb_add(&bar[XB_XCNT(b.x)], 1u);
    return b;
}
__device__ __forceinline__ void xcd_barrier_complete(unsigned* bar, unsigned x, unsigned& nloc, unsigned& nx) {
    const unsigned G = gridDim.x * gridDim.y * gridDim.z;
    unsigned sum, cnt, mine, sp = 0u;
    for (;;) {
        sum = 0u; cnt = 0u; mine = 0u;
#pragma unroll
        for (unsigned j = 0; j < 16; ++j) { const unsigned c = xb_ld(&bar[XB_XCNT(j)]); sum += c; cnt += (c > 0u) ? 1u : 0u; mine = (j == x) ? c : mine; }
        if (sum == G) break;
        __builtin_amdgcn_s_sleep(1);
        if ((++sp & 255u) == 0u) { if (xb_ld(&bar[XB_TMO])) break; if (sp > XB_SPIN_CAP) { atomicAdd(&bar[XB_TMO], 1u); break; } }
    }
    nloc = mine > 0u ? mine : 1u; nx = cnt > 0u ? cnt : 1u;
}

__device__ __forceinline__ void xcd_barrier(const XcdBarrier& b) {
    asm volatile("s_waitcnt vmcnt(0)" ::: "memory");
    __syncthreads();
    if (threadIdx.x == 0) {
        unsigned* bar = b.bar;
        __builtin_amdgcn_s_waitcnt(0);
        unsigned nloc = b.st[0], nx = b.st[1];
        if (nloc == 0u) { xcd_barrier_complete(bar, b.x, nloc, nx); b.st[0] = nloc; b.st[1] = nx; }
        const unsigned old = xb_add(&bar[XB_XSUB(b.x)], 1u);
        const unsigned gen = old / nloc;
        if (old + 1u == (gen + 1u) * nloc) {
            __builtin_amdgcn_fence(__ATOMIC_RELEASE, "agent");
            asm volatile("s_waitcnt vmcnt(0)" ::: "memory");
            const unsigned og = xb_add(&bar[XB_TOP], 1u);
            const unsigned tg = og / nx;
            if (og + 1u == (tg + 1u) * nx) xb_add(&bar[XB_TOPGEN], 1u);
            else XB_SPIN(xb_ld(&bar[XB_TOPGEN]) == tg, bar);
            __builtin_amdgcn_fence(__ATOMIC_ACQUIRE, "agent");
            xb_add(&bar[XB_XGEN(b.x)], 1u);
            asm volatile("s_waitcnt vmcnt(0)" ::: "memory");
        } else {
            XB_SPIN(xb_ld(&bar[XB_XGEN(b.x)]) == gen, bar);
            __builtin_amdgcn_fence(__ATOMIC_ACQUIRE, "agent");
            asm volatile("s_waitcnt vmcnt(0)" ::: "memory");
        }
    }
    __syncthreads();
}
struct Frame {
    LAS unsigned char* lds;
    volatile LAS unsigned* MISC;
    gu32* ctl;
    int tid, lane, wave, vcu, G;
    unsigned char* ws; float* out;
};
__device__ __forceinline__ float wave_sum(float v) {
#pragma unroll
    for (int o = 1; o < 64; o <<= 1) v += __shfl_xor(v, o);
    return v;
}
__device__ __forceinline__ void p0_transpose_item(const float* W, int K, int N, bf16* WT, int row_off, LAS float* scr, int item, int lane) {
    const int nblk = N / 32, kb = item / nblk, nb = item % nblk, k0 = 64 * kb, n0 = 32 * nb;
#pragma unroll 8
    for (int i = 0; i < 32; ++i) { const int kk = 2 * i + (lane >> 5); scr[kk * 33 + (lane & 31)] = W[(size_t)(k0 + kk) * N + n0 + (lane & 31)]; }
    LDS_WAIT(); asm volatile("" ::: "memory");
    const int c = lane & 7;
#pragma unroll
    for (int j = 0; j < 4; ++j) { const int n = (lane >> 3) + 8 * j; const LAS float* s = scr + (8 * c) * 33 + n;
        v4u o; o.x = pk2(s[0 * 33], s[1 * 33]); o.y = pk2(s[2 * 33], s[3 * 33]); o.z = pk2(s[4 * 33], s[5 * 33]); o.w = pk2(s[6 * 33], s[7 * 33]);
        *(GAS v4u*)(WT + (size_t)(row_off + n0 + n) * K + k0 + 8 * c) = o; }
    LDS_WAIT(); asm volatile("" ::: "memory");
}
__device__ __forceinline__ void cvt_rows(Frame& F, const float* src, bf16* dst, size_t n8) {
    for (size_t i = (size_t)F.vcu * 512 + F.tid; i < n8; i += (size_t)F.G * 512) {
        const f32x4 a = *(const f32x4*)(src + i * 8), b = *(const f32x4*)(src + i * 8 + 4);
        v4u o; o.x = pk2(a.x, a.y); o.y = pk2(a.z, a.w); o.z = pk2(b.x, b.y); o.w = pk2(b.z, b.w);
        *(v4u*)(dst + i * 8) = o; }
}
struct In { const float *x, *p, *w_in, *q_norm, *k_norm, *lb_logits, *hg_norm, *w_pa, *w_pb, *w_gate, *b_gate, *w_o, *ln1_g, *ln1_b, *w_up, *conv_w, *conv_b, *w_down, *ln2_g, *ln2_b, *w_pg, *w_ple; };

__device__ __forceinline__ void p0_prologue(Frame& F, const In& I) {
    unsigned char* ws = F.ws;
    { float* tab = (float*)(ws + WS_TAB);
      for (int i = blockIdx.x * 512 + F.tid; i < 4096 + 4096; i += F.G * 512) {
          if (i < 4096) { const int pos = i >> 5, fi = i & 31; const float inv = powf(10000.0f, -(float)(2 * fi) / 64.0f); const float ang = (float)pos * inv; tab[i] = cosf(ang); tab[4096 + i] = sinf(ang); }
          else { const int j = i - 4096, dir = j >> 11, c = j & 2047; const float a = I.lb_logits[(dir * 2 + 0) * 2048 + c], b = I.lb_logits[(dir * 2 + 1) * 2048 + c];
                 tab[8192 + j] = 1.0f / (1.0f + expf(b - a)); } } }
    LAS float* scr = (LAS float*)(F.lds + F.wave * 16384);
    const int gw = F.vcu * NWAVES + F.wave, NGW = F.G * NWAVES;
    constexpr int I0 = (DM / 64) * (N_IN / 32), I1 = (DM / 64) * (2 * DM / 32), I2 = (ATTN_DIM / 64) * (DM / 32), I3 = I2, I4 = (DM / 64) * (DM / 32), I5 = (DM / 64) * (2 * DFF / 32), I6 = (DFF / 64) * (DM / 32);
    constexpr int NITEMS = I0 + I1 + I2 + I3 + I4 + I5 + I6;
    for (int it = gw; it < NITEMS; it += NGW) {
        int r = it;
        if (r < I0) { p0_transpose_item(I.w_in, DM, N_IN, (bf16*)(ws + WS_BT1), 0, scr, r, F.lane); continue; } r -= I0;
        if (r < I1) { p0_transpose_item(I.w_gate, DM, 2 * DM, (bf16*)(ws + WS_BT1), N_IN, scr, r, F.lane); continue; } r -= I1;
        if (r < I2) { p0_transpose_item(I.w_pa, ATTN_DIM, DM, (bf16*)(ws + WS_WPA), 0, scr, r, F.lane); continue; } r -= I2;
        if (r < I3) { p0_transpose_item(I.w_pb, HQK, DM, (bf16*)(ws + WS_WPB), 0, scr, r, F.lane); continue; } r -= I3;
        if (r < I4) { p0_transpose_item(I.w_o, DM, DM, (bf16*)(ws + WS_WO), 0, scr, r, F.lane); continue; } r -= I4;
        if (r < I5) { p0_transpose_item(I.w_up, DM, 2 * DFF, (bf16*)(ws + WS_WUP), 0, scr, r, F.lane); continue; } r -= I5;
        p0_transpose_item(I.w_down, DFF, DM, (bf16*)(ws + WS_WDN), 0, scr, r, F.lane);
    }
    cvt_rows(F, I.x, (bf16*)(ws + WS_XB), (size_t)M * DM / 8);
}
__device__ __forceinline__ void qk_prep(Frame& F, const In& I) {
    bf16* QA = (bf16*)(F.ws + WS_QA); bf16* KA = (bf16*)(F.ws + WS_KA); const float* tab = (const float*)(F.ws + WS_TAB);
    const int sub = F.lane & 15, e0 = sub * 8, e1 = e0 ^ 32, fi = e0 & 31;
    const float sgn = (sub & 4) ? 1.f : -1.f;
    for (int it = (F.vcu * 512 + F.tid) >> 4; it < M * 20; it += F.G * 32) {
        bf16* ptr; const float* gain; int row;
        if (it < M * 16) { row = it >> 4; ptr = QA + (size_t)row * 2048 + (it & 15) * 128; gain = I.q_norm; }
        else { const int i2 = it - M * 16; row = i2 >> 2; ptr = KA + (size_t)row * 512 + (i2 & 3) * 128; gain = I.k_norm; }
        const v4u xv = *(const v4u*)(ptr + e0);
        v4u pv; pv.x = __shfl_xor(xv.x, 4); pv.y = __shfl_xor(xv.y, 4); pv.z = __shfl_xor(xv.z, 4); pv.w = __shfl_xor(xv.w, 4);
        const float x[8] = {bflo(xv.x), bfhi(xv.x), bflo(xv.y), bfhi(xv.y), bflo(xv.z), bfhi(xv.z), bflo(xv.w), bfhi(xv.w)};
        const float px[8] = {bflo(pv.x), bfhi(pv.x), bflo(pv.y), bfhi(pv.y), bflo(pv.z), bfhi(pv.z), bflo(pv.w), bfhi(pv.w)};
        float ss = 0.f;
#pragma unroll
        for (int j = 0; j < 8; ++j) ss += x[j] * x[j];
        ss += __shfl_xor(ss, 1); ss += __shfl_xor(ss, 2); ss += __shfl_xor(ss, 4); ss += __shfl_xor(ss, 8);
        const float rstd = 1.0f / sqrtf(ss * (1.0f / 128.0f) + RMS_EPS);
        const int t = row & (SEQ - 1), pos = (e0 < 64) ? (t >> 6) : (t & 63);
        const f32x4 c0 = *(const f32x4*)(tab + pos * 32 + fi), c1 = *(const f32x4*)(tab + pos * 32 + fi + 4);
        const f32x4 s0 = *(const f32x4*)(tab + 4096 + pos * 32 + fi), s1 = *(const f32x4*)(tab + 4096 + pos * 32 + fi + 4);
        const f32x4 g0 = *(const f32x4*)(gain + e0), g1 = *(const f32x4*)(gain + e0 + 4), h0 = *(const f32x4*)(gain + e1), h1 = *(const f32x4*)(gain + e1 + 4);
        float o[8];
#pragma unroll
        for (int j = 0; j < 8; ++j) { const float cj = j < 4 ? c0[j & 3] : c1[j & 3], sj = j < 4 ? s0[j & 3] : s1[j & 3], gj = j < 4 ? g0[j & 3] : g1[j & 3], hj = j < 4 ? h0[j & 3] : h1[j & 3];
            o[j] = (x[j] * rstd * gj) * cj + sgn * (px[j] * rstd * hj) * sj; }
        v4u w; w.x = pk2(o[0], o[1]); w.y = pk2(o[2], o[3]); w.z = pk2(o[4], o[5]); w.w = pk2(o[6], o[7]);
        *(v4u*)(ptr + e0) = w;
    }
}
__device__ __forceinline__ void h1_pass(Frame& F) {
    unsigned char* ws = F.ws; const float* tab = (const float*)(ws + WS_TAB);
    bf16* QF = (bf16*)(ws + WS_QF); bf16* KF = (bf16*)(ws + WS_KF); bf16* KB = (bf16*)(ws + WS_KB); bf16* QB = (bf16*)(ws + WS_QB);
    typedef float f2 __attribute__((ext_vector_type(2)));
    const int p = F.tid & 255, h = F.tid >> 8;
    for (int it = F.vcu; it < NCHUNK * 4; it += F.G) {
        const int c = it >> 2, cg = it & 3, col = cg * 512 + 2 * p; const size_t base = (size_t)(c * 64 + 32 * h) * 2048 + col; const size_t vecidx = (size_t)c * 2048 + col;
        const float lbf0 = tab[8192 + col], lbf1 = tab[8192 + col + 1], lbb0 = tab[8192 + 2048 + col], lbb1 = tab[8192 + 2048 + col + 1];
        float TF0 = 0.f, TF1 = 0.f, TB0 = 0.f, TB1 = 0.f;
        { const bf16* zf = KF + base; const bf16* zb = KB + base;
#pragma unroll 8
          for (int j = 0; j < 32; ++j) { const unsigned a = *(const unsigned*)zf, b = *(const unsigned*)zb; zf += 2048; zb += 2048;
              TF0 += __logf(lbf0 + (1.f - lbf0) * sigm(bflo(a))); TF1 += __logf(lbf1 + (1.f - lbf1) * sigm(bfhi(a)));
              TB0 += __logf(lbb0 + (1.f - lbb0) * sigm(bflo(b))); TB1 += __logf(lbb1 + (1.f - lbb1) * sigm(bfhi(b))); } }
        { float* vf = (float*)(ws + (h == 0 ? WS_RF : WS_WF)) + vecidx; float* vb = (float*)(ws + (h == 1 ? WS_RB : WS_WB)) + vecidx;
          *(f2*)vf = (f2){__expf(TF0), __expf(TF1)}; *(f2*)vb = (f2){__expf(TB0), __expf(TB1)}; }
        float PF0 = 0.f, PF1 = 0.f, PB0 = 0.f, PB1 = 0.f;
        { bf16* qf = QF + base; bf16* kf = KF + base; bf16* kb = KB + base; bf16* qb = QB + base;
#pragma unroll 4
          for (int j = 0; j < 32; ++j) {
              const unsigned qq = *(const unsigned*)qf, a = *(const unsigned*)kf, b = *(const unsigned*)kb;
              const float q0 = bflo(qq), q1 = bfhi(qq);
              const float ff0 = lbf0 + (1.f - lbf0) * sigm(bflo(a)), ff1 = lbf1 + (1.f - lbf1) * sigm(bfhi(a));
              const float fb0 = lbb0 + (1.f - lbb0) * sigm(bflo(b)), fb1 = lbb1 + (1.f - lbb1) * sigm(bfhi(b));
              const float lf0 = __logf(ff0), lf1 = __logf(ff1), lb0 = __logf(fb0), lb1 = __logf(fb1);
              PF0 += lf0; PF1 += lf1; PB0 += lb0; PB1 += lb1;
              float xf0 = (h == 0) ? (PF0 - TF0) : PF0, xf1 = (h == 0) ? (PF1 - TF1) : PF1;
              float xb0 = (h == 1) ? (lb0 - PB0) : (TB0 - PB0 + lb0), xb1 = (h == 1) ? (lb1 - PB1) : (TB1 - PB1 + lb1);
              xf0 = fminf(fmaxf(xf0, -80.f), 80.f); xf1 = fminf(fmaxf(xf1, -80.f), 80.f); xb0 = fminf(fmaxf(xb0, -80.f), 80.f); xb1 = fminf(fmaxf(xb1, -80.f), 80.f);
              const float EF0 = __expf(xf0), EF1 = __expf(xf1), EB0 = __expf(xb0), EB1 = __expf(xb1);
              *(unsigned*)qf = pk2(q0 * EF0, q1 * EF1);
              *(unsigned*)kf = pk2((1.f - ff0) * __builtin_amdgcn_rcpf(EF0), (1.f - ff1) * __builtin_amdgcn_rcpf(EF1));
              *(unsigned*)qb = pk2(q0 * EB0, q1 * EB1);
              *(unsigned*)kb = pk2((1.f - fb0) * __builtin_amdgcn_rcpf(EB0), (1.f - fb1) * __builtin_amdgcn_rcpf(EB1));
              qf += 2048; kf += 2048; kb += 2048; qb += 2048; } }
    }
}
__device__ __forceinline__ void p2_small_converts(Frame& F, const In& I) {
    LAS float* scr = (LAS float*)(F.lds + F.wave * 16384);
    const int gw = F.vcu * NWAVES + F.wave, NGW = F.G * NWAVES;
    constexpr int J0 = (DM / 64) * (DM / 32), J1 = (PLE / 64) * (DM / 32);
    for (int it = gw; it < J0 + J1; it += NGW) {
        if (it < J0) p0_transpose_item(I.w_pg, DM, DM, (bf16*)(F.ws + WS_WPG), 0, scr, it, F.lane);
        else p0_transpose_item(I.w_ple, PLE, DM, (bf16*)(F.ws + WS_WPLE), 0, scr, it - J0, F.lane);
    }
    cvt_rows(F, I.p, (bf16*)(F.ws + WS_PB), (size_t)M * PLE / 8);
}
typedef short v4i16_t __attribute__((ext_vector_type(4)));
__device__ __forceinline__ unsigned offb(unsigned row, unsigned ch) { return 256u * row + 16u * (ch ^ (((row & 3u) << 2) | ((row >> 2) & 3u))); }
__device__ __forceinline__ s16x4 vtr(const LAS unsigned char* p) { return __builtin_bit_cast(s16x4, __builtin_amdgcn_ds_read_tr16_b64_v4i16((LAS v4i16_t*)p)); }
#define MFMA16(a, b, c) __builtin_amdgcn_mfma_f32_16x16x32_bf16((a), (b), (c), 0, 0, 0)
template <int DIR>
__device__ __forceinline__ void scan_unit(Frame& F, const bf16* QIN, const bf16* KIN, const bf16* VV, bf16* OO, const float* RV, const float* WV, int b, int h) {
    LAS unsigned char* lds = F.lds;
    const int tid = F.tid, lane = F.lane, wid = F.wave, l15 = lane & 15, g = lane >> 4;
    constexpr int BUFSZ = 3 * 16384 + 1024, AM_OFF = 2 * BUFSZ;
    static_assert(AM_OFF + 8192 <= RING_BYTES, "scan LDS");
    int so[2]; size_t go[2];
#pragma unroll
    for (int j = 0; j < 2; ++j) { const int c = tid + 512 * j, row = c >> 4, ch = c & 15; so[j] = (row >> 5) * 8192 + (int)offb(row & 31, ch); go[j] = (size_t)row * 2048 + h * 128 + ch * 8; }
    f32x4 S[8];
#pragma unroll
    for (int i = 0; i < 8; ++i) S[i] = (f32x4){0.f, 0.f, 0.f, 0.f};
    v4u rq[2], rk[2], rv[2]; f32x4 rw = (f32x4){0.f, 0.f, 0.f, 0.f};
#define SCAN_LOAD(n) do { const size_t rb_ = (size_t)(b * SEQ + 64 * (n)) * 2048; \
        _Pragma("unroll") for (int j = 0; j < 2; ++j) { rq[j] = *(const v4u*)(QIN + rb_ + go[j]); rk[j] = *(const v4u*)(KIN + rb_ + go[j]); rv[j] = *(const v4u*)(VV + rb_ + go[j]); } \
        if (tid < 64) rw = *(const f32x4*)((tid < 32 ? RV : WV) + (size_t)(b * 128 + (n)) * 2048 + h * 128 + 4 * (tid & 31)); } while (0)
    SCAN_LOAD(DIR == 0 ? 0 : 127);
    const LAS unsigned char* AM = lds + AM_OFF;
    const int tq = l15 >> 2, tp = lane & 3;
    for (int it = 0; it < 128; ++it) {
        const int n = (DIR == 0) ? it : 127 - it;
        LAS unsigned char* bufp = lds + (it & 1) * BUFSZ;
#pragma unroll
        for (int j = 0; j < 2; ++j) { *(LAS v4u*)(bufp + so[j]) = rq[j]; *(LAS v4u*)(bufp + 16384 + so[j]) = rk[j]; *(LAS v4u*)(bufp + 32768 + so[j]) = rv[j]; }
        if (tid < 64) *(LAS f32x4*)(bufp + 49152 + tid * 16) = rw;
        if (it + 1 < 128) SCAN_LOAD((DIR == 0) ? it + 1 : 126 - it);
        __syncthreads();
        const LAS unsigned char* Qi = bufp; const LAS unsigned char* Ki = bufp + 16384; const LAS unsigned char* Vi = bufp + 32768;
        const LAS float* rI = (const LAS float*)(bufp + 49152); const LAS float* wI = rI + 128;
        { const int ti = wid >> 1, sj0 = (wid & 1) * 2, qrow = 16 * ti + l15, kr0 = 16 * sj0 + l15, kr1 = kr0 + 16;
          f32x4 a0 = (f32x4){0.f, 0.f, 0.f, 0.f}, a1 = a0;
#pragma unroll
          for (int ks = 0; ks < 4; ++ks) { const unsigned ch = 4 * ks + g;
              const bf16x8 qf = *(const LAS bf16x8*)(Qi + (qrow >> 5) * 8192 + offb(qrow & 31, ch));
              const bf16x8 k0 = *(const LAS bf16x8*)(Ki + (kr0 >> 5) * 8192 + offb(kr0 & 31, ch));
              const bf16x8 k1 = *(const LAS bf16x8*)(Ki + (kr1 >> 5) * 8192 + offb(kr1 & 31, ch));
              a0 = MFMA16(k0, qf, a0); a1 = MFMA16(k1, qf, a1); }
          const int t = qrow;
#pragma unroll
          for (int tl = 0; tl < 2; ++tl) { f32x4 v = tl ? a1 : a0; const int sbase = 16 * (sj0 + tl) + 4 * g;
#pragma unroll
              for (int i = 0; i < 4; ++i) { const int s = sbase + i; const bool keep = (DIR == 0) ? (s <= t) : (s >= t); v[i] = keep ? v[i] : 0.f; }
              v2u w2; w2.x = pk2(v[0], v[1]); w2.y = pk2(v[2], v[3]);
              *(LAS v2u*)(lds + AM_OFF + t * 128 + ((((sbase >> 3)) ^ (t & 7)) << 4) + 8 * (g & 1)) = w2; } }
        __syncthreads();
        bf16x8 vf[2];
#pragma unroll
        for (int ks = 0; ks < 2; ++ks) { const LAS unsigned char* tb = Vi + ks * 8192;
            const s16x4 lo = vtr(tb + offb(8 * g + tq, 2 * wid + (tp >> 1)) + 8 * (tp & 1)), hi = vtr(tb + offb(8 * g + 4 + tq, 2 * wid + (tp >> 1)) + 8 * (tp & 1));
            vf[ks] = (bf16x8){lo[0], lo[1], lo[2], lo[3], hi[0], hi[1], hi[2], hi[3]}; }
        f32x4 ao[4];
#pragma unroll
        for (int tt = 0; tt < 4; ++tt) ao[tt] = (f32x4){0.f, 0.f, 0.f, 0.f};
#pragma unroll
        for (int tt = 0; tt < 4; ++tt) { const int t = 16 * tt + l15;
#pragma unroll
            for (int ks = 0; ks < 2; ++ks) { const bf16x8 af = *(const LAS bf16x8*)(AM + t * 128 + (((4 * ks + g) ^ (t & 7)) << 4)); ao[tt] = MFMA16(vf[ks], af, ao[tt]); } }
#pragma unroll
        for (int ks = 0; ks < 4; ++ks) {
            const f32x4 r0 = *(const LAS f32x4*)(rI + 32 * ks + 4 * g), r1 = *(const LAS f32x4*)(rI + 32 * ks + 16 + 4 * g);
            const f32x4 s0 = S[2 * ks] * r0, s1 = S[2 * ks + 1] * r1;
            v4u sw; sw.x = pk2(s0[0], s0[1]); sw.y = pk2(s0[2], s0[3]); sw.z = pk2(s1[0], s1[1]); sw.w = pk2(s1[2], s1[3]);
            const bf16x8 sf = __builtin_bit_cast(bf16x8, sw);
#pragma unroll
            for (int tt = 0; tt < 4; ++tt) { const int t = 16 * tt + l15; const LAS unsigned char* qb = Qi + (t >> 5) * 8192;
                const v2u qa = *(const LAS v2u*)(qb + offb(t & 31, 4 * ks + (g >> 1)) + 8 * (g & 1)), qc = *(const LAS v2u*)(qb + offb(t & 31, 4 * ks + 2 + (g >> 1)) + 8 * (g & 1));
                v4u qw; qw.x = qa.x; qw.y = qa.y; qw.z = qc.x; qw.w = qc.y;
                ao[tt] = MFMA16(sf, __builtin_bit_cast(bf16x8, qw), ao[tt]); } }
        { bf16* op = OO + (size_t)(b * SEQ + 64 * n + l15) * 2048 + h * 128 + 16 * wid + 4 * g;
#pragma unroll
          for (int tt = 0; tt < 4; ++tt) { v2u w2; w2.x = pk2(ao[tt][0], ao[tt][1]); w2.y = pk2(ao[tt][2], ao[tt][3]); *(v2u*)(op + (size_t)(16 * tt) * 2048) = w2; } }
#pragma unroll
        for (int dt = 0; dt < 8; ++dt) { f32x4 T = (f32x4){0.f, 0.f, 0.f, 0.f};
#pragma unroll
            for (int ks = 0; ks < 2; ++ks) { const LAS unsigned char* tb = Ki + ks * 8192;
                const s16x4 lo = vtr(tb + offb(8 * g + tq, 2 * dt + (tp >> 1)) + 8 * (tp & 1)), hi = vtr(tb + offb(8 * g + 4 + tq, 2 * dt + (tp >> 1)) + 8 * (tp & 1));
                const bf16x8 kt = (bf16x8){lo[0], lo[1], lo[2], lo[3], hi[0], hi[1], hi[2], hi[3]};
                T = MFMA16(kt, vf[ks], T); }
            const f32x4 rr = *(const LAS f32x4*)(rI + 16 * dt + 4 * g), ww = *(const LAS f32x4*)(wI + 16 * dt + 4 * g);
            S[dt] = (rr * ww) * S[dt] + ww * T; }
    }
    __syncthreads();
#undef SCAN_LOAD
}
__device__ __forceinline__ void combine_pass(Frame& F, const In& I) {
    bf16* OF = (bf16*)(F.ws + WS_QF); const bf16* OB = (const bf16*)(F.ws + WS_QB); const bf16* GH = (const bf16*)(F.ws + WS_GH);
    const int sub = F.lane & 15, e0 = sub * 8;
    for (int it = (F.vcu * 512 + F.tid) >> 4; it < M * 16; it += F.G * 32) {
        const int row = it >> 4, head = it & 15; const size_t off = (size_t)row * 2048 + head * 128 + e0;
        const v4u a = *(const v4u*)(OF + off), bq = *(const v4u*)(OB + off), gq = *(const v4u*)(GH + off);
        float o[8] = {bflo(a.x) + bflo(bq.x), bfhi(a.x) + bfhi(bq.x), bflo(a.y) + bflo(bq.y), bfhi(a.y) + bfhi(bq.y), bflo(a.z) + bflo(bq.z), bfhi(a.z) + bfhi(bq.z), bflo(a.w) + bflo(bq.w), bfhi(a.w) + bfhi(bq.w)};
        const float gg[8] = {bflo(gq.x), bfhi(gq.x), bflo(gq.y), bfhi(gq.y), bflo(gq.z), bfhi(gq.z), bflo(gq.w), bfhi(gq.w)};
        float ss = 0.f;
#pragma unroll
        for (int j = 0; j < 8; ++j) ss += o[j] * o[j];
        ss += __shfl_xor(ss, 1); ss += __shfl_xor(ss, 2); ss += __shfl_xor(ss, 4); ss += __shfl_xor(ss, 8);
        const float rstd = 1.0f / sqrtf(ss * (1.0f / 128.0f) + RMS_EPS);
        const f32x4 n0 = *(const f32x4*)(I.hg_norm + head * 128 + e0), n1 = *(const f32x4*)(I.hg_norm + head * 128 + e0 + 4);
#pragma unroll
        for (int j = 0; j < 8; ++j) o[j] = o[j] * rstd * (j < 4 ? n0[j & 3] : n1[j & 3]) * gg[j];
        v4u w; w.x = pk2(o[0], o[1]); w.y = pk2(o[2], o[3]); w.z = pk2(o[4], o[5]); w.w = pk2(o[6], o[7]);
        *(v4u*)(OF + off) = w;
    }
}
__device__ __forceinline__ void ln_pass(Frame& F, const float* X, bf16* XB, const float* gam, const float* bet, float* Y) {
    const int gw = F.vcu * NWAVES + F.wave, NGW = F.G * NWAVES;
    for (int m = gw; m < M; m += NGW) {
        const f32x4* xr = (const f32x4*)(X + (size_t)m * DM) + F.lane; f32x4* yr = (f32x4*)(Y + (size_t)m * DM) + F.lane;
        f32x4 v[16]; float s = 0.f;
#pragma unroll
        for (int j = 0; j < 16; ++j) { v[j] = xr[64 * j]; s += (v[j].x + v[j].y) + (v[j].z + v[j].w); }
        const float mean = wave_sum(s) * (1.f / DM); float s2 = 0.f;
#pragma unroll
        for (int j = 0; j < 16; ++j) { v[j] = v[j] - mean; s2 += (v[j].x * v[j].x + v[j].y * v[j].y) + (v[j].z * v[j].z + v[j].w * v[j].w); }
        const float rstd = 1.f / sqrtf(wave_sum(s2) * (1.f / DM) + LN_EPS);
        v2u* o8 = (v2u*)(XB + (size_t)m * DM) + F.lane;
#pragma unroll
        for (int j = 0; j < 16; ++j) { const f32x4 gg = *((const f32x4*)gam + F.lane + 64 * j), bb = *((const f32x4*)bet + F.lane + 64 * j);
            const f32x4 y = v[j] * rstd * gg + bb; yr[64 * j] = y; v2u w; w.x = pk2(y.x, y.y); w.y = pk2(y.z, y.w); o8[64 * j] = w; }
    }
}
__device__ __forceinline__ void conv_pass(Frame& F, const In& I) {
    bf16* U = (bf16*)(F.ws + WS_UB); const bf16* Gp = (const bf16*)(F.ws + WS_GB);
    constexpr int NCG = DFF / 8, NIT = (M / 32) * NCG;
    for (int it = F.vcu * 512 + F.tid; it < NIT; it += F.G * 512) {
        const int r = it / NCG, cg = it - r * NCG, c0 = cg * 8, t0 = r * 32, tl = t0 & (SEQ - 1);
        float w0[8], w1[8], w2[8], bb[8];
        { const f32x4 a0 = *(const f32x4*)(I.conv_w + c0), a1 = *(const f32x4*)(I.conv_w + c0 + 4), b0 = *(const f32x4*)(I.conv_w + DFF + c0), b1 = *(const f32x4*)(I.conv_w + DFF + c0 + 4);
          const f32x4 d0 = *(const f32x4*)(I.conv_w + 2 * DFF + c0), d1 = *(const f32x4*)(I.conv_w + 2 * DFF + c0 + 4), e0 = *(const f32x4*)(I.conv_b + c0), e1 = *(const f32x4*)(I.conv_b + c0 + 4);
#pragma unroll
          for (int j = 0; j < 4; ++j) { w0[j] = a0[j]; w0[4 + j] = a1[j]; w1[j] = b0[j]; w1[4 + j] = b1[j]; w2[j] = d0[j]; w2[4 + j] = d1[j]; bb[j] = e0[j]; bb[4 + j] = e1[j]; } }
        const v4u zero = (v4u){0u, 0u, 0u, 0u};
        const bf16* gq = Gp + (size_t)t0 * DFF + c0; bf16* uq = U + (size_t)t0 * DFF + c0;
        v4u gp = *(const v4u*)(gq - (tl == 0 ? 0 : DFF)); if (tl == 0) gp = zero;
        v4u gc = *(const v4u*)gq;
        for (int j0 = 0; j0 < 32; j0 += 4) {
            v4u gn[4], uu[4];
#pragma unroll
            for (int jj = 0; jj < 4; ++jj) { const bool last = (tl + j0 + jj == SEQ - 1); gn[jj] = *(const v4u*)(gq + (size_t)(j0 + jj + (last ? 0 : 1)) * DFF); if (last) gn[jj] = zero; uu[jj] = *(const v4u*)(uq + (size_t)(j0 + jj) * DFF); }
#pragma unroll
            for (int jj = 0; jj < 4; ++jj) {
                const unsigned gpa[4] = {gp.x, gp.y, gp.z, gp.w}, gca[4] = {gc.x, gc.y, gc.z, gc.w}, gna[4] = {gn[jj].x, gn[jj].y, gn[jj].z, gn[jj].w}, ua[4] = {uu[jj].x, uu[jj].y, uu[jj].z, uu[jj].w};
                unsigned ow[4];
#pragma unroll
                for (int q = 0; q < 4; ++q) {
                    const float a0 = bflo(gpa[q]) * w0[2 * q] + bflo(gca[q]) * w1[2 * q] + bflo(gna[q]) * w2[2 * q] + bb[2 * q];
                    const float a1 = bfhi(gpa[q]) * w0[2 * q + 1] + bfhi(gca[q]) * w1[2 * q + 1] + bfhi(gna[q]) * w2[2 * q + 1] + bb[2 * q + 1];
                    ow[q] = pk2(a0 * sigm(a0) * bflo(ua[q]), a1 * sigm(a1) * bfhi(ua[q])); }
                *(v4u*)(uq + (size_t)(j0 + jj) * DFF) = (v4u){ow[0], ow[1], ow[2], ow[3]};
                gp = gc; gc = gn[jj]; }
        }
    }
}
struct Args { In in; float* out; unsigned char* ws; int ph_lo, ph_hi, li, pad; };
__global__ void __launch_bounds__(NWAVES * 64, 2) mk_fwd(Args args) {
    extern __shared__ __attribute__((aligned(16))) unsigned char lds[];
    Frame F;
    F.lds = (LAS unsigned char*)lds;
    F.MISC = (volatile LAS unsigned*)(F.lds + MISC_OFF);
    F.tid = threadIdx.x; F.lane = F.tid & 63; F.wave = __builtin_amdgcn_readfirstlane(F.tid >> 6);
    F.G = gridDim.x; { const int bx = blockIdx.x; F.vcu = (F.G % 8 == 0) ? (bx % 8) * (F.G / 8) + bx / 8 : bx; }
    F.ws = args.ws; F.out = args.out;
    F.ctl = (gu32*)(args.ws + WS_CTL);
    const In& I = args.in;
    unsigned char* ws = args.ws;
    for (int u = F.tid; u < (LDS_BYTES - LDSCTL_OFF) / 4; u += NWAVES * 64) ((LAS unsigned*)(F.lds + LDSCTL_OFF))[u] = 0u;
    __syncthreads();
    XcdBarrier bar; bar.bar = (unsigned*)(F.ctl + CW_BAR); bar.x = 0; bar.st = nullptr;
    if (N_LAUNCHES == 1) bar = xcd_barrier_post((unsigned*)(F.ctl + CW_BAR), F.MISC + 8);
#define GRID_BAR() do { if (N_LAUNCHES == 1) xcd_barrier(bar); } while (0)
    const int lo = args.ph_lo, hi = args.ph_hi;
#ifndef PH_MASK
#define PH_MASK 0xFFFF
#endif
#define IN(k) ((((PH_MASK) >> (k)) & 1) && lo <= (k) && (k) < hi)
#define BOTH(k) (IN(k) && IN((k) + 1))
    bf16* const BT1 = (bf16*)(ws + WS_BT1); bf16* const XB = (bf16*)(ws + WS_XB);
    bf16* const QA = (bf16*)(ws + WS_QA); bf16* const KA = (bf16*)(ws + WS_KA); bf16* const VA = (bf16*)(ws + WS_VA);
    bf16* const QF = (bf16*)(ws + WS_QF); bf16* const KF = (bf16*)(ws + WS_KF); bf16* const KB = (bf16*)(ws + WS_KB); bf16* const QB = (bf16*)(ws + WS_QB);
    bf16* const IH = (bf16*)(ws + WS_IH); bf16* const GH = (bf16*)(ws + WS_GH); bf16* const GATE = (bf16*)(ws + WS_GATE);
    bf16* const MIX = (bf16*)(ws + WS_MIX); bf16* const X1B = (bf16*)(ws + WS_X1B); bf16* const UB = (bf16*)(ws + WS_UB); float* const PE = (float*)(ws + WS_PE);

#ifndef REPEAT_PHASE
#define REPEAT_PHASE -1
#endif
    bf16* const DUMMY = (bf16*)F.out;
    if (IN(0)) { if (REPEAT_PHASE == 0) { p0_prologue(F, I); GRID_BAR(); } p0_prologue(F, I); if (BOTH(0)) GRID_BAR(); }
    if (IN(1)) {
        pg8::Gemm g{XB, BT1, M, N_IN, DM}; pg8::StaticOrder S; S.init(M, N_IN, F.G, (int)blockIdx.x);
        pg8::EpiProj E{QA, KA, VA, QF, KF, KB, IH, GH, GATE, I.b_gate, 0};
        if (REPEAT_PHASE == 1) { pg8::gemm_phase<pg8::EpiProj, pg8::StaticOrder, true, true>(F.lds, g, S, E); GRID_BAR(); }
        pg8::gemm_phase<pg8::EpiProj, pg8::StaticOrder, true, true>(F.lds, g, S, E);
        if (BOTH(1)) GRID_BAR();
    }
    if (IN(2)) { qk_prep(F, I); h1_pass(F); p2_small_converts(F, I); if (BOTH(2)) GRID_BAR(); }
    if (IN(3)) {
        if (REPEAT_PHASE == 3) { if (blockIdx.x < 64) { const int u = blockIdx.x, dir = u >> 5, b = (u >> 4) & 1, h = u & 15;
            if (dir == 0) scan_unit<0>(F, QF, KF, IH, DUMMY, (const float*)(ws + WS_RF), (const float*)(ws + WS_WF), b, h);
            else          scan_unit<1>(F, QB, KB, IH, DUMMY + (size_t)M * 2048, (const float*)(ws + WS_RB), (const float*)(ws + WS_WB), b, h); } GRID_BAR(); }
        if (blockIdx.x < 64) { const int u = blockIdx.x, dir = u >> 5, b = (u >> 4) & 1, h = u & 15;
            if (dir == 0) scan_unit<0>(F, QF, KF, IH, QF, (const float*)(ws + WS_RF), (const float*)(ws + WS_WF), b, h);
            else          scan_unit<1>(F, QB, KB, IH, QB, (const float*)(ws + WS_RB), (const float*)(ws + WS_WB), b, h); }
        { pg8::Gemm g{XB, BT1 + (size_t)N_IN * DM, M, 2 * DM, DM}; pg8::SplitOrder S{(int)blockIdx.x};
          pg8::EpiProj E{QA, KA, VA, QF, KF, KB, IH, GH, GATE, I.b_gate, N_IN};
          pg8::gemm_phase<pg8::EpiProj, pg8::SplitOrder, true, true>(F.lds, g, S, E); }
        if (BOTH(3)) GRID_BAR();
    }
    if (IN(4)) {
        if (REPEAT_PHASE == 4) { for (int u = F.vcu; u < 1024; u += F.G) { const int gI = u >> 7, r = u & 127, b = gI >> 2, kvh = gI & 3, qh = kvh * 4 + (r >> 5), qb = r & 31;
            const size_t qoff = (size_t)(b * SEQ + qb * 256) * 2048 + qh * 128, koff = (size_t)(b * SEQ) * 512 + kvh * 128;
            attn::attn_dense_body(QA + qoff, KA + koff, VA + koff, DUMMY + qoff, SEQ, (char*)lds); } GRID_BAR(); }
        for (int u = F.vcu; u < 1024; u += F.G) { const int gI = u >> 7, r = u & 127, b = gI >> 2, kvh = gI & 3, qh = kvh * 4 + (r >> 5), qb = r & 31;
            const size_t qoff = (size_t)(b * SEQ + qb * 256) * 2048 + qh * 128, koff = (size_t)(b * SEQ) * 512 + kvh * 128;
            attn::attn_dense_body(QA + qoff, KA + koff, VA + koff, QA + qoff, SEQ, (char*)lds); }
        if (BOTH(4)) GRID_BAR();
    }
    if (IN(5)) { combine_pass(F, I); if (BOTH(5)) GRID_BAR(); }
    if (IN(6)) {
        pg8::Gemm g{QA, (bf16*)(ws + WS_WPA), M, DM, ATTN_DIM}; pg8::StaticOrder S; S.init(M, DM, F.G, (int)blockIdx.x);
        pg8::EpiGateMulBf16 E{(bf16*)F.out, DM, GATE, 2 * DM, 0};
        if (REPEAT_PHASE == 6) { pg8::gemm_phase<pg8::EpiGateMulBf16, pg8::StaticOrder, true, true>(F.lds, g, S, E); GRID_BAR(); }
        pg8::gemm_phase<pg8::EpiGateMulBf16, pg8::StaticOrder, true, true>(F.lds, g, S, E);
        if (BOTH(6)) GRID_BAR();
    }
    if (IN(7)) {
        pg8::Gemm g{QF, (bf16*)(ws + WS_WPB), M, DM, HQK}; pg8::StaticOrder S; S.init(M, DM, F.G, (int)blockIdx.x);
        pg8::EpiGateAddBf16 E{MIX, (const bf16*)F.out, DM, GATE, 2 * DM, DM};
        if (REPEAT_PHASE == 7) { pg8::gemm_phase<pg8::EpiGateAddBf16, pg8::StaticOrder, true, true>(F.lds, g, S, E); GRID_BAR(); }
        pg8::gemm_phase<pg8::EpiGateAddBf16, pg8::StaticOrder, true, true>(F.lds, g, S, E);
        if (BOTH(7)) GRID_BAR();
    }
    if (IN(8)) {
        pg8::Gemm g{MIX, (bf16*)(ws + WS_WO), M, DM, DM}; pg8::StaticOrder S; S.init(M, DM, F.G, (int)blockIdx.x);
        pg8::EpiAxpyF32 E{I.x, F.out, DM, DN_ALPHA};
        if (REPEAT_PHASE == 8) { pg8::gemm_phase<pg8::EpiAxpyF32, pg8::StaticOrder, true, true>(F.lds, g, S, E); GRID_BAR(); }
        pg8::gemm_phase<pg8::EpiAxpyF32, pg8::StaticOrder, true, true>(F.lds, g, S, E);
        if (BOTH(8)) GRID_BAR();
    }
    if (IN(9)) { if (REPEAT_PHASE == 9) { ln_pass(F, F.out, X1B, I.ln1_g, I.ln1_b, (float*)(ws + WS_UB)); GRID_BAR(); } ln_pass(F, F.out, X1B, I.ln1_g, I.ln1_b, F.out); if (BOTH(9)) GRID_BAR(); }
    if (IN(10)) {
        pg8::Gemm g{X1B, (bf16*)(ws + WS_WUP), M, 2 * DFF, DM}; pg8::StaticOrder S; S.init(M, 2 * DFF, F.G, (int)blockIdx.x);
        pg8::EpiBf16 E{UB, DFF, DFF, (size_t)M * DFF};
        if (REPEAT_PHASE == 10) { pg8::gemm_phase<pg8::EpiBf16, pg8::StaticOrder, true, true>(F.lds, g, S, E); GRID_BAR(); }
        pg8::gemm_phase<pg8::EpiBf16, pg8::StaticOrder, true, true>(F.lds, g, S, E);
        if (BOTH(10)) GRID_BAR();
    }
    if (IN(11)) { conv_pass(F, I); if (BOTH(11)) GRID_BAR(); }
    if (IN(12)) {
        pg8::Gemm g{UB, (bf16*)(ws + WS_WDN), M, DM, DFF}; pg8::StaticOrder S; S.init(M, DM, F.G, (int)blockIdx.x);
        pg8::EpiAxpyF32 E{F.out, F.out, DM, DN_ALPHA};
        if (REPEAT_PHASE == 12) { pg8::EpiAxpyF32 E2{F.out, PE, DM, DN_ALPHA}; pg8::gemm_phase<pg8::EpiAxpyF32, pg8::StaticOrder, true, true>(F.lds, g, S, E2); GRID_BAR(); }
        pg8::gemm_phase<pg8::EpiAxpyF32, pg8::StaticOrder, true, true>(F.lds, g, S, E);
        if (BOTH(12)) GRID_BAR();
    }
    if (IN(13)) { ln_pass(F, F.out, X1B, I.ln2_g, I.ln2_b, F.out); if (BOTH(13)) GRID_BAR(); }
    if (IN(14)) {
        pg8::Gemm g{(bf16*)(ws + WS_PB), (bf16*)(ws + WS_WPLE), M, DM, PLE}; pg8::StaticOrder S; S.init(M, DM, F.G, (int)blockIdx.x);
        pg8::EpiGateMulF32 E{PE, DM, nullptr, 0, 0};
        pg8::gemm_phase<pg8::EpiGateMulF32, pg8::StaticOrder, true, true>(F.lds, g, S, E);
        if (BOTH(14)) GRID_BAR();
    }
    if (IN(15)) {
        pg8::Gemm g{X1B, (bf16*)(ws + WS_WPG), M, DM, DM}; pg8::StaticOrder S; S.init(M, DM, F.G, (int)blockIdx.x);
        pg8::EpiFinal E{F.out, PE, DM};
        pg8::gemm_phase<pg8::EpiFinal, pg8::StaticOrder, true, true>(F.lds, g, S, E);
    }
#undef IN
#undef BOTH
#undef GRID_BAR
}

extern "C" void kernel_launch(void* const* d_in, const int* in_sizes, int n_in, void* d_out, int out_size, void* d_ws, size_t ws_size, hipStream_t stream) {
    static int grid = 0;
    if (grid == 0) {
        if (n_in != 22 || in_sizes[0] != M * DM || out_size != M * DM || ws_size < WS_END) { fprintf(stderr, "kernel_launch: shape mismatch n_in %d in0 %d out %d ws %zu (need %zu)\n", n_in, n_in > 0 ? in_sizes[0] : -1, out_size, ws_size, (size_t)WS_END); grid = -1; return; }
        int dev = 0, cus = 0, per_cu = 0;
        if (hipGetDevice(&dev) != hipSuccess || hipDeviceGetAttribute(&cus, hipDeviceAttributeMultiprocessorCount, dev) != hipSuccess) { grid = -1; return; }
        if (hipFuncSetAttribute((const void*)mk_fwd, hipFuncAttributeMaxDynamicSharedMemorySize, LDS_BYTES) != hipSuccess) { fprintf(stderr, "kernel_launch: hipFuncSetAttribute failed\n"); grid = -1; return; }
        if (hipOccupancyMaxActiveBlocksPerMultiprocessor(&per_cu, (const void*)mk_fwd, NWAVES * 64, LDS_BYTES) != hipSuccess || per_cu < 1) fprintf(stderr, "kernel_launch: occupancy query says %d\n", per_cu);
        (void)hipGetLastError();
        grid = cus;
        if (grid != 256) { fprintf(stderr, "kernel_launch: built for 256 CUs, got %d; nothing launched\n", grid); grid = -1; return; }
    }
    if (grid < 0) return;
    (void)hipMemsetAsync((char*)d_ws + WS_CTL, 0, CTL_ZERO_BYTES, stream);
    Args a{};
    const float** ip = (const float**)&a.in;
    for (int i = 0; i < 22; ++i) ip[i] = (const float*)d_in[i];
    a.out = (float*)d_out; a.ws = (unsigned char*)d_ws; a.pad = 0;
    if (N_LAUNCHES == 1) { a.ph_lo = 0; a.ph_hi = N_PHASES; a.li = 0; hipLaunchKernelGGL(mk_fwd, dim3(grid), dim3(NWAVES * 64), LDS_BYTES, stream, a); }
    else for (int li = 0; li < N_PHASES; ++li) { a.ph_lo = li; a.ph_hi = li + 1; a.li = li; hipLaunchKernelGGL(mk_fwd, dim3(grid), dim3(NWAVES * 64), LDS_BYTES, stream, a); }
    const hipError_t le = hipPeekAtLastError();
    if (le != hipSuccess) fprintf(stderr, "kernel_launch: launch failed: %s\n", hipGetErrorName(le));
}
```

```cpp
#include <hip/hip_runtime.h>
#include <cstdio>
#include <cstdint>
namespace pg8 {
#define PG8_LAS __attribute__((address_space(3)))
typedef unsigned short bf16_t;
typedef short bf16x8 __attribute__((ext_vector_type(8)));
typedef float f32x4 __attribute__((ext_vector_type(4)));
typedef unsigned u32x4 __attribute__((ext_vector_type(4)));
constexpr int BM = 256, BK = 64, HALF = 128, HTB = HALF * BK * 2  , STAGE_BYTES = 8 * HTB, NXCD = 8, WGM = 8;

__host__ __device__ __forceinline__ int lds_byte(int r, int c) { const int st = (r >> 4) * 2 + (c >> 5), rr = r & 15, cc = c & 31, ob = rr * 64 + cc * 2; return st * 1024 + (ob ^ (((ob >> 9) & 1) << 5)); }
__host__ __device__ __forceinline__ void stage_rc(int b, int& R, int& C) { const int st = b / 1024, sb = b % 1024, swz = sb ^ (((sb >> 9) & 1) << 5); R = (st >> 1) * 16 + swz / 64; C = (st & 1) * 32 + (swz % 64) / 2; }
__host__ __device__ __forceinline__ int perm32(int rho) { const int n = rho >> 4, i = rho & 15; return 8 * (i >> 2) + 4 * n + (i & 3); }

struct Unit { int pm, pn; };
struct Gemm { const bf16_t* A; const bf16_t* Bt; int M, N, K; };

struct StaticOrder {
    int nM, nN, nwg, G, c;
    __host__ __device__ void init(int M, int N, int G_, int c_) { nM = M / BM; nN = N / BM; nwg = nM * nN; G = G_; c = c_; }
    __host__ __device__ bool next(int i, Unit& u) const {
        const long L = (long)i * G + c; if (L >= nwg) return false;
        int wgid = (int)L; { const int q = nwg / NXCD, r = nwg % NXCD, xcd = wgid % NXCD, off = wgid / NXCD; wgid = (xcd < r ? xcd * (q + 1) : r * (q + 1) + (xcd - r) * q) + off; }
        const int nig = WGM * nN, gid = wgid / nig, fm = gid * WGM, gsz = (nM - fm) < WGM ? (nM - fm) : WGM;
        u.pm = fm + ((wgid % nig) % gsz); u.pn = (wgid % nig) / gsz; return true;
    }
    __device__ __forceinline__ void a_ready(const Unit&) const {}
    __device__ __forceinline__ void done(const Unit&) const {}
};

struct SplitOrder {
    int c;
    __host__ __device__ bool next(int i, Unit& u) const {
        int L;
        if (c < 64) { if (i >= 5) return false; L = 768 + i * 256 + c; }
        else { if (i >= 9) return false; L = (i < 4) ? i * 192 + (c - 64) : 768 + (i - 4) * 256 + c; }
        const int wgid = (L % NXCD) * 256 + L / NXCD;
        const int gid = wgid / 256, fm = gid * WGM, rem = wgid % 256;
        u.pm = fm + rem % WGM; u.pn = rem / WGM; return true;
    }
    __device__ __forceinline__ void a_ready(const Unit&) const {}
    __device__ __forceinline__ void done(const Unit&) const {}
};

struct SameTileOrder : StaticOrder {
    __host__ __device__ bool next(int i, Unit& u) const { const long L = (long)i * G + c; if (L >= nwg) return false; u.pm = c & 7; u.pn = (c >> 3) & 7; return true; }
};

struct PeOrder {
    int c;
    __host__ __device__ bool next(int i, Unit& u) const {
        if (c < 128 || i >= 8) return false;
        const int L = (c - 128) * 8 + i;
        u.pm = L >> 4; u.pn = L & 15; return true;
    }
    __device__ __forceinline__ void a_ready(const Unit&) const {}
    __device__ __forceinline__ void done(const Unit&) const {}
};

struct DynOrder {
    unsigned* ctr; PG8_LAS volatile int* slots; int xcd; int limit = 256;
    __device__ __forceinline__ void prime() const {
        if (threadIdx.x == 0) { slots[0] = (int)__hip_atomic_fetch_add(ctr, 1u, __ATOMIC_RELAXED, __HIP_MEMORY_SCOPE_AGENT); slots[1] = (int)__hip_atomic_fetch_add(ctr, 1u, __ATOMIC_RELAXED, __HIP_MEMORY_SCOPE_AGENT); }
        __syncthreads();
    }
    __device__ __forceinline__ bool next(int i, Unit& u) const {
        const int t = __builtin_amdgcn_readfirstlane(slots[i & 3]);
        if (i >= 1 && threadIdx.x == 0) slots[(i + 1) & 3] = (int)__hip_atomic_fetch_add(ctr, 1u, __ATOMIC_RELAXED, __HIP_MEMORY_SCOPE_AGENT);
        if (t >= limit) return false;
        const int fm = xcd * WGM; u.pm = fm + t % WGM; u.pn = t / WGM; return true;
    }
    __device__ __forceinline__ void a_ready(const Unit&) const {}
    __device__ __forceinline__ void done(const Unit&) const {}
};
__device__ __forceinline__ unsigned cvt_pk_bf16(float lo, float hi) { unsigned r; asm volatile("v_cvt_pk_bf16_f32 %0, %1, %2" : "=v"(r) : "v"(lo), "v"(hi)); return r; }
typedef unsigned u32x2 __attribute__((ext_vector_type(2)));
__device__ __forceinline__ float bf_lo(unsigned w) { return __uint_as_float(w << 16); }
__device__ __forceinline__ float bf_hi(unsigned w) { return __uint_as_float(w & 0xffff0000u); }
__device__ __forceinline__ float sigmoid_f(float v) { return __builtin_amdgcn_rcpf(1.0f + __expf(-v)); }

struct EpiBf16 {
    static constexpr bool PERM = true, AFTER_DRAIN = false; static constexpr int MID_K = -1;
    bf16_t* O; int ldc; int split_cols; size_t split_stride;
    __device__ __forceinline__ void operator()(const f32x4 (&acc)[2][2][4][2], const Unit& u, int wr, int wc, int fr, int fq) const {
        const int row0 = u.pm * BM + wr * 64 + fr; int colt = u.pn * BM; bf16_t* base = O;
        if (split_cols) { const int t = colt / split_cols; base += (size_t)t * split_stride; colt -= t * split_cols; }
        const int col0 = colt + wc * 32 + 8 * fq;
#pragma unroll
        for (int ai = 0; ai < 2; ++ai)
#pragma unroll
            for (int m = 0; m < 4; ++m) { bf16_t* rowp = base + (size_t)(row0 + ai * HALF + m * 16) * ldc + col0;
#pragma unroll
                for (int bj = 0; bj < 2; ++bj) { const f32x4 v0 = acc[ai][bj][m][0], v1 = acc[ai][bj][m][1];
                    u32x4 w; w.x = cvt_pk_bf16(v0[0], v0[1]); w.y = cvt_pk_bf16(v0[2], v0[3]); w.z = cvt_pk_bf16(v1[0], v1[1]); w.w = cvt_pk_bf16(v1[2], v1[3]);
                    *(u32x4*)(rowp + bj * HALF) = w; } }
    }
    struct Ctx { bf16_t* base; int cadj; };
    __device__ __forceinline__ Ctx begin(const Unit& u) const { Ctx c{O, 0}; if (split_cols) { const int t = (u.pn * BM) / split_cols; c.base += (size_t)t * split_stride; c.cadj = -t * split_cols; } return c; }
    __device__ __forceinline__ void chunk4(const Ctx& c, int row, int col, f32x4& v) const {
        typedef unsigned u32x2_e __attribute__((ext_vector_type(2)));
        *(u32x2_e*)(c.base + (size_t)row * ldc + col + c.cadj) = (u32x2_e){cvt_pk_bf16(v[0], v[1]), cvt_pk_bf16(v[2], v[3])}; }
};
struct EpiBf16S {
    static constexpr bool PERM = true, AFTER_DRAIN = false; static constexpr int MID_K = -1;
    bf16_t* O; int ldc; int split_cols; size_t split_stride; float ascale;
    __device__ __forceinline__ void operator()(const f32x4 (&acc)[2][2][4][2], const Unit& u, int wr, int wc, int fr, int fq) const {
        const int row0 = u.pm * BM + wr * 64 + fr; int colt = u.pn * BM; bf16_t* base = O;
        if (split_cols) { const int t = colt / split_cols; base += (size_t)t * split_stride; colt -= t * split_cols; }
        const int col0 = colt + wc * 32 + 8 * fq;
#pragma unroll
        for (int ai = 0; ai < 2; ++ai)
#pragma unroll
            for (int m = 0; m < 4; ++m) { bf16_t* rowp = base + (size_t)(row0 + ai * HALF + m * 16) * ldc + col0;
#pragma unroll
                for (int bj = 0; bj < 2; ++bj) { const f32x4 v0 = acc[ai][bj][m][0] * ascale, v1 = acc[ai][bj][m][1] * ascale;
                    u32x4 w; w.x = cvt_pk_bf16(v0[0], v0[1]); w.y = cvt_pk_bf16(v0[2], v0[3]); w.z = cvt_pk_bf16(v1[0], v1[1]); w.w = cvt_pk_bf16(v1[2], v1[3]);
                    *(u32x4*)(rowp + bj * HALF) = w; } }
    }
};
struct EpiProj {
    static constexpr bool PERM = true, AFTER_DRAIN = false; static constexpr int MID_K = -1;
    bf16_t *QA, *KA, *VA, *QH, *ZF, *ZB, *IH, *GH, *GATE; const float* bgate; int col_base; float ascale; int skip_at, skip_by;
    __device__ __forceinline__ void operator()(const f32x4 (&acc)[2][2][4][2], const Unit& u, int wr, int wc, int fr, int fq) const {
        const int row0 = u.pm * BM + wr * 64 + fr; int colt = u.pn * BM + col_base; bf16_t* base; int ldc = 2048; int act = 0; const float* bias = nullptr;
        if (colt >= skip_at) colt += skip_by;
        if (colt < 2048) { base = QA; }
        else if (colt < 2560) { base = KA; ldc = 512; colt -= 2048; }
        else if (colt < 3072) { base = VA; ldc = 512; colt -= 2560; }
        else if (colt < 5120) { base = QH; colt -= 3072; act = 1; }
        else if (colt < 7168) { base = ZF; colt -= 5120; }
        else if (colt < 9216) { base = ZB; colt -= 7168; }
        else if (colt < 11264) { base = IH; colt -= 9216; }
        else if (colt < 13312) { base = GH; colt -= 11264; act = 1; }
        else { base = GATE; ldc = 8192; colt -= 13312; act = 2; bias = bgate; }
        const int col0 = colt + wc * 32 + 8 * fq;
        f32x4 bv[2][2];
#pragma unroll
        for (int bj = 0; bj < 2; ++bj)
#pragma unroll
            for (int n = 0; n < 2; ++n) bv[bj][n] = bias ? *(const f32x4*)(bias + col0 + bj * HALF + 4 * n) : (f32x4){0.f, 0.f, 0.f, 0.f};
#pragma unroll
        for (int ai = 0; ai < 2; ++ai)
#pragma unroll
            for (int m = 0; m < 4; ++m) { bf16_t* rowp = base + (size_t)(row0 + ai * HALF + m * 16) * ldc + col0;
#pragma unroll
                for (int bj = 0; bj < 2; ++bj) { f32x4 v0 = acc[ai][bj][m][0] * ascale + bv[bj][0], v1 = acc[ai][bj][m][1] * ascale + bv[bj][1];
                    if (act != 0) {
#pragma unroll
                        for (int j = 0; j < 4; ++j) { const float s0 = sigmoid_f(v0[j]), s1 = sigmoid_f(v1[j]); v0[j] = (act == 1) ? v0[j] * s0 : s0; v1[j] = (act == 1) ? v1[j] * s1 : s1; } }
                    u32x4 w; w.x = cvt_pk_bf16(v0[0], v0[1]); w.y = cvt_pk_bf16(v0[2], v0[3]); w.z = cvt_pk_bf16(v1[0], v1[1]); w.w = cvt_pk_bf16(v1[2], v1[3]);
                    *(u32x4*)(rowp + bj * HALF) = w; } }
    }
};
struct EpiGateMulF32 {
    static constexpr bool PERM = false, AFTER_DRAIN = false; static constexpr int MID_K = -1;
    float* out; int ldc; const bf16_t* gate; int ldg; int goff;
    __device__ __forceinline__ void operator()(const f32x4 (&acc)[2][2][4][2], const Unit& u, int wr, int wc, int fr, int fq) const {
        const int row0 = u.pm * BM + wr * 64 + fr, col0 = u.pn * BM + wc * 32 + 4 * fq;
#pragma unroll
        for (int ai = 0; ai < 2; ++ai)
#pragma unroll
            for (int m = 0; m < 4; ++m) { const int row = row0 + ai * HALF + m * 16; float* rowp = out + (size_t)row * ldc + col0;
#pragma unroll
                for (int bj = 0; bj < 2; ++bj)
#pragma unroll
                    for (int n = 0; n < 2; ++n) { f32x4 v = acc[ai][bj][m][n];
                        if (gate) { const u32x2 gw = *(const u32x2*)(gate + (size_t)row * ldg + goff + col0 + bj * HALF + n * 16);
                            v = v * (f32x4){bf_lo(gw.x), bf_hi(gw.x), bf_lo(gw.y), bf_hi(gw.y)}; }
                        *(f32x4*)(rowp + bj * HALF + n * 16) = v; } }
    }
};
struct EpiGate {
    static constexpr bool PERM = true, AFTER_DRAIN = false; static constexpr int MID_K = -1;
    bf16_t* G; int ldg; const float* bgate; float ascale;
    __device__ __forceinline__ void operator()(const f32x4 (&acc)[2][2][4][2], const Unit& u, int, int, int, int) const {
        int t_ = (int)threadIdx.x; asm volatile("" : "+v"(t_));
        const int wid_ = t_ >> 6, wr = wid_ >> 2, wc = wid_ & 3, fr = t_ & 15, fq = (t_ >> 4) & 3;
        const int row0 = u.pm * BM + wr * 64 + fr, c0 = u.pn * HALF + wc * 32 + 8 * fq;
#pragma unroll
        for (int ai = 0; ai < 2; ++ai)
#pragma unroll
            for (int m = 0; m < 4; ++m) { bf16_t* rowp = G + (size_t)(row0 + ai * HALF + m * 16) * ldg + c0;
                const f32x4 ba0 = *(const f32x4*)(bgate + c0), ba1 = *(const f32x4*)(bgate + c0 + 4), bh0 = *(const f32x4*)(bgate + 4096 + c0), bh1 = *(const f32x4*)(bgate + 4096 + c0 + 4);
                const f32x4 a0 = acc[ai][0][m][0] * ascale + ba0, a1 = acc[ai][0][m][1] * ascale + ba1, h0 = acc[ai][1][m][0] * ascale + bh0, h1 = acc[ai][1][m][1] * ascale + bh1;
                f32x4 r0, r1, g0, g1;
#pragma unroll
                for (int j = 0; j < 4; ++j) { g0[j] = fmaxf(sigmoid_f(h0[j]), 1e-30f); g1[j] = fmaxf(sigmoid_f(h1[j]), 1e-30f);
                    r0[j] = sigmoid_f(a0[j]) * __builtin_amdgcn_rcpf(g0[j]); r1[j] = sigmoid_f(a1[j]) * __builtin_amdgcn_rcpf(g1[j]); }
                u32x4 w; w.x = cvt_pk_bf16(r0[0], r0[1]); w.y = cvt_pk_bf16(r0[2], r0[3]); w.z = cvt_pk_bf16(r1[0], r1[1]); w.w = cvt_pk_bf16(r1[2], r1[3]);
                *(u32x4*)rowp = w;
                w.x = cvt_pk_bf16(g0[0], g0[1]); w.y = cvt_pk_bf16(g0[2], g0[3]); w.z = cvt_pk_bf16(g1[0], g1[1]); w.w = cvt_pk_bf16(g1[2], g1[3]);
                *(u32x4*)(rowp + 4096) = w;
                asm volatile("" ::: "memory"); }
    }
};
struct EpiMix {
    static constexpr bool PERM = true, AFTER_DRAIN = false; static constexpr int MID_K = 16;
    unsigned char* O8; int ldc; const bf16_t* gate; int ldg; float oscale; float midscale;
    __device__ __forceinline__ void mid(f32x4 (&acc)[2][2][4][2], const Unit& u, int wr, int wc, int fr, int fq) const {
        int row0 = u.pm * BM + wr * 64 + fr, col0 = u.pn * BM + wc * 32 + 8 * fq;
        asm volatile("" : "+v"(row0), "+v"(col0));
#pragma unroll
        for (int ai = 0; ai < 2; ++ai)
#pragma unroll
            for (int m = 0; m < 4; ++m) { const bf16_t* gp = gate + (size_t)(row0 + ai * HALF + m * 16) * ldg + col0;
#pragma unroll
                for (int bj = 0; bj < 2; ++bj) { const u32x4 ga = *(const u32x4*)(gp + bj * HALF);
                    const unsigned gaw[4] = {ga.x, ga.y, ga.z, ga.w};
#pragma unroll
                    for (int q = 0; q < 4; ++q) { acc[ai][bj][m][q >> 1][(q & 1) * 2] *= bf_lo(gaw[q]) * midscale; acc[ai][bj][m][q >> 1][(q & 1) * 2 + 1] *= bf_hi(gaw[q]) * midscale; } }
                asm volatile("" ::: "memory"); }
    }
    __device__ __forceinline__ void operator()(const f32x4 (&acc)[2][2][4][2], const Unit& u, int wr, int wc, int fr, int fq) const {
        const int row0 = u.pm * BM + wr * 64 + fr, col0 = u.pn * BM + wc * 32 + 8 * fq;
#pragma unroll
        for (int ai = 0; ai < 2; ++ai)
#pragma unroll
            for (int m = 0; m < 4; ++m) { const int row = row0 + ai * HALF + m * 16;
#pragma unroll
                for (int bj = 0; bj < 2; ++bj) { const u32x4 gw = *(const u32x4*)(gate + (size_t)row * ldg + ldc + col0 + bj * HALF);
                    const f32x4 v0 = acc[ai][bj][m][0] * (f32x4){fmaxf(bf_lo(gw.x), 1e-30f), fmaxf(bf_hi(gw.x), 1e-30f), fmaxf(bf_lo(gw.y), 1e-30f), fmaxf(bf_hi(gw.y), 1e-30f)};
                    const f32x4 v1 = acc[ai][bj][m][1] * (f32x4){fmaxf(bf_lo(gw.z), 1e-30f), fmaxf(bf_hi(gw.z), 1e-30f), fmaxf(bf_lo(gw.w), 1e-30f), fmaxf(bf_hi(gw.w), 1e-30f)};
                    unsigned lo8 = 0u, hi8 = 0u;
                    lo8 = (unsigned)__builtin_amdgcn_cvt_pk_fp8_f32(v0[0] * oscale, v0[1] * oscale, (int)lo8, false); lo8 = (unsigned)__builtin_amdgcn_cvt_pk_fp8_f32(v0[2] * oscale, v0[3] * oscale, (int)lo8, true);
                    hi8 = (unsigned)__builtin_amdgcn_cvt_pk_fp8_f32(v1[0] * oscale, v1[1] * oscale, (int)hi8, false); hi8 = (unsigned)__builtin_amdgcn_cvt_pk_fp8_f32(v1[2] * oscale, v1[3] * oscale, (int)hi8, true);
                    typedef unsigned u32x2_e __attribute__((ext_vector_type(2)));
                    *(u32x2_e*)(O8 + (size_t)row * ldc + col0 + bj * HALF) = (u32x2_e){lo8, hi8}; } }
    }
};
struct EpiGateMulBf16 {
    static constexpr bool PERM = true, AFTER_DRAIN = false; static constexpr int MID_K = -1;
    bf16_t* O; int ldc; const bf16_t* gate; int ldg; int goff;
    __device__ __forceinline__ void operator()(const f32x4 (&acc)[2][2][4][2], const Unit& u, int wr, int wc, int fr, int fq) const {
        const int row0 = u.pm * BM + wr * 64 + fr, col0 = u.pn * BM + wc * 32 + 8 * fq;
#pragma unroll
        for (int ai = 0; ai < 2; ++ai)
#pragma unroll
            for (int m = 0; m < 4; ++m) { const int row = row0 + ai * HALF + m * 16;
#pragma unroll
                for (int bj = 0; bj < 2; ++bj) { const size_t off = (size_t)row * ldc + col0 + bj * HALF;
                    const u32x4 gw = *(const u32x4*)(gate + (size_t)row * ldg + goff + col0 + bj * HALF);
                    const f32x4 v0 = acc[ai][bj][m][0] * (f32x4){bf_lo(gw.x), bf_hi(gw.x), bf_lo(gw.y), bf_hi(gw.y)};
                    const f32x4 v1 = acc[ai][bj][m][1] * (f32x4){bf_lo(gw.z), bf_hi(gw.z), bf_lo(gw.w), bf_hi(gw.w)};
                    u32x4 w; w.x = cvt_pk_bf16(v0[0], v0[1]); w.y = cvt_pk_bf16(v0[2], v0[3]); w.z = cvt_pk_bf16(v1[0], v1[1]); w.w = cvt_pk_bf16(v1[2], v1[3]);
                    *(u32x4*)(O + off) = w; } }
    }
};
struct EpiGateAddBf16 {
    static constexpr bool PERM = true, AFTER_DRAIN = false; static constexpr int MID_K = -1;
    bf16_t* O; const bf16_t* T; int ldc; const bf16_t* gate; int ldg; int goff;
    __device__ __forceinline__ void operator()(const f32x4 (&acc)[2][2][4][2], const Unit& u, int wr, int wc, int fr, int fq) const {
        const int row0 = u.pm * BM + wr * 64 + fr, col0 = u.pn * BM + wc * 32 + 8 * fq;
#pragma unroll
        for (int ai = 0; ai < 2; ++ai)
#pragma unroll
            for (int m = 0; m < 4; ++m) { const int row = row0 + ai * HALF + m * 16;
#pragma unroll
                for (int bj = 0; bj < 2; ++bj) { const size_t off = (size_t)row * ldc + col0 + bj * HALF;
                    const u32x4 gw = *(const u32x4*)(gate + (size_t)row * ldg + goff + col0 + bj * HALF);
                    const u32x4 tw = *(const u32x4*)(T + off);
                    const f32x4 t0 = (f32x4){bf_lo(tw.x), bf_hi(tw.x), bf_lo(tw.y), bf_hi(tw.y)}, t1 = (f32x4){bf_lo(tw.z), bf_hi(tw.z), bf_lo(tw.w), bf_hi(tw.w)};
                    const f32x4 v0 = t0 + acc[ai][bj][m][0] * (f32x4){bf_lo(gw.x), bf_hi(gw.x), bf_lo(gw.y), bf_hi(gw.y)};
                    const f32x4 v1 = t1 + acc[ai][bj][m][1] * (f32x4){bf_lo(gw.z), bf_hi(gw.z), bf_lo(gw.w), bf_hi(gw.w)};
                    u32x4 w; w.x = cvt_pk_bf16(v0[0], v0[1]); w.y = cvt_pk_bf16(v0[2], v0[3]); w.z = cvt_pk_bf16(v1[0], v1[1]); w.w = cvt_pk_bf16(v1[2], v1[3]);
                    *(u32x4*)(O + off) = w; } }
    }
};
struct EpiAxpyF32 {
    static constexpr bool PERM = false, AFTER_DRAIN = false; static constexpr int MID_K = -1;
    const float* base; float* out; int ldc; float alpha;
    __device__ __forceinline__ void operator()(const f32x4 (&acc)[2][2][4][2], const Unit& u, int wr, int wc, int fr, int fq) const {
        const int row0 = u.pm * BM + wr * 64 + fr, col0 = u.pn * BM + wc * 32 + 4 * fq;
#pragma unroll
        for (int ai = 0; ai < 2; ++ai)
#pragma unroll
            for (int m = 0; m < 4; ++m) { const size_t off = (size_t)(row0 + ai * HALF + m * 16) * ldc + col0;
#pragma unroll
                for (int bj = 0; bj < 2; ++bj)
#pragma unroll
                    for (int n = 0; n < 2; ++n) { const f32x4 bs = *(const f32x4*)(base + off + bj * HALF + n * 16);
                        *(f32x4*)(out + off + bj * HALF + n * 16) = bs * alpha + acc[ai][bj][m][n]; }
                asm volatile("" ::: "memory"); }
    }
};
struct EpiFinal {
    static constexpr bool PERM = true, AFTER_DRAIN = false; static constexpr int MID_K = -1;
    const bf16_t* x2; float* out; const bf16_t* pe; int ldc;
    __device__ __forceinline__ void operator()(const f32x4 (&acc)[2][2][4][2], const Unit& u, int wr, int wc, int fr, int fq) const {
        const int row0 = u.pm * BM + wr * 64 + fr, col0 = u.pn * BM + wc * 32 + 8 * fq;
#pragma unroll
        for (int ai = 0; ai < 2; ++ai)
#pragma unroll
            for (int m = 0; m < 4; ++m) { const int row = row0 + ai * HALF + m * 16;
#pragma unroll
                for (int bj = 0; bj < 2; ++bj) { const size_t off = (size_t)row * ldc + col0 + bj * HALF;
                    const u32x4 xw = *(const u32x4*)(x2 + off), pw = *(const u32x4*)(pe + off);
                    const f32x4 a0 = acc[ai][bj][m][0], a1 = acc[ai][bj][m][1];
                    const f32x4 x0 = (f32x4){bf_lo(xw.x), bf_hi(xw.x), bf_lo(xw.y), bf_hi(xw.y)}, x1 = (f32x4){bf_lo(xw.z), bf_hi(xw.z), bf_lo(xw.w), bf_hi(xw.w)};
                    const f32x4 p0 = (f32x4){bf_lo(pw.x), bf_hi(pw.x), bf_lo(pw.y), bf_hi(pw.y)}, p1 = (f32x4){bf_lo(pw.z), bf_hi(pw.z), bf_lo(pw.w), bf_hi(pw.w)};
                    f32x4 o0, o1;
#pragma unroll
                    for (int j = 0; j < 4; ++j) { o0[j] = x0[j] + sigmoid_f(a0[j]) * p0[j]; o1[j] = x1[j] + sigmoid_f(a1[j]) * p1[j]; }
                    *(f32x4*)(out + off) = o0; *(f32x4*)(out + off + 4) = o1; }
                asm volatile("" ::: "memory"); }
    }
};

struct EpiNull {
    static constexpr bool PERM = true, AFTER_DRAIN = false; static constexpr int MID_K = -1;
    bf16_t* O; int never;
    __device__ __forceinline__ void operator()(const f32x4 (&acc)[2][2][4][2], const Unit& u, int wr, int wc, int fr, int fq) const {
        f32x4 s = (f32x4){0.f, 0.f, 0.f, 0.f};
#pragma unroll
        for (int ai = 0; ai < 2; ++ai)
#pragma unroll
            for (int m = 0; m < 4; ++m)
#pragma unroll
                for (int bj = 0; bj < 2; ++bj) s += acc[ai][bj][m][0] + acc[ai][bj][m][1];
        if (u.pm < never) *(f32x4*)(O + (size_t)(threadIdx.x) * 8) = s;
    }
};
typedef int pg8_v8i __attribute__((ext_vector_type(8)));
template <class Epi, class Sched, bool ALIGN_EPI = false, bool SP2 = false, bool F8T = false, int DBG = 0, bool TWO = false>
__device__ __forceinline__ void gemm_phase(PG8_LAS unsigned char* lds, const Gemm g, const Sched& S, const Epi& E) {
    const int tid = threadIdx.x, wid = __builtin_amdgcn_readfirstlane(tid >> 6), lane = tid & 63, wr = wid >> 2, wc = wid & 3, fr = lane & 15, fq = lane >> 4;
    constexpr bool F8 = F8T;
    const int K = g.K, nt = TWO ? 48 : K / BK;
    unsigned voffA[2], voffB[2];
#pragma unroll
    for (int i = 0; i < 2; ++i) { int R, C; stage_rc(tid * 16 + i * 8192, R, C); const int Rb = Epi::PERM ? ((R & ~31) + perm32(R & 31)) : R;
        voffA[i] = (unsigned)(R * K + C) * 2u; voffB[i] = (unsigned)(Rb * K + C) * 2u; }
    const size_t kstep = (size_t)(BK * 2);
    const size_t hstep = (size_t)HALF * K * 2;
    const size_t tstep = 2 * hstep;
    const unsigned ldsw = (unsigned)wid * 1024u;
    const int aoffH = lds_byte(wr * 64 + fr, fq * 8), boffH = lds_byte(wc * 32 + fr, fq * 8), aoffQ = lds_byte(wr * 64 + fr, fq * 16), boffQ = lds_byte(wc * 32 + fr, fq * 16);
#define aoff (F8 ? aoffQ : aoffH)
#define boff (F8 ? boffQ : boffH)
#define PG8_TT(x) (TWO ? ((x) < 16 ? (x) : (x) + 16) : (x))
#define PG8_SA(b, h) (((b) * 2 + (h)) * HTB)
#define PG8_SB(b, h) ((4 + (b) * 2 + (h)) * HTB)
#define PG8_STAGE(bufoff, gbase, voff) do { if constexpr ((DBG & 1) || (DBG & 2)) break; _Pragma("unroll") for (int _i = 0; _i < 2; ++_i) \
        __builtin_amdgcn_global_load_lds((const unsigned*)((const char*)(gbase) + (voff)[_i]), (PG8_LAS unsigned*)(lds + (bufoff) + ldsw + _i * 8192), 16, 0, 0); } while (0)
#define PG8_LD32(off) __builtin_shufflevector(*(const PG8_LAS f32x4*)(lds + (off)), *(const PG8_LAS f32x4*)(lds + (off) + 16), 0, 1, 2, 3, 4, 5, 6, 7)
#define PG8_LDA(dst, b, h) do { if constexpr ((DBG & 1) || (DBG & 4)) { asm volatile("" : "+v"(dst[0][0])); break; } if constexpr (F8) { _Pragma("unroll") for (int m = 0; m < 4; ++m) dst##8[m] = __builtin_bit_cast(pg8_v8i, PG8_LD32(PG8_SA(b, h) + aoff + m * 2048)); } \
        else { _Pragma("unroll") for (int m = 0; m < 4; ++m) _Pragma("unroll") for (int k = 0; k < 2; ++k) dst[m][k] = *(const PG8_LAS bf16x8*)(lds + PG8_SA(b, h) + aoff + m * 2048 + k * 1024); } } while (0)
#define PG8_LDB(dst, b, h) do { if constexpr ((DBG & 1) || (DBG & 4)) { asm volatile("" : "+v"(dst[0][0])); break; } if constexpr (F8) { _Pragma("unroll") for (int n = 0; n < 2; ++n) dst##8[n] = __builtin_bit_cast(pg8_v8i, PG8_LD32(PG8_SB(b, h) + boff + n * 2048)); } \
        else { _Pragma("unroll") for (int n = 0; n < 2; ++n) _Pragma("unroll") for (int k = 0; k < 2; ++k) dst[n][k] = *(const PG8_LAS bf16x8*)(lds + PG8_SB(b, h) + boff + n * 2048 + k * 1024); } } while (0)
#define PG8_MMA(ai, bj, At, Bt) do { __builtin_amdgcn_s_setprio(1); \
        if constexpr (F8) { _Pragma("unroll") for (int m = 0; m < 4; ++m) _Pragma("unroll") for (int n = 0; n < 2; ++n) \
            asm volatile("v_mfma_scale_f32_16x16x128_f8f6f4 %0, %1, %2, %0, %3, %3 op_sel_hi:[0,0,0]" : "+v"(acc[ai][bj][m][n]) : "v"(Bt##8[n]), "v"(At##8[m]), "v"(f8scale)); } \
        else { _Pragma("unroll") for (int m = 0; m < 4; ++m) _Pragma("unroll") for (int n = 0; n < 2; ++n) _Pragma("unroll") for (int k = 0; k < 2; ++k) \
            acc[ai][bj][m][n] = __builtin_amdgcn_mfma_f32_16x16x32_bf16(Bt[n][k], At[m][k], acc[ai][bj][m][n], 0, 0, 0); } \
        __builtin_amdgcn_s_setprio(0); } while (0)
#define PG8_WAIT_V(n) asm volatile("s_waitcnt vmcnt(" #n ")" ::: "memory")
#define PG8_WAIT_L(n) asm volatile("s_waitcnt lgkmcnt(" #n ")" ::: "memory")
#define PG8_BAR __builtin_amdgcn_s_barrier()
#define PG8_SCHED __builtin_amdgcn_sched_barrier(0)
#define PG8_SP2BODY PG8_LDB(B0, 0, 0); PG8_LDB(B1, 0, 1); PG8_SCHED; PG8_LDA(At, 0, 0); PG8_STAGE(PG8_SA(1, 1), a1 + hstep, voffA); \
        PG8_WAIT_V(8); PG8_WAIT_L(0); PG8_BAR; PG8_MMA(0, 0, At, B0); PG8_MMA(0, 1, At, B1); PG8_BAR; PG8_SCHED; \
        PG8_LDA(At, 0, 1); PG8_STAGE(PG8_SB(0, 0), b2, voffB); PG8_STAGE(PG8_SB(0, 1), b2 + hstep, voffB); PG8_STAGE(PG8_SA(0, 0), a2, voffA); \
        PG8_WAIT_V(8); PG8_WAIT_L(0); PG8_BAR; PG8_MMA(1, 0, At, B0); PG8_MMA(1, 1, At, B1); PG8_BAR; PG8_SCHED; \
        PG8_LDB(B0, 1, 0); PG8_LDB(B1, 1, 1); PG8_SCHED; PG8_LDA(At, 1, 0); PG8_STAGE(PG8_SA(0, 1), a2 + hstep, voffA); \
        PG8_WAIT_V(8); PG8_WAIT_L(0); PG8_BAR; PG8_MMA(0, 0, At, B0); PG8_MMA(0, 1, At, B1); PG8_BAR; PG8_SCHED; \
        PG8_LDA(At, 1, 1); PG8_STAGE(PG8_SB(1, 0), b3, voffB); PG8_STAGE(PG8_SB(1, 1), b3 + hstep, voffB); PG8_STAGE(PG8_SA(1, 0), a3, voffA); \
        PG8_WAIT_V(8); PG8_WAIT_L(0); PG8_BAR; PG8_MMA(1, 0, At, B0); PG8_MMA(1, 1, At, B1); PG8_BAR; PG8_SCHED;
#define PG8_ITER_HEAD const bool last = (t == nt - 2); \
        const char* a1 = cA + (size_t)PG8_TT(t + 1) * kstep; \
        const char* a2 = last ? nA : cA + (size_t)PG8_TT(t + 2) * kstep; const char* b2 = last ? nB : cB + (size_t)PG8_TT(t + 2) * kstep; \
        const char* a3 = a2 + kstep; const char* b3 = b2 + kstep; \
        if (last && has_next) S.a_ready(nxt);
    Unit cur, nxt; int ui = 0;
    if (!S.next(0, cur)) return;
    f32x4 acc[2][2][4][2];
#pragma unroll
    for (int a = 0; a < 2; ++a)
#pragma unroll
        for (int b = 0; b < 2; ++b)
#pragma unroll
            for (int m = 0; m < 4; ++m)
#pragma unroll
                for (int n = 0; n < 2; ++n) acc[a][b][m][n] = (f32x4){0.f, 0.f, 0.f, 0.f};
    bf16x8 At[4][2], B0[2][2], B1[2][2]; pg8_v8i At8[4], B08[2], B18[2];
    if constexpr ((DBG & 1) || (DBG & 4)) {
#pragma unroll
        for (int m = 0; m < 4; ++m)
#pragma unroll
            for (int k = 0; k < 2; ++k) asm volatile("v_mov_b32 %0, 0" : "=v"(At[m][k][0]));
#pragma unroll
        for (int n = 0; n < 2; ++n)
#pragma unroll
            for (int k = 0; k < 2; ++k) { asm volatile("" : "=v"(B0[n][k])); asm volatile("" : "=v"(B1[n][k])); }
#pragma unroll
        for (int m = 0; m < 4; ++m)
#pragma unroll
            for (int k = 0; k < 2; ++k) asm volatile("" : "+v"(At[m][k]));
    }
    int f8scale = 0x7F7F7F7F; asm volatile("" : "+v"(f8scale));
    const char* cA = (const char*)g.A + (size_t)cur.pm * tstep; const char* cB = (const char*)g.Bt + (size_t)cur.pn * tstep;
    S.a_ready(cur);
    if constexpr (SP2) {
        PG8_STAGE(PG8_SB(0, 0), cB, voffB); PG8_STAGE(PG8_SB(0, 1), cB + hstep, voffB); PG8_STAGE(PG8_SA(0, 0), cA, voffA); PG8_STAGE(PG8_SA(0, 1), cA + hstep, voffA);
        if (wr == 1) PG8_BAR;
        PG8_WAIT_V(2); PG8_BAR;
        PG8_STAGE(PG8_SB(1, 0), cB + kstep, voffB); PG8_STAGE(PG8_SA(1, 0), cA + kstep, voffA); PG8_STAGE(PG8_SB(1, 1), cB + hstep + kstep, voffB);
        PG8_WAIT_V(6); PG8_BAR;
    } else {
        PG8_STAGE(PG8_SB(0, 0), cB, voffB); PG8_STAGE(PG8_SA(0, 0), cA, voffA); PG8_STAGE(PG8_SB(0, 1), cB + hstep, voffB); PG8_STAGE(PG8_SA(0, 1), cA + hstep, voffA);
        if (wr == 1) PG8_BAR;
        PG8_WAIT_V(4); PG8_BAR;
        PG8_STAGE(PG8_SB(1, 0), cB + kstep, voffB); PG8_STAGE(PG8_SA(1, 0), cA + kstep, voffA); PG8_STAGE(PG8_SB(1, 1), cB + hstep + kstep, voffB);
        PG8_WAIT_V(6); PG8_BAR;
    }
    for (;;) {
        const bool has_next = S.next(ui + 1, nxt);
        const char* nA = has_next ? (const char*)g.A + (size_t)nxt.pm * tstep : cA; const char* nB = has_next ? (const char*)g.Bt + (size_t)nxt.pn * tstep : cB;
        if constexpr (TWO) {
            for (int t = 0; t < 16; t += 2) { PG8_ITER_HEAD { constexpr bool F8 = true; PG8_SP2BODY } }
            asm volatile("s_nop 15\n\ts_nop 7" ::: "memory");
            E.mid(acc, cur, wr, wc, fr, fq);
            for (int t = 16; t < nt; t += 2) { PG8_ITER_HEAD { constexpr bool F8 = false; PG8_SP2BODY } }
        } else
        for (int t = 0; t < nt; t += 2) {
            const bool last = (t == nt - 2);
            const char* a1 = cA + (size_t)PG8_TT(t + 1) * kstep;
            const char* a2 = last ? nA : cA + (size_t)PG8_TT(t + 2) * kstep; const char* b2 = last ? nB : cB + (size_t)PG8_TT(t + 2) * kstep;
            const char* a3 = a2 + kstep; const char* b3 = b2 + kstep;
            if (last && has_next) S.a_ready(nxt);
            if constexpr (Epi::MID_K >= 0) { if (t == Epi::MID_K) { if constexpr (TWO || F8T) asm volatile("s_nop 15\n\ts_nop 7" ::: "memory"); E.mid(acc, cur, wr, wc, fr, fq); } }
            if constexpr (SP2) {
            PG8_SP2BODY
            } else {
            PG8_LDB(B0, 0, 0); PG8_SCHED; PG8_LDA(At, 0, 0); PG8_STAGE(PG8_SA(1, 1), a1 + hstep, voffA);
            PG8_WAIT_L(8); PG8_BAR; PG8_WAIT_L(0); PG8_MMA(0, 0, At, B0); PG8_BAR; PG8_SCHED;
            PG8_LDB(B1, 0, 1); PG8_STAGE(PG8_SB(0, 0), b2, voffB);
            PG8_BAR; PG8_WAIT_L(0); PG8_MMA(0, 1, At, B1); PG8_BAR;
            PG8_LDA(At, 0, 1); PG8_STAGE(PG8_SA(0, 0), a2, voffA);
            PG8_BAR; PG8_WAIT_L(0); PG8_MMA(1, 0, At, B0); PG8_BAR; PG8_SCHED;
            PG8_STAGE(PG8_SB(0, 1), b2 + hstep, voffB);
            PG8_WAIT_V(6); PG8_BAR; PG8_MMA(1, 1, At, B1); PG8_BAR;
            PG8_LDB(B0, 1, 0); PG8_SCHED; PG8_LDA(At, 1, 0); PG8_STAGE(PG8_SA(0, 1), a2 + hstep, voffA);
            PG8_WAIT_L(8); PG8_BAR; PG8_WAIT_L(0); PG8_MMA(0, 0, At, B0); PG8_BAR; PG8_SCHED;
            PG8_LDB(B1, 1, 1); PG8_STAGE(PG8_SB(1, 0), b3, voffB);
            PG8_BAR; PG8_WAIT_L(0); PG8_MMA(0, 1, At, B1); PG8_BAR;
            PG8_LDA(At, 1, 1); PG8_STAGE(PG8_SA(1, 0), a3, voffA);
            PG8_BAR; PG8_WAIT_L(0); PG8_MMA(1, 0, At, B0); PG8_BAR; PG8_SCHED;
            PG8_STAGE(PG8_SB(1, 1), b3 + hstep, voffB);
            PG8_WAIT_V(6); PG8_BAR; PG8_MMA(1, 1, At, B1); PG8_BAR;
            }
        }
        if constexpr (ALIGN_EPI) { if (wr == 0) PG8_BAR; }
        if constexpr (F8T) asm volatile("s_nop 15\n\ts_nop 7" ::: "memory");
        if constexpr (!Epi::AFTER_DRAIN) { E(acc, cur, wr, wc, fr, fq); S.done(cur); }
        if (!has_next) break;
#pragma unroll
        for (int a = 0; a < 2; ++a)
#pragma unroll
            for (int b = 0; b < 2; ++b)
#pragma unroll
                for (int m = 0; m < 4; ++m)
#pragma unroll
                    for (int n = 0; n < 2; ++n) acc[a][b][m][n] = (f32x4){0.f, 0.f, 0.f, 0.f};
        cur = nxt; cA = nA; cB = nB; ++ui;
        if constexpr (ALIGN_EPI) { if (wr == 1) PG8_BAR; }
    }
    PG8_WAIT_V(0);
    if constexpr (!ALIGN_EPI) { if (wr == 0) PG8_BAR; }
    PG8_BAR;
    if constexpr (Epi::AFTER_DRAIN) { E.fused(acc, cur, wr, wc, fr, fq, lds, wid, lane); S.done(cur); }
#undef PG8_SA
#undef PG8_TT
#undef PG8_SP2BODY
#undef PG8_ITER_HEAD
#undef aoff
#undef boff
#undef PG8_SB
#undef PG8_STAGE
#undef PG8_LDA
#undef PG8_LDB
#undef PG8_MMA
#undef PG8_LD32
#undef PG8_WAIT_V
#undef PG8_WAIT_L
#undef PG8_BAR
#undef PG8_SCHED
}
}
namespace attn {
typedef unsigned short bf16;
using bf16x8 = __attribute__((ext_vector_type(8))) short;
using s16x4  = __attribute__((ext_vector_type(4))) short;
using f32x16 = __attribute__((ext_vector_type(16))) float;
using u32x4  = __attribute__((ext_vector_type(4))) unsigned;
constexpr int   D = 128, NW = 8, QBLK = 32, KVBLK = 64;
constexpr float SCALE = 0.088388347648318440f;
constexpr float THR = 8.f;
constexpr int LDQ = 2048, LDK = 512, LDO = 4096;
constexpr size_t SHM_V = KVBLK * D * 2, SHM_K = KVBLK * D * 2, SHM_ATTN = 2 * SHM_V + 2 * SHM_K + NW * 64 * 4;
#define KSWZ(row, colB) ((row) * 256 + ((colB) ^ (((row) & 15) << 4)))
#define SBAR() __builtin_amdgcn_sched_barrier(0)
__device__ __forceinline__ int crow(int r, int hi) { return (r & 3) + 8 * (r >> 2) + 4 * hi; }
typedef float f32x2_a __attribute__((ext_vector_type(2))); typedef __bf16 bf16x2_a __attribute__((ext_vector_type(2)));
__device__ __forceinline__ unsigned cvtpk(float lo, float hi) { f32x2_a v = {lo, hi}; bf16x2_a b = __builtin_convertvector(v, bf16x2_a); return __builtin_bit_cast(unsigned, b); }
__device__ __forceinline__ void partialSM(f32x16& p0, f32x16& p1, float& m_reg, float& mn, float& alpha) {
  constexpr float C = SCALE * 1.4426950408889634f;
  mn = m_reg; alpha = 1.f;
  float mnC = m_reg;
  for (int r = 0; r < 16; ++r) p0[r] = fmaf(p0[r], C, mnC); for (int r = 0; r < 16; ++r) p1[r] = fmaf(p1[r], C, mnC);
  for (int r = 0; r < 16; ++r) p0[r] = __builtin_amdgcn_exp2f(p0[r]);
}
__device__ __forceinline__ void finishSM(f32x16& p0, f32x16& p1, float alpha, float& l_reg, bf16x8& pa0, bf16x8& pa1, bf16x8& pa2, bf16x8& pa3) {
  for (int r = 0; r < 16; ++r) p1[r] = __builtin_amdgcn_exp2f(p1[r]);
  float ps = 0; for (int r = 0; r < 16; ++r) ps += p0[r]; for (int r = 0; r < 16; ++r) ps += p1[r];
  { auto rr = __builtin_amdgcn_permlane32_swap(__float_as_uint(ps), __float_as_uint(ps), false, false);
    ps = __uint_as_float(rr[0]) + __uint_as_float(rr[1]); }
  l_reg = l_reg * alpha + ps;
#define PK4(P, BASE, OUT) do { unsigned a0 = cvtpk(P[BASE + 0], P[BASE + 1]), a1 = cvtpk(P[BASE + 2], P[BASE + 3]);   \
    unsigned b0 = cvtpk(P[BASE + 4], P[BASE + 5]), b1 = cvtpk(P[BASE + 6], P[BASE + 7]);                              \
    auto r0 = __builtin_amdgcn_permlane32_swap(a0, b0, false, false); auto r1 = __builtin_amdgcn_permlane32_swap(a1, b1, false, false); \
    u32x4 w = {r0[0], r1[0], r0[1], r1[1]}; OUT = *reinterpret_cast<bf16x8*>(&w); } while (0)
  PK4(p0, 0, pa0); PK4(p0, 8, pa1); PK4(p1, 0, pa2); PK4(p1, 8, pa3);
#undef PK4
}
__device__ __forceinline__ void qkt(f32x16& p0, f32x16& p1, const bf16* Ks, const bf16x8* qr, int r32, int hi) {
  p0 = f32x16{}; p1 = f32x16{};
  for (int d0 = 0; d0 < 8; ++d0) { int cb = (d0 * 16 + hi * 8) * 2;
    bf16x8 b0 = *reinterpret_cast<const bf16x8*>((const char*)Ks + KSWZ(r32, cb));
    bf16x8 b1 = *reinterpret_cast<const bf16x8*>((const char*)Ks + KSWZ(32 + r32, cb));
    p0 = __builtin_amdgcn_mfma_f32_32x32x16_bf16(b0, qr[d0], p0, 0, 0, 0);
    p1 = __builtin_amdgcn_mfma_f32_32x32x16_bf16(b1, qr[d0], p1, 0, 0, 0); }
}
__device__ __forceinline__ int v_st(int k, int c) { const int kk = (k & ~0xC) | ((k & 4) << 1) | ((k & 8) >> 1); return ((kk >> 3) * 4 + (c >> 5)) * 512 + ((kk & 7) * 32 + (c & 31)) * 2; }
__device__ __forceinline__ int v_rd_base(int lane) { return ((lane & 3) << 3) | (((lane >> 2) & 3) << 6) | (((lane >> 4) & 1) << 5) | (((lane >> 5) & 1) << 8); }
constexpr int v_rd_off(int d0, int ks, int half) { return d0 * 512 + ks * 4096 + half * 2048; }
template <int OFF> __device__ __forceinline__ s16x4 tr_read(int vb) {
  s16x4 r; asm volatile("ds_read_b64_tr_b16 %0, %1 offset:%2" : "=&v"(r) : "v"(vb), "i"(OFF) : "memory"); return r;
}
template <int D0> __device__ __forceinline__ void pv_one(f32x16& od, int vb, bf16x8 pa0, bf16x8 pa1, bf16x8 pa2, bf16x8 pa3) {
  const s16x4 l0 = tr_read<v_rd_off(D0, 0, 0)>(vb), h0 = tr_read<v_rd_off(D0, 0, 1)>(vb), l1 = tr_read<v_rd_off(D0, 1, 0)>(vb), h1 = tr_read<v_rd_off(D0, 1, 1)>(vb);
  const s16x4 l2 = tr_read<v_rd_off(D0, 2, 0)>(vb), h2 = tr_read<v_rd_off(D0, 2, 1)>(vb), l3 = tr_read<v_rd_off(D0, 3, 0)>(vb), h3 = tr_read<v_rd_off(D0, 3, 1)>(vb);
  asm volatile("s_waitcnt lgkmcnt(0)" ::: "memory"); SBAR();
#define PK(L, H) (bf16x8){L[0], L[1], L[2], L[3], H[0], H[1], H[2], H[3]}
  od = __builtin_amdgcn_mfma_f32_32x32x16_bf16(pa0, PK(l0, h0), od, 0, 0, 0);
  od = __builtin_amdgcn_mfma_f32_32x32x16_bf16(pa1, PK(l1, h1), od, 0, 0, 0);
  od = __builtin_amdgcn_mfma_f32_32x32x16_bf16(pa2, PK(l2, h2), od, 0, 0, 0);
  od = __builtin_amdgcn_mfma_f32_32x32x16_bf16(pa3, PK(l3, h3), od, 0, 0, 0);
#undef PK
}
__device__ __forceinline__ void pv_d0(f32x16* o, int vb, bf16x8 pa0, bf16x8 pa1, bf16x8 pa2, bf16x8 pa3) {
  pv_one<0>(o[0], vb, pa0, pa1, pa2, pa3); pv_one<1>(o[1], vb, pa0, pa1, pa2, pa3); pv_one<2>(o[2], vb, pa0, pa1, pa2, pa3); pv_one<3>(o[3], vb, pa0, pa1, pa2, pa3);
}
__device__ __forceinline__ void attn_dense_body(const bf16* Qb, const bf16* __restrict__ Kh, const bf16* __restrict__ Vh, bf16* Ob, int seq, char* lds, float negM) {
  const int tid = threadIdx.x, wid = tid >> 6, lane = tid & 63, r32 = lane & 31, hi = lane >> 5;
  bf16* V_lds = (bf16*)lds; bf16* K_lds = (bf16*)(lds + 2 * SHM_V);
  float* ws = (float*)(lds + 2 * SHM_V + 2 * SHM_K) + wid * 64; float* li_l = ws; float* al_l = ws + 32;
  float m_reg = negM  , l_reg = 0; f32x16 o[4] = {}; bf16x8 qr[8];
  const bf16* Qw = Qb + (long)(wid * QBLK + r32) * LDQ + hi * 8;
#pragma unroll
  for (int d0 = 0; d0 < 8; ++d0) qr[d0] = *reinterpret_cast<const bf16x8*>(Qw + d0 * 16);
  const int sr = tid >> 4, sc = (tid & 15) * 8, vst0 = v_st(sr, sc), vst1 = v_st(32 + sr, sc);
  const int vb0 = (int)(uintptr_t)V_lds + v_rd_base(lane);
  struct { bf16x8 vs0, vs1, ks0, ks1; } sr_[2];
#define SLOAD(i, k0) do { sr_[i].vs0 = *reinterpret_cast<const bf16x8*>(&Vh[(long)((k0) + sr) * LDK + sc]); sr_[i].vs1 = *reinterpret_cast<const bf16x8*>(&Vh[(long)((k0) + 32 + sr) * LDK + sc]); \
    sr_[i].ks0 = *reinterpret_cast<const bf16x8*>(&Kh[(long)((k0) + sr) * LDK + sc]); sr_[i].ks1 = *reinterpret_cast<const bf16x8*>(&Kh[(long)((k0) + 32 + sr) * LDK + sc]); } while (0)
#define SWRITE(b, i) do { *(bf16x8*)((char*)V_lds + (b) * SHM_V + vst0) = sr_[i].vs0;          \
    *(bf16x8*)((char*)V_lds + (b) * SHM_V + vst1) = sr_[i].vs1; int kc = sc * 2;               \
    *(bf16x8*)((char*)K_lds + (b) * SHM_K + KSWZ(sr, kc)) = sr_[i].ks0;                       \
    *(bf16x8*)((char*)K_lds + (b) * SHM_K + KSWZ(32 + sr, kc)) = sr_[i].ks1; } while (0)
#define SWAIT() asm volatile("s_waitcnt vmcnt(4)" ::: "memory")
#define RESC(a) do { if (__any((a) < 1.f)) { if (hi == 0) al_l[r32] = (a); asm volatile("s_waitcnt lgkmcnt(0)" ::: "memory"); \
    for (int d = 0; d < 4; ++d) for (int r = 0; r < 16; ++r) o[d][r] *= al_l[crow(r, hi)]; } } while (0)
  f32x16 pA0, pA1, pB0, pB1; float mnA, mnB, alA, alB; bf16x8 pa0, pa1, pa2, pa3; const int NT = seq / KVBLK;
  constexpr int SE = 0, SO = 1;
  SLOAD(SE, 0); asm volatile("s_waitcnt vmcnt(0)" ::: "memory"); SWRITE(0, SE); __syncthreads();
  qkt(pA0, pA1, K_lds, qr, r32, hi); partialSM(pA0, pA1, m_reg, mnA, alA);
  SLOAD(SO, KVBLK); if (2 < NT) SLOAD(SE, 2 * KVBLK);
  SWAIT(); SWRITE(1, SO); __syncthreads();
  for (int j = 1; j + 1 < NT; j += 2) {
    SBAR(); qkt(pB0, pB1, (bf16*)((char*)K_lds + SHM_K), qr, r32, hi);
    finishSM(pA0, pA1, alA, l_reg, pa0, pa1, pa2, pa3); SBAR();
    SLOAD(SO, (j + 2) * KVBLK); SBAR();
    pv_d0(o, vb0, pa0, pa1, pa2, pa3); partialSM(pB0, pB1, m_reg, mnB, alB);
    __syncthreads(); SWAIT(); SWRITE(0, SE);
    RESC(alB); __syncthreads();
    SBAR(); qkt(pA0, pA1, K_lds, qr, r32, hi);
    finishSM(pB0, pB1, alB, l_reg, pa0, pa1, pa2, pa3); SBAR();
    if (j + 3 < NT) SLOAD(SE, (j + 3) * KVBLK); SBAR();
    pv_d0(o, vb0 + (int)SHM_V, pa0, pa1, pa2, pa3); partialSM(pA0, pA1, m_reg, mnA, alA);
    __syncthreads(); SWAIT(); SWRITE(1, SO);
    RESC(alA); __syncthreads();
  }
  SBAR(); qkt(pB0, pB1, (bf16*)((char*)K_lds + SHM_K), qr, r32, hi);
  finishSM(pA0, pA1, alA, l_reg, pa0, pa1, pa2, pa3); SBAR();
  pv_d0(o, vb0, pa0, pa1, pa2, pa3); partialSM(pB0, pB1, m_reg, mnB, alB);
  __syncthreads(); RESC(alB);
  finishSM(pB0, pB1, alB, l_reg, pa0, pa1, pa2, pa3); SBAR();
  pv_d0(o, vb0 + (int)SHM_V, pa0, pa1, pa2, pa3);
  if (hi == 0) li_l[r32] = l_reg; asm volatile("s_waitcnt lgkmcnt(0)" ::: "memory");
  float rli[16];
#pragma unroll
  for (int r = 0; r < 16; ++r) rli[r] = __builtin_amdgcn_rcpf(li_l[crow(r, hi)]);
  bf16* Ow = Ob + (long)(wid * QBLK) * LDO;
#pragma unroll
  for (int r = 0; r < 16; ++r) { int orow = crow(r, hi);
    for (int d0 = 0; d0 < 4; ++d0) { const float v = o[d0][r] * rli[r]; Ow[(long)orow * LDO + d0 * 32 + r32] = (bf16)(cvtpk(v, v) & 0xffffu); } }
  __syncthreads();
#undef SLOAD
#undef SWRITE
#undef SWAIT
#undef RESC
}
typedef int v8i_t __attribute__((ext_vector_type(8)));
constexpr size_t SHM_K8 = KVBLK * D;
#define K8SW(row, slot) ((row) * 128 + ((((slot) ^ (((row) >> 1) & 7))) << 4))
__device__ __forceinline__ void qkt8(f32x16& p0, f32x16& p1, const char* Ks, const v8i_t* qf, int r32, int hi) {
  int sc = 0x7F7F7F7F; asm volatile("" : "+v"(sc));
  const int sl = 2 * hi;
#define KF8(ROW, SL) ({ const u32x4 l_ = *reinterpret_cast<const u32x4*>(Ks + K8SW(ROW, SL)), h_ = *reinterpret_cast<const u32x4*>(Ks + K8SW(ROW, (SL) + 1)); \
    (v8i_t){(int)l_.x, (int)l_.y, (int)l_.z, (int)l_.w, (int)h_.x, (int)h_.y, (int)h_.z, (int)h_.w}; })
  const v8i_t a00 = KF8(r32, sl), a10 = KF8(32 + r32, sl), a01 = KF8(r32, sl + 4), a11 = KF8(32 + r32, sl + 4);
#undef KF8
  asm volatile("s_nop 1\n\tv_mfma_scale_f32_32x32x64_f8f6f4 %0, %1, %2, 0, %3, %3 op_sel_hi:[0,0,0]" : "=&v"(p0) : "v"(a00), "v"(qf[0]), "v"(sc));
  asm volatile("s_nop 1\n\tv_mfma_scale_f32_32x32x64_f8f6f4 %0, %1, %2, 0, %3, %3 op_sel_hi:[0,0,0]" : "=&v"(p1) : "v"(a10), "v"(qf[0]), "v"(sc), "v"(a00));
  asm volatile("s_nop 1\n\tv_mfma_scale_f32_32x32x64_f8f6f4 %0, %1, %2, %0, %3, %3 op_sel_hi:[0,0,0]" : "+v"(p0) : "v"(a01), "v"(qf[1]), "v"(sc), "v"(a10));
  asm volatile("s_nop 1\n\tv_mfma_scale_f32_32x32x64_f8f6f4 %0, %2, %3, %0, %4, %4 op_sel_hi:[0,0,0]\n\ts_nop 15\n\ts_nop 7" : "+v"(p1), "+v"(p0) : "v"(a11), "v"(qf[1]), "v"(sc), "v"(a01));
}
__device__ __forceinline__ void attn_dense_body_q8(const unsigned char* Qb8, const unsigned char* __restrict__ Kh8, const bf16* __restrict__ Vh, bf16* Ob, int seq, char* lds,
                                                   __attribute__((address_space(3))) unsigned char* ldsA, float negM) {
  typedef __attribute__((address_space(3))) unsigned LU;
  const int tid = threadIdx.x, wid = __builtin_amdgcn_readfirstlane(tid >> 6), lane = tid & 63, r32 = lane & 31, hi = lane >> 5;
  constexpr int RING = 4, KOFF = RING * (int)SHM_V;
  const char* K_lds = lds + KOFF;
  float* li_l = (float*)(lds + KOFF + RING * SHM_K8) + wid * 64;
  float m_reg = negM, l_reg = 0, mn, al; f32x16 o[4] = {}; v8i_t qf[2];
  { const unsigned char* Qw = Qb8 + (long)(wid * QBLK + r32) * 2048 + hi * 32;
#pragma unroll
    for (int s = 0; s < 2; ++s) { const u32x4 a = *reinterpret_cast<const u32x4*>(Qw + 64 * s), b = *reinterpret_cast<const u32x4*>(Qw + 64 * s + 16);
      qf[s] = (v8i_t){(int)a.x, (int)a.y, (int)a.z, (int)a.w, (int)b.x, (int)b.y, (int)b.z, (int)b.w}; } }
  unsigned gV0, gV1, gK;
  { const int c0 = tid, c1 = tid + 512;
#define VSRC(ci) ({ const int kk_ = (((ci) >> 7) << 3) | (((ci) & 31) >> 2), k_ = (kk_ & ~0xC) | ((kk_ & 4) << 1) | ((kk_ & 8) >> 1), c_ = ((((ci) >> 5) & 3) << 5) | (((ci) & 3) << 3); (unsigned)((k_ * LDK + c_) * 2); })
    gV0 = VSRC(c0); gV1 = VSRC(c1);
#undef VSRC
    const int kr = tid >> 3, ps = tid & 7; gK = (unsigned)(kr * 512 + ((ps ^ ((kr >> 1) & 7)) << 4)); }
  const int vb0 = (int)(uintptr_t)lds + v_rd_base(lane);
#define DMA(t) do { const int s_ = (t) & 3; const char* vb_ = (const char*)Vh + (size_t)(t) * (KVBLK * LDK * 2); const unsigned char* kb_ = Kh8 + (size_t)(t) * (KVBLK * 512); \
    __builtin_amdgcn_global_load_lds((const unsigned*)(vb_ + gV0), (LU*)(ldsA + s_ * (int)SHM_V + wid * 1024), 16, 0, 0); \
    __builtin_amdgcn_global_load_lds((const unsigned*)(vb_ + gV1), (LU*)(ldsA + s_ * (int)SHM_V + 8192 + wid * 1024), 16, 0, 0); \
    __builtin_amdgcn_global_load_lds((const unsigned*)(kb_ + gK), (LU*)(ldsA + KOFF + s_ * (int)SHM_K8 + wid * 1024), 16, 0, 0); } while (0)
#define VWAIT(n) asm volatile("s_waitcnt vmcnt(" #n ")" ::: "memory")
#define WGBAR() do { asm volatile("s_waitcnt lgkmcnt(0)" ::: "memory"); __builtin_amdgcn_s_barrier(); asm volatile("" ::: "memory"); } while (0)
#define HALF(t, PN0, PN1, PO0, PO1, W) do { SBAR(); qkt8(PN0, PN1, K_lds + ((t) & 3) * (int)SHM_K8, qf, r32, hi); \
    finishSM(PO0, PO1, 1.f, l_reg, pa0, pa1, pa2, pa3); SBAR(); \
    pv_d0(o, vb0 + (((t) - 1) & 3) * (int)SHM_V, pa0, pa1, pa2, pa3); partialSM(PN0, PN1, m_reg, mn, al); \
    W; WGBAR(); } while (0)
  f32x16 pA0, pA1, pB0, pB1; bf16x8 pa0, pa1, pa2, pa3; const int NT = seq / KVBLK;
  DMA(0); DMA(1); DMA(2);
  VWAIT(6); WGBAR();
  qkt8(pA0, pA1, K_lds, qf, r32, hi); partialSM(pA0, pA1, m_reg, mn, al);
  VWAIT(3); WGBAR();
  int t = 1;
  for (; t + 4 < NT; t += 2) {
    DMA(t + 2); HALF(t, pB0, pB1, pA0, pA1, VWAIT(3));
    DMA(t + 3); HALF(t + 1, pA0, pA1, pB0, pB1, VWAIT(3));
  }
  DMA(t + 2); HALF(t, pB0, pB1, pA0, pA1, VWAIT(3));
  HALF(t + 1, pA0, pA1, pB0, pB1, VWAIT(0));
  HALF(t + 2, pB0, pB1, pA0, pA1, (void)0);
  finishSM(pB0, pB1, 1.f, l_reg, pa0, pa1, pa2, pa3); SBAR();
  pv_d0(o, vb0 + ((NT - 1) & 3) * (int)SHM_V, pa0, pa1, pa2, pa3);
  if (hi == 0) li_l[r32] = l_reg; asm volatile("s_waitcnt lgkmcnt(0)" ::: "memory");
  float rli[16];
#pragma unroll
  for (int r = 0; r < 16; ++r) rli[r] = __builtin_amdgcn_rcpf(li_l[crow(r, hi)]);
  bf16* Ow = Ob + (long)(wid * QBLK) * LDO;
#pragma unroll
  for (int r = 0; r < 16; ++r) { int orow = crow(r, hi);
    for (int d0 = 0; d0 < 4; ++d0) { const float v = o[d0][r] * rli[r]; Ow[(long)orow * LDO + d0 * 32 + r32] = (bf16)(cvtpk(v, v) & 0xffffu); } }
  __syncthreads();
#undef DMA
#undef VWAIT
#undef WGBAR
#undef HALF
}
template <int VAR = 0>
__device__ __forceinline__ void qkt8c(f32x16& p0, f32x16& p1, const char* Ks, const v8i_t* qf, const f32x16& cinit, int r32, int hi, v8i_t& keepk) {
  int sc = 0x7F7F7F7F, scq = 0x7C7C7C7C; asm volatile("" : "+v"(sc), "+v"(scq));
  const int sl = 2 * hi;
#define KF8(ROW, SL) ({ const u32x4 l_ = *reinterpret_cast<const u32x4*>(Ks + K8SW(ROW, SL)), h_ = *reinterpret_cast<const u32x4*>(Ks + K8SW(ROW, (SL) + 1)); \
    (v8i_t){(int)l_.x, (int)l_.y, (int)l_.z, (int)l_.w, (int)h_.x, (int)h_.y, (int)h_.z, (int)h_.w}; })
  const v8i_t a00 = KF8(r32, sl), a10 = KF8(32 + r32, sl), a01 = KF8(r32, sl + 4), a11 = KF8(32 + r32, sl + 4);
#undef KF8
  if constexpr (VAR & 1) { asm volatile("" : "=&v"(p0) : "v"(a00), "v"(qf[0]), "v"(sc), "v"(scq), "v"(cinit)); } else { asm volatile("v_mfma_scale_f32_32x32x64_f8f6f4 %0, %1, %2, %5, %3, %4 op_sel_hi:[0,0,0]" : "=&v"(p0) : "v"(a00), "v"(qf[0]), "v"(sc), "v"(scq), "v"(cinit)); }
  if constexpr (VAR & 1) { asm volatile("" : "=&v"(p1) : "v"(a10), "v"(qf[0]), "v"(sc), "v"(scq), "v"(cinit), "v"(a00)); } else { asm volatile("v_mfma_scale_f32_32x32x64_f8f6f4 %0, %1, %2, %5, %3, %4 op_sel_hi:[0,0,0]" : "=&v"(p1) : "v"(a10), "v"(qf[0]), "v"(sc), "v"(scq), "v"(cinit), "v"(a00)); }
  if constexpr (VAR & 1) { asm volatile("" : "+v"(p0) : "v"(a01), "v"(qf[1]), "v"(sc), "v"(scq), "v"(a10)); } else { asm volatile("v_mfma_scale_f32_32x32x64_f8f6f4 %0, %1, %2, %0, %3, %4 op_sel_hi:[0,0,0]" : "+v"(p0) : "v"(a01), "v"(qf[1]), "v"(sc), "v"(scq), "v"(a10)); }
  if constexpr (VAR & 1) { asm volatile("" : "+v"(p1), "+v"(p0) : "v"(a11), "v"(qf[1]), "v"(sc), "v"(scq), "v"(a01)); } else { asm volatile("v_mfma_scale_f32_32x32x64_f8f6f4 %0, %2, %3, %0, %4, %5 op_sel_hi:[0,0,0]" : "+v"(p1), "+v"(p0) : "v"(a11), "v"(qf[1]), "v"(sc), "v"(scq), "v"(a01)); }
  keepk = a11;
}
template <int VAR = 0>
__device__ __forceinline__ void partialSM8(f32x16& p0) { if constexpr (VAR & 2) { asm volatile("" : "+v"(p0)); } else { for (int r = 0; r < 16; ++r) p0[r] = __builtin_amdgcn_exp2f(p0[r]); } }
template <int VAR = 0>
__device__ __forceinline__ void finishSM8(f32x16& p0, f32x16& p1, float& l_reg, v8i_t& P8) {
  if constexpr (VAR & 2) { asm volatile("" : "=v"(P8) : "v"(p0), "v"(p1)); l_reg += 1.f; return; }
  for (int r = 0; r < 16; ++r) p1[r] = __builtin_amdgcn_exp2f(p1[r]);
  float ps = 0; for (int r = 0; r < 16; ++r) ps += p0[r]; for (int r = 0; r < 16; ++r) ps += p1[r];
  { auto rr = __builtin_amdgcn_permlane32_swap(__float_as_uint(ps), __float_as_uint(ps), false, false);
    ps = __uint_as_float(rr[0]) + __uint_as_float(rr[1]); }
  l_reg += ps;
#pragma unroll
  for (int j = 0; j < 4; ++j) { int w = 0; w = __builtin_amdgcn_cvt_pk_bf8_f32(p0[4 * j], p0[4 * j + 1], w, false); w = __builtin_amdgcn_cvt_pk_bf8_f32(p0[4 * j + 2], p0[4 * j + 3], w, true); P8[j] = w;
    int u = 0; u = __builtin_amdgcn_cvt_pk_bf8_f32(p1[4 * j], p1[4 * j + 1], u, false); u = __builtin_amdgcn_cvt_pk_bf8_f32(p1[4 * j + 2], p1[4 * j + 3], u, true); P8[4 + j] = u; }
}
template <int VAR = 0>
__device__ __forceinline__ void pv8(f32x16* o, const char* Vs, int va0, int va1, const v8i_t& P8, v8i_t& keep) {
  int sc = 0x7F7F7F7F; asm volatile("" : "+v"(sc));
#define VF8(D0) ({ const u32x4 l_ = *reinterpret_cast<const u32x4*>(Vs + va0 + (D0) * 2048), h_ = *reinterpret_cast<const u32x4*>(Vs + va1 + (D0) * 2048); \
    (v8i_t){(int)l_.x, (int)l_.y, (int)l_.z, (int)l_.w, (int)h_.x, (int)h_.y, (int)h_.z, (int)h_.w}; })
  const v8i_t f0 = VF8(0), f1 = VF8(1), f2 = VF8(2), f3 = VF8(3);
#undef VF8
  if constexpr (VAR & 1) { asm volatile("" : "+v"(o[0]) : "v"(P8), "v"(f0), "v"(sc)); } else { asm volatile("s_nop 1\n\tv_mfma_scale_f32_32x32x64_f8f6f4 %0, %1, %2, %0, %3, %3 op_sel_hi:[0,0,0] cbsz:1" : "+v"(o[0]) : "v"(P8), "v"(f0), "v"(sc)); }
  if constexpr (VAR & 1) { asm volatile("" : "+v"(o[1]) : "v"(P8), "v"(f1), "v"(sc), "v"(f0)); } else { asm volatile("v_mfma_scale_f32_32x32x64_f8f6f4 %0, %1, %2, %0, %3, %3 op_sel_hi:[0,0,0] cbsz:1" : "+v"(o[1]) : "v"(P8), "v"(f1), "v"(sc), "v"(f0)); }
  if constexpr (VAR & 1) { asm volatile("" : "+v"(o[2]) : "v"(P8), "v"(f2), "v"(sc), "v"(f1)); } else { asm volatile("v_mfma_scale_f32_32x32x64_f8f6f4 %0, %1, %2, %0, %3, %3 op_sel_hi:[0,0,0] cbsz:1" : "+v"(o[2]) : "v"(P8), "v"(f2), "v"(sc), "v"(f1)); }
  if constexpr (VAR & 1) { asm volatile("" : "+v"(o[3]) : "v"(P8), "v"(f3), "v"(sc), "v"(f2)); } else { asm volatile("v_mfma_scale_f32_32x32x64_f8f6f4 %0, %1, %2, %0, %3, %3 op_sel_hi:[0,0,0] cbsz:1" : "+v"(o[3]) : "v"(P8), "v"(f3), "v"(sc), "v"(f2)); }
  keep = f3;
}
template <int VAR = 0>
__device__ __forceinline__ void attn_dense_body_q8v8(const unsigned char* Qb8, const unsigned char* __restrict__ Kh8, const unsigned char* __restrict__ Vt8, bf16* Ob, int seq, char* lds,
                                                     __attribute__((address_space(3))) unsigned char* ldsA, float negM) {
  typedef __attribute__((address_space(3))) unsigned LU;
  const int tid = threadIdx.x, wid = __builtin_amdgcn_readfirstlane(tid >> 6), lane = tid & 63, r32 = lane & 31, hi = lane >> 5;
  constexpr int RING = 4, SHM_V8 = 8192, KOFF = RING * SHM_V8;
  const char* K_lds = lds + KOFF;
  float* li_l = (float*)(lds + KOFF + RING * SHM_K8) + wid * 64;
  float l_reg = 0; f32x16 o[4] = {}; v8i_t qf[2]; f32x16 cinit;
  { float c0 = negM + 13.0f; asm volatile("" : "+v"(c0));
#pragma unroll
    for (int r = 0; r < 16; ++r) cinit[r] = c0; asm volatile("" : "+v"(cinit)); }
  { const unsigned char* Qw = Qb8 + (long)(wid * QBLK + r32) * 2048 + hi * 32;
#pragma unroll
    for (int s = 0; s < 2; ++s) { const u32x4 a = *reinterpret_cast<const u32x4*>(Qw + 64 * s), b = *reinterpret_cast<const u32x4*>(Qw + 64 * s + 16);
      qf[s] = (v8i_t){(int)a.x, (int)a.y, (int)a.z, (int)a.w, (int)b.x, (int)b.y, (int)b.z, (int)b.w}; } }
  unsigned gK; { const int kr = tid >> 3, ps = tid & 7; gK = (unsigned)(kr * 512 + ((ps ^ ((kr >> 1) & 7)) << 4)); }
  const unsigned gV = (unsigned)tid * 16u;
  const int va0 = r32 * 64 + (((2 * hi) ^ ((r32 >> 2) & 3)) << 4), va1 = r32 * 64 + (((2 * hi + 1) ^ ((r32 >> 2) & 3)) << 4);
#define DMAK(t) __builtin_amdgcn_global_load_lds((const unsigned*)(Kh8 + (size_t)(t) * (KVBLK * 512) + gK), (LU*)(ldsA + KOFF + ((t) & 3) * (int)SHM_K8 + wid * 1024), 16, 0, 0)
#define DMAV(t) __builtin_amdgcn_global_load_lds((const unsigned*)(Vt8 + (size_t)(t) * 8192 + gV), (LU*)(ldsA + ((t) & 3) * SHM_V8 + wid * 1024), 16, 0, 0)
#define VWAIT(n) asm volatile("s_waitcnt vmcnt(" #n ")" ::: "memory")
#define WGBAR() do { asm volatile("s_waitcnt lgkmcnt(0)" ::: "memory"); __builtin_amdgcn_s_barrier(); asm volatile("" ::: "memory"); } while (0)
#define SQ(t, P0, P1) qkt8c<VAR>(P0, P1, K_lds + ((t) & 3) * (int)SHM_K8, qf, cinit, r32, hi, keepk)
#define SPV(t) pv8<VAR>(o, lds + ((t) & 3) * SHM_V8, va0, va1, P8, keep)
#define KEEP() asm volatile("" :: "v"(P8), "v"(keep))
#define SYNC(W, DK, DV) do { W; WGBAR(); DK; DV; } while (0)
#define ITER(t, PN0, PN1, PO0, PO1, W, DK, DV) do { if (!gB) SYNC(W, DK, DV); SBAR(); if (doM) SQ(t, PN0, PN1); SBAR(); if (gB) SYNC(W, DK, DV); \
    SBAR(); if (doV) finishSM8<VAR>(PO0, PO1, l_reg, P8); else asm volatile("" : "=v"(P8)); asm volatile("" :: "v"(keepk)); if (doM) SPV((t) - 1); if (doV) partialSM8<VAR>(PN0); KEEP(); } while (0)
  f32x16 pA0, pA1, pB0, pB1; v8i_t P8, keep = {}, keepk = {}; const int NT = seq / KVBLK;
  const bool gB = (VAR & 8) ? (wid >= 4) : ((wid & 1) != 0);
  const bool doM = (VAR & 4) ? !gB : true, doV = (VAR & 4) ? gB : true;
  DMAK(0); DMAK(1); DMAV(0); DMAK(2); DMAV(1); DMAK(3); DMAV(2);
  VWAIT(5); WGBAR();
  SQ(0, pA0, pA1); asm volatile("s_nop 15\n\ts_nop 7" : "+v"(pA0), "+v"(pA1) : "v"(keepk)); partialSM8<VAR>(pA0);
  int t = 1;
  for (; t + 4 < NT; t += 2) {
    ITER(t, pB0, pB1, pA0, pA1, VWAIT(3), DMAK(t + 3), DMAV(t + 2));
    ITER(t + 1, pA0, pA1, pB0, pB1, VWAIT(3), DMAK(t + 4), DMAV(t + 3));
  }
  ITER(t, pB0, pB1, pA0, pA1, VWAIT(3), (void)0, DMAV(t + 2));
  ITER(t + 1, pA0, pA1, pB0, pB1, VWAIT(0), (void)0, (void)0);
  ITER(t + 2, pB0, pB1, pA0, pA1, (void)0, (void)0, (void)0);
  finishSM8<VAR>(pB0, pB1, l_reg, P8); SBAR();
  SPV(NT - 1);
  asm volatile("s_nop 15\n\ts_nop 7" : "+v"(o[0]), "+v"(o[1]), "+v"(o[2]), "+v"(o[3]) : "v"(P8), "v"(keep));
  if (hi == 0) li_l[r32] = l_reg; asm volatile("s_waitcnt lgkmcnt(0)" ::: "memory");
  float rli[16];
#pragma unroll
  for (int r = 0; r < 16; ++r) rli[r] = __builtin_amdgcn_rcpf(li_l[crow(r, hi)]);
  __syncthreads();
  { unsigned char* Os = (unsigned char*)(lds + wid * 4096);
#pragma unroll
    for (int r = 0; r < 16; ++r) { const int orow = crow(r, hi);
#pragma unroll
      for (int d0 = 0; d0 < 4; ++d0) { const float v = o[d0][r] * rli[r] * 32.0f; Os[orow * 128 + d0 * 32 + r32] = (unsigned char)(__builtin_amdgcn_cvt_pk_fp8_f32(v, v, 0, false) & 0xff); } }
    asm volatile("s_waitcnt lgkmcnt(0)" ::: "memory");
    unsigned char* Ow = (unsigned char*)Ob + (long)(wid * QBLK) * 8192;
#pragma unroll
    for (int i2 = 0; i2 < 4; ++i2) { const int pi = i2 * 64 + lane, row = pi >> 3, c16 = pi & 7;
      *reinterpret_cast<u32x4*>(Ow + (long)row * 8192 + c16 * 16) = *reinterpret_cast<const u32x4*>(Os + row * 128 + c16 * 16); } }
  __syncthreads();
#undef DMAK
#undef DMAV
#undef VWAIT
#undef WGBAR
#undef SQ
#undef SPV
#undef KEEP
#undef SYNC
#undef ITER
}
#undef K8SW
#undef KSWZ
#undef SBAR
}
constexpr int NWAVES = 8;
#ifndef MK_N_LAUNCHES
#define MK_N_LAUNCHES 1
#endif
constexpr int N_PHASES = 16;
constexpr int N_LAUNCHES = MK_N_LAUNCHES;
constexpr int BATCH = 2, SEQ = 8192, DM = 4096, M = BATCH * SEQ;
constexpr int ATTN_DIM = 2048, KV_DIM = 512, HQK = 2048, DFF = 11008, PLE = 256, NHG = 16, NQH = 16, NKVH = 4;
constexpr int N_IN = 13312, N1 = N_IN + 2 * DM;
constexpr float DN_ALPHA = 1.189207115002721f, LN_EPS = 1e-5f, RMS_EPS = 1e-6f;
constexpr int NCHUNK = M / 64;
constexpr size_t MiB = 1u << 20;
constexpr size_t WS_CTL = 0, CTL_ZERO_BYTES = 1 * MiB;
constexpr size_t WS_TAB = 1 * MiB;
constexpr size_t WS_RF = 2 * MiB, WS_WF = 4 * MiB, WS_RB = 6 * MiB, WS_WB = 8 * MiB;
constexpr size_t WS_BT1 = 10 * MiB;
constexpr size_t WS_WPAB = 178 * MiB, WS_WO = 210 * MiB;
constexpr size_t WS_XB = 242 * MiB;
constexpr size_t WS_QA = 370 * MiB, WS_KA = 434 * MiB, WS_VA = 450 * MiB;
constexpr size_t WS_QF = 466 * MiB, WS_KF = 530 * MiB, WS_KB = 594 * MiB, WS_QB = 658 * MiB, WS_IH = 722 * MiB, WS_GH = 786 * MiB;
constexpr size_t WS_GATE = 850 * MiB;
constexpr float MIX_ASCALE = 32.f;
constexpr size_t WS_MIX = 530 * MiB, WS_Y1 = 52 * MiB;
constexpr size_t WS_WUP = 1106 * MiB, WS_WDN = 1278 * MiB, WS_END = 1364 * MiB;
constexpr size_t WS_WPG = 10 * MiB, WS_WPLE = 42 * MiB, WS_PB = 44 * MiB, WS_X1B = 52 * MiB, WS_UB = 180 * MiB, WS_GB = 524 * MiB, WS_PE = 880 * MiB;
static_assert(WS_WDN + (size_t)DM * DFF * 2 <= WS_END && WS_GB + (size_t)M * DFF * 2 <= WS_WUP && WS_X1B + (size_t)M * DM * 2 <= WS_UB, "ws map");
constexpr size_t OUT_X8 = 128 * MiB, OUT_W8 = 192 * MiB, OUT_W8A = 224 * MiB;
constexpr int N_F8 = 7168;
constexpr int N_ATT = 3072;
constexpr float GATE_WSCALE = 64.0f;
constexpr size_t WS_Q8 = 52 * MiB, WS_K8 = 84 * MiB, WS_VT8 = 92 * MiB;
constexpr int CW_TMO = 0, CW_CODE = 1, CW_BAR = 4096;
constexpr int RING_BYTES = 131072, LDSCTL_OFF = RING_BYTES, MISC_OFF = LDSCTL_OFF + 320, LDS_BYTES = 147456;

#define GAS __attribute__((address_space(1)))
#define LAS __attribute__((address_space(3)))
typedef unsigned short bf16;
typedef unsigned v4u __attribute__((ext_vector_type(4)));
typedef unsigned v2u __attribute__((ext_vector_type(2)));
typedef float f32x4 __attribute__((ext_vector_type(4)));
typedef short bf16x8 __attribute__((ext_vector_type(8)));
typedef short s16x4 __attribute__((ext_vector_type(4)));
typedef GAS unsigned gu32;
#define RLX_AGENT __ATOMIC_RELAXED, __HIP_MEMORY_SCOPE_AGENT
#define LDS_WAIT() asm volatile("s_waitcnt lgkmcnt(0)" ::: "memory")
#define VM_WAIT() asm volatile("s_waitcnt vmcnt(0)" ::: "memory")
typedef float f32x2_t __attribute__((ext_vector_type(2))); typedef __bf16 bf16x2_t __attribute__((ext_vector_type(2)));
__device__ __forceinline__ unsigned pk2(float lo, float hi) { f32x2_t v = {lo, hi}; bf16x2_t b = __builtin_convertvector(v, bf16x2_t); return __builtin_bit_cast(unsigned, b); }
__device__ __forceinline__ float bflo(unsigned w) { return __uint_as_float(w << 16); }
__device__ __forceinline__ float bfhi(unsigned w) { return __uint_as_float(w & 0xffff0000u); }
__device__ __forceinline__ float sigm(float v) { return __builtin_amdgcn_rcpf(1.0f + __expf(-v)); }
#define XB_TMO      128
#define XB_XCNT(j)  (256  + 64 * (j))
#define XB_XSUB(j)  (1280 + 64 * (j))
#define XB_XGEN(j)  (2304 + 64 * (j))
#define XB_TOP      3328
#define XB_TOPGEN   3392
#define XCD_BAR_WORDS 3456
#define XB_SPIN_CAP (1u << 18)

__device__ __forceinline__ unsigned xb_ld(unsigned* p)              { return __hip_atomic_load(p, __ATOMIC_RELAXED, __HIP_MEMORY_SCOPE_AGENT); }
__device__ __forceinline__ unsigned xb_add(unsigned* p, unsigned v) { return __hip_atomic_fetch_add(p, v, __ATOMIC_RELAXED, __HIP_MEMORY_SCOPE_AGENT); }
__device__ __forceinline__ unsigned xb_xcc_id() { return (unsigned)__builtin_amdgcn_s_getreg((3 << 11) | 20) & 0xFu; }
#define XB_SPIN(cond, bar) do { unsigned _sp = 0; while (cond) { __builtin_amdgcn_s_sleep(1); \
    if ((++_sp & 255u) == 0u) { if (xb_ld(&(bar)[XB_TMO])) break; if (_sp > XB_SPIN_CAP) { atomicAdd(&(bar)[XB_TMO], 1u); break; } } } } while (0)

struct XcdBarrier {
    unsigned* bar; unsigned x;
    volatile LAS unsigned* st;
};

__device__ __forceinline__ XcdBarrier xcd_barrier_post(unsigned* bar, volatile LAS unsigned* st) {
    XcdBarrier b; b.bar = bar; b.x = xb_xcc_id(); b.st = st;
    if (threadIdx.x == 0) (void)xb_add(&bar[XB_XCNT(b.x)], 1u);
    return b;
}
__device__ __forceinline__ void xcd_barrier_complete(unsigned* bar, unsigned x, unsigned& nloc, unsigned& nx) {
    const unsigned G = gridDim.x * gridDim.y * gridDim.z;
    unsigned sum, cnt, mine, sp = 0u;
    for (;;) {
        sum = 0u; cnt = 0u; mine = 0u;
#pragma unroll
        for (unsigned j = 0; j < 16; ++j) { const unsigned c = xb_ld(&bar[XB_XCNT(j)]); sum += c; cnt += (c > 0u) ? 1u : 0u; mine = (j == x) ? c : mine; }
        if (sum == G) break;
        __builtin_amdgcn_s_sleep(1);
        if ((++sp & 255u) == 0u) { if (xb_ld(&bar[XB_TMO])) break; if (sp > XB_SPIN_CAP) { atomicAdd(&bar[XB_TMO], 1u); break; } }
    }
    nloc = mine > 0u ? mine : 1u; nx = cnt > 0u ? cnt : 1u;
}

__device__ __forceinline__ void xcd_barrier(const XcdBarrier& b) {
    asm volatile("s_waitcnt vmcnt(0)" ::: "memory");
    __syncthreads();
    if (threadIdx.x == 0) {
        unsigned* bar = b.bar;
        __builtin_amdgcn_s_waitcnt(0);
        unsigned nloc = b.st[0], nx = b.st[1];
        if (nloc == 0u) { xcd_barrier_complete(bar, b.x, nloc, nx); b.st[0] = nloc; b.st[1] = nx; }
        const unsigned old = xb_add(&bar[XB_XSUB(b.x)], 1u);
        const unsigned gen = old / nloc;
        if (old + 1u == (gen + 1u) * nloc) {
            __builtin_amdgcn_fence(__ATOMIC_RELEASE, "agent");
            asm volatile("s_waitcnt vmcnt(0)" ::: "memory");
            const unsigned og = xb_add(&bar[XB_TOP], 1u);
            const unsigned tg = og / nx;
            if (og + 1u == (tg + 1u) * nx) xb_add(&bar[XB_TOPGEN], 1u);
            else XB_SPIN(xb_ld(&bar[XB_TOPGEN]) == tg, bar);
            __builtin_amdgcn_fence(__ATOMIC_ACQUIRE, "agent");
            xb_add(&bar[XB_XGEN(b.x)], 1u);
            asm volatile("s_waitcnt vmcnt(0)" ::: "memory");
        } else {
            XB_SPIN(xb_ld(&bar[XB_XGEN(b.x)]) == gen, bar);
            __builtin_amdgcn_fence(__ATOMIC_ACQUIRE, "agent");
            asm volatile("s_waitcnt vmcnt(0)" ::: "memory");
        }
    }
    __syncthreads();
}
struct Frame {
    LAS unsigned char* lds;
    volatile LAS unsigned* MISC;
    gu32* ctl;
    int tid, lane, wave, vcu, G;
    unsigned char* ws; float* out;
};
__device__ __forceinline__ float wave_sum(float v) {
#pragma unroll
    for (int o = 1; o < 64; o <<= 1) v += __shfl_xor(v, o);
    return v;
}
__device__ __forceinline__ void p0_transpose_item(const float* W, int K, int N, bf16* WT, int row_off, LAS float* scr, int item, int lane, int ldk = 0, int koff = 0) {
    if (ldk == 0) ldk = K;
    const int nblk = N / 32, kb = item / nblk, nb = item % nblk, k0 = 64 * kb, n0 = 32 * nb;
#pragma unroll 8
    for (int i = 0; i < 32; ++i) { const int kk = 2 * i + (lane >> 5); scr[kk * 33 + (lane & 31)] = W[(size_t)(k0 + kk) * N + n0 + (lane & 31)]; }
    LDS_WAIT(); asm volatile("" ::: "memory");
    const int c = lane & 7;
#pragma unroll
    for (int j = 0; j < 4; ++j) { const int n = (lane >> 3) + 8 * j; const LAS float* s = scr + (8 * c) * 33 + n;
        v4u o; o.x = pk2(s[0 * 33], s[1 * 33]); o.y = pk2(s[2 * 33], s[3 * 33]); o.z = pk2(s[4 * 33], s[5 * 33]); o.w = pk2(s[6 * 33], s[7 * 33]);
        *(GAS v4u*)(WT + (size_t)(row_off + n0 + n) * ldk + koff + k0 + 8 * c) = o; }
    LDS_WAIT(); asm volatile("" ::: "memory");
}
__device__ __forceinline__ void cvt_rows(Frame& F, const float* src, bf16* dst, size_t n8) {
    for (size_t i = (size_t)F.vcu * 512 + F.tid; i < n8; i += (size_t)F.G * 512) {
        const f32x4 a = *(const f32x4*)(src + i * 8), b = *(const f32x4*)(src + i * 8 + 4);
        v4u o; o.x = pk2(a.x, a.y); o.y = pk2(a.z, a.w); o.z = pk2(b.x, b.y); o.w = pk2(b.z, b.w);
        *(v4u*)(dst + i * 8) = o; }
}
__device__ __forceinline__ unsigned pk4_fp8(float a, float b, float c, float d) { unsigned w = 0u; w = (unsigned)__builtin_amdgcn_cvt_pk_fp8_f32(a, b, (int)w, false); w = (unsigned)__builtin_amdgcn_cvt_pk_fp8_f32(c, d, (int)w, true); return w; }
__device__ __forceinline__ void cvt_x(Frame& F, const float* src, bf16* dst, unsigned char* dst8, size_t n8) {
    for (size_t i = (size_t)F.vcu * 512 + F.tid; i < n8; i += (size_t)F.G * 512) {
        const f32x4 a = *(const f32x4*)(src + i * 8), b = *(const f32x4*)(src + i * 8 + 4);
        v4u o; o.x = pk2(a.x, a.y); o.y = pk2(a.z, a.w); o.z = pk2(b.x, b.y); o.w = pk2(b.z, b.w);
        *(v4u*)(dst + i * 8) = o;
        v2u o8; o8.x = pk4_fp8(a.x, a.y, a.z, a.w); o8.y = pk4_fp8(b.x, b.y, b.z, b.w);
        *(v2u*)(dst8 + i * 8) = o8; }
}
__device__ __forceinline__ void p0_transpose_item_fp8(const float* W, int K, int N, unsigned char* WT, int row_off, LAS float* scr, int item, int lane, float wscale, int ldk = 0) {
    if (ldk == 0) ldk = K;
    const int nblk = N / 32, kb = item / nblk, nb = item % nblk, k0 = 64 * kb, n0 = 32 * nb;
#pragma unroll 8
    for (int i = 0; i < 32; ++i) { const int kk = 2 * i + (lane >> 5); scr[kk * 33 + (lane & 31)] = W[(size_t)(k0 + kk) * N + n0 + (lane & 31)] * wscale; }
    LDS_WAIT(); asm volatile("" ::: "memory");
    const int c = lane & 7;
#pragma unroll
    for (int j = 0; j < 4; ++j) { const int n = (lane >> 3) + 8 * j; const LAS float* s = scr + (8 * c) * 33 + n;
        v2u o; o.x = pk4_fp8(s[0 * 33], s[1 * 33], s[2 * 33], s[3 * 33]); o.y = pk4_fp8(s[4 * 33], s[5 * 33], s[6 * 33], s[7 * 33]);
        *(GAS v2u*)(WT + (size_t)(row_off + n0 + n) * ldk + k0 + 8 * c) = o; }
    LDS_WAIT(); asm volatile("" ::: "memory");
}
struct In { const float *x, *p, *w_in, *q_norm, *k_norm, *lb_logits, *hg_norm, *w_pa, *w_pb, *w_gate, *b_gate, *w_o, *ln1_g, *ln1_b, *w_up, *conv_w, *conv_b, *w_down, *ln2_g, *ln2_b, *w_pg, *w_ple; };

__device__ __forceinline__ void p0_prologue(Frame& F, const In& I) {
    unsigned char* ws = F.ws;
    { float* tab = (float*)(ws + WS_TAB);
      for (int i = blockIdx.x * 512 + F.tid; i < 4096 + 4096; i += F.G * 512) {
          if (i < 4096) { const int pos = i >> 5, fi = i & 31; const float inv = powf(10000.0f, -(float)(2 * fi) / 64.0f); const float ang = (float)pos * inv; tab[i] = cosf(ang); tab[4096 + i] = sinf(ang); }
          else { const int j = i - 4096, dir = j >> 11, c = j & 2047; const float a = I.lb_logits[(dir * 2 + 0) * 2048 + c], b = I.lb_logits[(dir * 2 + 1) * 2048 + c];
                 tab[8192 + j] = 1.0f / (1.0f + expf(b - a)); } } }
    LAS float* scr = (LAS float*)(F.lds + F.wave * 16384);
    const int gw = F.vcu * NWAVES + F.wave, NGW = F.G * NWAVES;
    constexpr int I0 = (DM / 64) * (N_IN / 32), I1 = (DM / 64) * (2 * DM / 32), I2 = (ATTN_DIM / 64) * (DM / 32), I3 = I2, I4 = (DM / 64) * (DM / 32), I5 = (DM / 64) * (2 * DFF / 32), I6 = (DFF / 64) * (DM / 32);
    constexpr int NITEMS = I0 + I1 + I2 + I3 + I4 + I5 + I6;
    for (int it = gw; it < NITEMS; it += NGW) {
        int r = it;
        if (r < I0) { const int n0w = 32 * (r % (N_IN / 32));
                      if (n0w < N_ATT) p0_transpose_item_fp8(I.w_in, DM, N_IN, (unsigned char*)F.out + OUT_W8A, 0, scr, r, F.lane, GATE_WSCALE);
                      else if (n0w >= 5120 && n0w < 9216) p0_transpose_item_fp8(I.w_in, DM, N_IN, (unsigned char*)F.out + OUT_W8A, N_ATT - 5120, scr, r, F.lane, GATE_WSCALE);
                      else p0_transpose_item(I.w_in, DM, N_IN, (bf16*)(ws + WS_BT1), n0w >= 9216 ? -4096 : 0, scr, r, F.lane);
                      continue; } r -= I0;
        if (r < I1) { const int n0g = 32 * (r % (2 * DM / 32)), cch = n0g & (DM - 1), dst = 256 * (cch >> 7) + ((n0g >= DM) ? 128 : 0) + (cch & 127);
            p0_transpose_item_fp8(I.w_gate, DM, 2 * DM, (unsigned char*)F.out + OUT_W8, dst - n0g, scr, r, F.lane, GATE_WSCALE); continue; } r -= I1;
        if (r < I2) { p0_transpose_item_fp8(I.w_pa, ATTN_DIM, DM, ws + WS_WPAB, 0, scr, r, F.lane, GATE_WSCALE, 4 * ATTN_DIM); continue; } r -= I2;
        if (r < I3) { p0_transpose_item(I.w_pb, HQK, DM, (bf16*)(ws + WS_WPAB), 0, scr, r, F.lane, 2 * ATTN_DIM, ATTN_DIM); continue; } r -= I3;
        if (r < I4) { p0_transpose_item_fp8(I.w_o, DM, DM, ws + WS_WO, 0, scr, r, F.lane, GATE_WSCALE); continue; } r -= I4;
        if (r < I5) { p0_transpose_item(I.w_up, DM, 2 * DFF, (bf16*)(ws + WS_WUP), 0, scr, r, F.lane); continue; } r -= I5;
        p0_transpose_item(I.w_down, DFF, DM, (bf16*)(ws + WS_WDN), 0, scr, r, F.lane);
    }
    cvt_x(F, I.x, (bf16*)(ws + WS_XB), (unsigned char*)F.out + OUT_X8, (size_t)M * DM / 8);
}
template <int NH>
__device__ __forceinline__ void qk_prep_one(Frame& F, const bf16* X, bf16* XO, unsigned char* XO8, const float* gain, const float* tab, const float s8) {
    const int sub = F.lane & 15, e0 = sub * 8, e1 = e0 ^ 32, fi = e0 & 31;
    const float sgn = (sub & 4) ? 1.f : -1.f;
    const int NG = F.G * 32;
    const f32x4 g0 = *(const f32x4*)(gain + e0), g1 = *(const f32x4*)(gain + e0 + 4), h0 = *(const f32x4*)(gain + e1), h1 = *(const f32x4*)(gain + e1 + 4);
    for (int it0 = (F.vcu * 512 + F.tid) >> 4; it0 < M * NH; it0 += 4 * NG) {
        v4u xa = *(const v4u*)(X + (size_t)(it0) * 128 + e0), xb = *(const v4u*)(X + (size_t)(it0 + NG) * 128 + e0);
        v4u xc = *(const v4u*)(X + (size_t)(it0 + 2 * NG) * 128 + e0), xd = *(const v4u*)(X + (size_t)(it0 + 3 * NG) * 128 + e0);
#define QK_ONE(XV, ITEM) do { const int it_ = (ITEM); const int row_ = it_ / NH; \
            v4u pv; pv.x = __shfl_xor(XV.x, 4); pv.y = __shfl_xor(XV.y, 4); pv.z = __shfl_xor(XV.z, 4); pv.w = __shfl_xor(XV.w, 4); \
            const float x[8] = {bflo(XV.x), bfhi(XV.x), bflo(XV.y), bfhi(XV.y), bflo(XV.z), bfhi(XV.z), bflo(XV.w), bfhi(XV.w)}; \
            const float px[8] = {bflo(pv.x), bfhi(pv.x), bflo(pv.y), bfhi(pv.y), bflo(pv.z), bfhi(pv.z), bflo(pv.w), bfhi(pv.w)}; \
            float ss = 0.f; \
            _Pragma("unroll") for (int j = 0; j < 8; ++j) ss += x[j] * x[j]; \
            ss += __shfl_xor(ss, 1); ss += __shfl_xor(ss, 2); ss += __shfl_xor(ss, 4); ss += __shfl_xor(ss, 8); \
            const float rstd = 1.0f / sqrtf(ss * (1.0f / 128.0f) + RMS_EPS); \
            const int t = row_ & (SEQ - 1), pos = (e0 < 64) ? (t >> 6) : (t & 63); \
            const f32x4 c0 = *(const f32x4*)(tab + pos * 32 + fi), c1 = *(const f32x4*)(tab + pos * 32 + fi + 4); \
            const f32x4 s0 = *(const f32x4*)(tab + 4096 + pos * 32 + fi), s1 = *(const f32x4*)(tab + 4096 + pos * 32 + fi + 4); \
            float o[8]; \
            _Pragma("unroll") for (int j = 0; j < 8; ++j) { const float cj = j < 4 ? c0[j & 3] : c1[j & 3], sj = j < 4 ? s0[j & 3] : s1[j & 3], gj = j < 4 ? g0[j & 3] : g1[j & 3], hj = j < 4 ? h0[j & 3] : h1[j & 3]; \
                o[j] = (x[j] * rstd * gj) * cj + sgn * (px[j] * rstd * hj) * sj; } \
            if (XO) { v4u w; w.x = pk2(o[0], o[1]); w.y = pk2(o[2], o[3]); w.z = pk2(o[4], o[5]); w.w = pk2(o[6], o[7]); *(v4u*)(XO + (size_t)it_ * 128 + e0) = w; } \
            v2u w8; w8.x = pk4_fp8(o[0] * s8, o[1] * s8, o[2] * s8, o[3] * s8); w8.y = pk4_fp8(o[4] * s8, o[5] * s8, o[6] * s8, o[7] * s8); *(v2u*)(XO8 + (size_t)it_ * 128 + e0) = w8; } while (0)
        QK_ONE(xa, it0); QK_ONE(xb, it0 + NG); QK_ONE(xc, it0 + 2 * NG); QK_ONE(xd, it0 + 3 * NG);
#undef QK_ONE
    }
}
__device__ __forceinline__ void qk_prep(Frame& F, const In& I, bf16* QAo, bf16* KAo) {
    const float* tab = (const float*)(F.ws + WS_TAB);
    qk_prep_one<16>(F, (const bf16*)(F.ws + WS_QA), QAo, F.ws + WS_Q8, I.q_norm, tab, 8.0f * 0.088388347648318440f * 1.4426950408889634f);
    qk_prep_one<4>(F, (const bf16*)(F.ws + WS_KA), KAo, F.ws + WS_K8, I.k_norm, tab, 1.0f);
}
__device__ __forceinline__ void vt8_prep(Frame& F) {
    const bf16* VA = (const bf16*)(F.ws + WS_VA); unsigned char* VT = F.ws + WS_VT8;
    const int gw = F.vcu * NWAVES + F.wave, NGW = F.G * NWAVES, l = F.lane;
    for (int it = gw; it < 2 * 4 * (SEQ / 64); it += NGW) {
        const int t = it & 127, kvh = (it >> 7) & 3, b = it >> 9;
        const bf16* src = VA + (size_t)(b * SEQ + t * 64) * 512 + kvh * 128 + 2 * l;
        unsigned x[64];
#pragma unroll
        for (int k = 0; k < 64; ++k) x[k] = *(const unsigned*)(src + (size_t)k * 512);
        unsigned char* dst = VT + (size_t)it * 8192;
#pragma unroll
        for (int c = 0; c < 2; ++c) { const int d = 2 * l + c;
#pragma unroll
            for (int s = 0; s < 4; ++s) { const int hi = s >> 1, half = s & 1; unsigned o[4];
#pragma unroll
                for (int rr = 0; rr < 4; ++rr) { const int k0 = 32 * half + 8 * rr + 4 * hi;
                    o[rr] = c ? pk4_fp8(bfhi(x[k0]), bfhi(x[k0 + 1]), bfhi(x[k0 + 2]), bfhi(x[k0 + 3])) : pk4_fp8(bflo(x[k0]), bflo(x[k0 + 1]), bflo(x[k0 + 2]), bflo(x[k0 + 3])); }
                *(v4u*)(dst + d * 64 + ((s ^ ((d >> 2) & 3)) << 4)) = (v4u){o[0], o[1], o[2], o[3]}; } }
    }
}
__device__ __forceinline__ void h1_pass(Frame& F, bf16* QFo, bf16* KFo, bf16* KBo, bf16* QBo) {
    unsigned char* ws = F.ws; const float* tab = (const float*)(ws + WS_TAB);
    const bf16* QF = (const bf16*)(ws + WS_QF); const bf16* KF = (const bf16*)(ws + WS_KF); const bf16* KB = (const bf16*)(ws + WS_KB);
    typedef float f2 __attribute__((ext_vector_type(2)));
    LAS f32x4* tot = (LAS f32x4*)F.lds;
    const int p = F.tid & 127, qd = F.tid >> 7, hf = qd >> 1, second = hf ? (qd & 1) : ((qd & 1) ^ 1);
    const float PMIN = 1.8e-35f;
    for (int it = F.vcu; it < NCHUNK * 8; it += F.G) {
        const int c = it >> 3, cg = it & 7, col = cg * 256 + 2 * p; const size_t vecidx = (size_t)c * 2048 + col;
        const float lbf0 = tab[8192 + col], lbf1 = tab[8192 + col + 1], lbb0 = tab[8192 + 2048 + col], lbb1 = tab[8192 + 2048 + col + 1];
        const size_t base = (size_t)(c * 64 + 16 * qd) * 2048 + col;
        unsigned rq[16], ra[16], rb[16];
#pragma unroll
        for (int j = 0; j < 16; ++j) { rq[j] = *(const unsigned*)(QF + base + (size_t)j * 2048); ra[j] = *(const unsigned*)(KF + base + (size_t)j * 2048); rb[j] = *(const unsigned*)(KB + base + (size_t)j * 2048); }
        float ff0[16], ff1[16], fb0[16], fb1[16]; float TF0 = 1.f, TF1 = 1.f, TB0 = 1.f, TB1 = 1.f;
#pragma unroll
        for (int j = 0; j < 16; ++j) {
            ff0[j] = lbf0 + (1.f - lbf0) * sigm(bflo(ra[j])); ff1[j] = lbf1 + (1.f - lbf1) * sigm(bfhi(ra[j]));
            fb0[j] = lbb0 + (1.f - lbb0) * sigm(bflo(rb[j])); fb1[j] = lbb1 + (1.f - lbb1) * sigm(bfhi(rb[j]));
            TF0 *= ff0[j]; TF1 *= ff1[j]; TB0 *= fb0[j]; TB1 *= fb1[j]; }
        __syncthreads();
        tot[qd * 128 + p] = (f32x4){TF0, TF1, TB0, TB1};
        __syncthreads();
        float PF0 = 1.f, PF1 = 1.f, PB0 = 1.f, PB1 = 1.f;
        if (second) { const f32x4 o = tot[(qd ^ 1) * 128 + p]; PF0 = o.x; PF1 = o.y; PB0 = o.z; PB1 = o.w;
            float* vf = (float*)(ws + (hf == 0 ? WS_RF : WS_WF)) + vecidx; float* vb = (float*)(ws + (hf == 1 ? WS_RB : WS_WB)) + vecidx;
            *(f2*)vf = (f2){PF0 * TF0, PF1 * TF1}; *(f2*)vb = (f2){PB0 * TB0, PB1 * TB1}; }
#define H1_ROW(j) do { const float q0 = bflo(rq[j]), q1 = bfhi(rq[j]); float EF0, EF1, IF0, IF1, EB0, EB1, IB0, IB1; \
            if (hf) { PF0 *= ff0[j]; PF1 *= ff1[j]; EF0 = fmaxf(PF0, PMIN); EF1 = fmaxf(PF1, PMIN); IF0 = __builtin_amdgcn_rcpf(EF0); IF1 = __builtin_amdgcn_rcpf(EF1); \
                      IB0 = fmaxf(PB0, PMIN); IB1 = fmaxf(PB1, PMIN); EB0 = __builtin_amdgcn_rcpf(IB0); EB1 = __builtin_amdgcn_rcpf(IB1); PB0 *= fb0[j]; PB1 *= fb1[j]; } \
            else    { IF0 = fmaxf(PF0, PMIN); IF1 = fmaxf(PF1, PMIN); EF0 = __builtin_amdgcn_rcpf(IF0); EF1 = __builtin_amdgcn_rcpf(IF1); PF0 *= ff0[j]; PF1 *= ff1[j]; \
                      PB0 *= fb0[j]; PB1 *= fb1[j]; EB0 = fmaxf(PB0, PMIN); EB1 = fmaxf(PB1, PMIN); IB0 = __builtin_amdgcn_rcpf(EB0); IB1 = __builtin_amdgcn_rcpf(EB1); } \
            const size_t o_ = base + (size_t)(j) * 2048; \
            *(unsigned*)(QFo + o_) = pk2(q0 * EF0, q1 * EF1); *(unsigned*)(KFo + o_) = pk2((1.f - ff0[j]) * IF0, (1.f - ff1[j]) * IF1); \
            *(unsigned*)(QBo + o_) = pk2(q0 * EB0, q1 * EB1); *(unsigned*)(KBo + o_) = pk2((1.f - fb0[j]) * IB0, (1.f - fb1[j]) * IB1); } while (0)
        if (hf) {
#pragma unroll
            for (int j = 0; j < 16; ++j) H1_ROW(j);
        } else {
#pragma unroll
            for (int j = 15; j >= 0; --j) H1_ROW(j);
        }
#undef H1_ROW
    }
    __syncthreads();
}
__device__ __forceinline__ void p2_small_converts(Frame& F, const In& I) {
    LAS float* scr = (LAS float*)(F.lds + F.wave * 16384);
    const int gw = F.vcu * NWAVES + F.wave, NGW = F.G * NWAVES;
    constexpr int J0 = (DM / 64) * (DM / 32), J1 = (PLE / 64) * (DM / 32);
    for (int it = gw; it < J0 + J1; it += NGW) {
        if (it < J0) p0_transpose_item(I.w_pg, DM, DM, (bf16*)(F.ws + WS_WPG), 0, scr, it, F.lane);
        else p0_transpose_item(I.w_ple, PLE, DM, (bf16*)(F.ws + WS_WPLE), 0, scr, it - J0, F.lane);
    }
    cvt_rows(F, I.p, (bf16*)(F.ws + WS_PB), (size_t)M * PLE / 8);
}
typedef short v4i16_t __attribute__((ext_vector_type(4)));
__device__ __forceinline__ unsigned offb(unsigned row, unsigned ch) { return 256u * row + 16u * (ch ^ (((row & 3u) << 2) | ((row >> 2) & 3u))); }
__device__ __forceinline__ s16x4 vtr(const LAS unsigned char* p) { return __builtin_bit_cast(s16x4, __builtin_amdgcn_ds_read_tr16_b64_v4i16((LAS v4i16_t*)p)); }
#define MFMA16(a, b, c) __builtin_amdgcn_mfma_f32_16x16x32_bf16((a), (b), (c), 0, 0, 0)
struct ScanRegs { v4u rq0, rq1, rk0, rk1, rv0, rv1; f32x4 rw; };
struct ScanCtx { const bf16* QIN; const bf16* KIN; const bf16* VV; bf16* OO; const float* RV; const float* WV; int b, h; int so0, so1; size_t go0, go1; };
template <int DIR>
__device__ __forceinline__ void scan_load(const ScanCtx& C, ScanRegs& R, int it, int tid) {
    const int n = (DIR == 0) ? it : 127 - it; const size_t rb = (size_t)(C.b * SEQ + 64 * n) * 2048;
    R.rq0 = *(const v4u*)(C.QIN + rb + C.go0); R.rk0 = *(const v4u*)(C.KIN + rb + C.go0); R.rv0 = *(const v4u*)(C.VV + rb + C.go0);
    R.rq1 = *(const v4u*)(C.QIN + rb + C.go1); R.rk1 = *(const v4u*)(C.KIN + rb + C.go1); R.rv1 = *(const v4u*)(C.VV + rb + C.go1);
    if (tid < 64) R.rw = *(const f32x4*)((tid < 32 ? C.RV : C.WV) + (size_t)(C.b * 128 + n) * 2048 + C.h * 128 + 4 * (tid & 31));
}
template <int DIR>
__device__ __forceinline__ void scan_step(Frame& F, const ScanCtx& C, ScanRegs& R, f32x4 (&S)[8], int it) {
    LAS unsigned char* lds = F.lds;
    const int tid = F.tid, wid = F.wave; int lane = F.lane;
    asm volatile("" : "+v"(lane));
    const int l15 = lane & 15, g = lane >> 4;
    constexpr int BUFSZ = 3 * 16384 + 1024, AM_OFF = 2 * BUFSZ;
    static_assert(AM_OFF + 8192 <= RING_BYTES, "scan LDS");
    const LAS unsigned char* AM = lds + AM_OFF;
    const int tq = l15 >> 2, tp = lane & 3;
    const int n = (DIR == 0) ? it : 127 - it;
    LAS unsigned char* bufp = lds + (it & 1) * BUFSZ;
    *(LAS v4u*)(bufp + C.so0) = R.rq0; *(LAS v4u*)(bufp + 16384 + C.so0) = R.rk0; *(LAS v4u*)(bufp + 32768 + C.so0) = R.rv0;
    *(LAS v4u*)(bufp + C.so1) = R.rq1; *(LAS v4u*)(bufp + 16384 + C.so1) = R.rk1; *(LAS v4u*)(bufp + 32768 + C.so1) = R.rv1;
    if (tid < 64) *(LAS f32x4*)(bufp + 49152 + tid * 16) = R.rw;
    if (it + 2 < 128) scan_load<DIR>(C, R, it + 2, tid);
    __syncthreads();
    const LAS unsigned char* Qi = bufp; const LAS unsigned char* Ki = bufp + 16384; const LAS unsigned char* Vi = bufp + 32768;
    const LAS float* rI = (const LAS float*)(bufp + 49152); const LAS float* wI = rI + 128;
    { const int ti = wid >> 1, sj0 = (wid & 1) * 2, qrow = 16 * ti + l15, kr0 = 16 * sj0 + l15, kr1 = kr0 + 16;
      f32x4 a0 = (f32x4){0.f, 0.f, 0.f, 0.f}, a1 = a0;
#pragma unroll
      for (int ks = 0; ks < 4; ++ks) { const unsigned ch = 4 * ks + g;
          const bf16x8 qf = *(const LAS bf16x8*)(Qi + (qrow >> 5) * 8192 + offb(qrow & 31, ch));
          const bf16x8 k0 = *(const LAS bf16x8*)(Ki + (kr0 >> 5) * 8192 + offb(kr0 & 31, ch));
          const bf16x8 k1 = *(const LAS bf16x8*)(Ki + (kr1 >> 5) * 8192 + offb(kr1 & 31, ch));
          a0 = MFMA16(k0, qf, a0); a1 = MFMA16(k1, qf, a1); }
      const int t = qrow;
#pragma unroll
      for (int tl = 0; tl < 2; ++tl) { f32x4 v = tl ? a1 : a0; const int sbase = 16 * (sj0 + tl) + 4 * g;
#pragma unroll
          for (int i = 0; i < 4; ++i) { const int s = sbase + i; const bool keep = (DIR == 0) ? (s <= t) : (s >= t); v[i] = keep ? v[i] : 0.f; }
          v2u w2; w2.x = pk2(v[0], v[1]); w2.y = pk2(v[2], v[3]);
          *(LAS v2u*)(lds + AM_OFF + t * 128 + ((((sbase >> 3)) ^ (t & 7)) << 4) + 8 * (g & 1)) = w2; } }
    __syncthreads();
    bf16x8 vf[2];
#pragma unroll
    for (int ks = 0; ks < 2; ++ks) { const LAS unsigned char* tb = Vi + ks * 8192;
        const s16x4 lo = vtr(tb + offb(8 * g + tq, 2 * wid + (tp >> 1)) + 8 * (tp & 1)), hi = vtr(tb + offb(8 * g + 4 + tq, 2 * wid + (tp >> 1)) + 8 * (tp & 1));
        vf[ks] = (bf16x8){lo[0], lo[1], lo[2], lo[3], hi[0], hi[1], hi[2], hi[3]}; }
    f32x4 ao[4];
#pragma unroll
    for (int tt = 0; tt < 4; ++tt) ao[tt] = (f32x4){0.f, 0.f, 0.f, 0.f};
#pragma unroll
    for (int tt = 0; tt < 4; ++tt) { const int t = 16 * tt + l15;
#pragma unroll
        for (int ks = 0; ks < 2; ++ks) { const bf16x8 af = *(const LAS bf16x8*)(AM + t * 128 + (((4 * ks + g) ^ (t & 7)) << 4)); ao[tt] = MFMA16(vf[ks], af, ao[tt]); } }
#pragma unroll
    for (int ks = 0; ks < 4; ++ks) {
        const f32x4 r0 = *(const LAS f32x4*)(rI + 32 * ks + 4 * g), r1 = *(const LAS f32x4*)(rI + 32 * ks + 16 + 4 * g);
        const f32x4 s0 = S[2 * ks] * r0, s1 = S[2 * ks + 1] * r1;
        v4u sw; sw.x = pk2(s0[0], s0[1]); sw.y = pk2(s0[2], s0[3]); sw.z = pk2(s1[0], s1[1]); sw.w = pk2(s1[2], s1[3]);
        const bf16x8 sf = __builtin_bit_cast(bf16x8, sw);
#pragma unroll
        for (int tt = 0; tt < 4; ++tt) { const int t = 16 * tt + l15; const LAS unsigned char* qb = Qi + (t >> 5) * 8192;
            const v2u qa = *(const LAS v2u*)(qb + offb(t & 31, 4 * ks + (g >> 1)) + 8 * (g & 1)), qc = *(const LAS v2u*)(qb + offb(t & 31, 4 * ks + 2 + (g >> 1)) + 8 * (g & 1));
            v4u qw; qw.x = qa.x; qw.y = qa.y; qw.z = qc.x; qw.w = qc.y;
            ao[tt] = MFMA16(sf, __builtin_bit_cast(bf16x8, qw), ao[tt]); } }
    { bf16* op = C.OO + (size_t)(C.b * SEQ + 64 * n + l15) * 2048 + C.h * 128 + 16 * wid + 4 * g;
#pragma unroll
      for (int tt = 0; tt < 4; ++tt) { v2u w2; w2.x = pk2(ao[tt][0], ao[tt][1]); w2.y = pk2(ao[tt][2], ao[tt][3]); *(v2u*)(op + (size_t)(16 * tt) * 2048) = w2; } }
#pragma unroll
    for (int dt = 0; dt < 8; ++dt) { f32x4 T = (f32x4){0.f, 0.f, 0.f, 0.f};
#pragma unroll
        for (int ks = 0; ks < 2; ++ks) { const LAS unsigned char* tb = Ki + ks * 8192;
            const s16x4 lo = vtr(tb + offb(8 * g + tq, 2 * dt + (tp >> 1)) + 8 * (tp & 1)), hi = vtr(tb + offb(8 * g + 4 + tq, 2 * dt + (tp >> 1)) + 8 * (tp & 1));
            const bf16x8 kt = (bf16x8){lo[0], lo[1], lo[2], lo[3], hi[0], hi[1], hi[2], hi[3]};
            T = MFMA16(kt, vf[ks], T); }
        const f32x4 rr = *(const LAS f32x4*)(rI + 16 * dt + 4 * g), ww = *(const LAS f32x4*)(wI + 16 * dt + 4 * g);
        S[dt] = (rr * ww) * S[dt] + ww * T; }
}
template <int DIR>
__device__ __forceinline__ void scan_unit(Frame& F, const bf16* QIN, const bf16* KIN, const bf16* VV, bf16* OO, const float* RV, const float* WV, int b, int h) {
    ScanCtx C; C.QIN = QIN; C.KIN = KIN; C.VV = VV; C.OO = OO; C.RV = RV; C.WV = WV; C.b = b; C.h = h;
    { const int c = F.tid, row = c >> 4, ch = c & 15; C.so0 = (row >> 5) * 8192 + (int)offb(row & 31, ch); C.go0 = (size_t)row * 2048 + h * 128 + ch * 8; }
    { const int c = F.tid + 512, row = c >> 4, ch = c & 15; C.so1 = (row >> 5) * 8192 + (int)offb(row & 31, ch); C.go1 = (size_t)row * 2048 + h * 128 + ch * 8; }
    f32x4 S[8];
#pragma unroll
    for (int i = 0; i < 8; ++i) S[i] = (f32x4){0.f, 0.f, 0.f, 0.f};
    ScanRegs RA, RB; RA.rw = (f32x4){0.f, 0.f, 0.f, 0.f}; RB.rw = RA.rw;
    scan_load<DIR>(C, RA, 0, F.tid); scan_load<DIR>(C, RB, 1, F.tid);
    for (int it = 0; it < 128; it += 2) { scan_step<DIR>(F, C, RA, S, it); scan_step<DIR>(F, C, RB, S, it + 1); }
    __syncthreads();
}
__device__ __forceinline__ void combine_pass(Frame& F, const In& I, bf16* YO, int pitch, int coff) {
    const bf16* OF = (const bf16*)(F.ws + WS_QF); const bf16* OB = (const bf16*)(F.ws + WS_QB); const bf16* GH = (const bf16*)(F.ws + WS_GH);
    const int sub = F.lane & 15, e0 = sub * 8;
    for (int it = (F.vcu * 512 + F.tid) >> 4; it < M * 16; it += F.G * 32) {
        const int row = it >> 4, head = it & 15; const size_t off = (size_t)row * 2048 + head * 128 + e0;
        const v4u a = *(const v4u*)(OF + off), bq = *(const v4u*)(OB + off), gq = *(const v4u*)(GH + off);
        float o[8] = {bflo(a.x) + bflo(bq.x), bfhi(a.x) + bfhi(bq.x), bflo(a.y) + bflo(bq.y), bfhi(a.y) + bfhi(bq.y), bflo(a.z) + bflo(bq.z), bfhi(a.z) + bfhi(bq.z), bflo(a.w) + bflo(bq.w), bfhi(a.w) + bfhi(bq.w)};
        const float gg[8] = {bflo(gq.x), bfhi(gq.x), bflo(gq.y), bfhi(gq.y), bflo(gq.z), bfhi(gq.z), bflo(gq.w), bfhi(gq.w)};
        float ss = 0.f;
#pragma unroll
        for (int j = 0; j < 8; ++j) ss += o[j] * o[j];
        ss += __shfl_xor(ss, 1); ss += __shfl_xor(ss, 2); ss += __shfl_xor(ss, 4); ss += __shfl_xor(ss, 8);
        const float rstd = 1.0f / sqrtf(ss * (1.0f / 128.0f) + RMS_EPS);
        const f32x4 n0 = *(const f32x4*)(I.hg_norm + head * 128 + e0), n1 = *(const f32x4*)(I.hg_norm + head * 128 + e0 + 4);
#pragma unroll
        for (int j = 0; j < 8; ++j) o[j] = o[j] * rstd * (j < 4 ? n0[j & 3] : n1[j & 3]) * gg[j];
        v4u w; w.x = pk2(o[0], o[1]); w.y = pk2(o[2], o[3]); w.z = pk2(o[4], o[5]); w.w = pk2(o[6], o[7]);
        *(v4u*)(YO + (size_t)row * pitch + coff + head * 128 + e0) = w;
    }
}
__device__ __forceinline__ void ln_pass(Frame& F, const float* Xf, const bf16* Xb, const bf16* Y, const float* gam, const float* bet, bf16* XO) {
    const int gw = F.vcu * NWAVES + F.wave, NGW = F.G * NWAVES;
    for (int m = gw; m < M; m += NGW) {
        f32x4 v[16]; float s = 0.f;
#pragma unroll
        for (int j = 0; j < 8; ++j) { const int ch = F.lane + 64 * j;
            const v4u yw = *((const v4u*)(Y + (size_t)m * DM) + ch);
            f32x4 a, b;
            if (Xf) { a = *((const f32x4*)(Xf + (size_t)m * DM) + 2 * ch); b = *((const f32x4*)(Xf + (size_t)m * DM) + 2 * ch + 1); }
            else { const v4u xw = *((const v4u*)(Xb + (size_t)m * DM) + ch); a = (f32x4){bflo(xw.x), bfhi(xw.x), bflo(xw.y), bfhi(xw.y)}; b = (f32x4){bflo(xw.z), bfhi(xw.z), bflo(xw.w), bfhi(xw.w)}; }
            v[2 * j] = a * DN_ALPHA + (f32x4){bflo(yw.x), bfhi(yw.x), bflo(yw.y), bfhi(yw.y)}; v[2 * j + 1] = b * DN_ALPHA + (f32x4){bflo(yw.z), bfhi(yw.z), bflo(yw.w), bfhi(yw.w)};
            s += ((v[2 * j].x + v[2 * j].y) + (v[2 * j].z + v[2 * j].w)) + ((v[2 * j + 1].x + v[2 * j + 1].y) + (v[2 * j + 1].z + v[2 * j + 1].w)); }
        const float mean = wave_sum(s) * (1.f / DM); float s2 = 0.f;
#pragma unroll
        for (int j = 0; j < 16; ++j) { v[j] = v[j] - mean; s2 += (v[j].x * v[j].x + v[j].y * v[j].y) + (v[j].z * v[j].z + v[j].w * v[j].w); }
        const float rstd = 1.f / sqrtf(wave_sum(s2) * (1.f / DM) + LN_EPS);
#pragma unroll
        for (int j = 0; j < 8; ++j) { const int ch = F.lane + 64 * j;
            const f32x4 g0 = *((const f32x4*)gam + 2 * ch), g1 = *((const f32x4*)gam + 2 * ch + 1), b0 = *((const f32x4*)bet + 2 * ch), b1 = *((const f32x4*)bet + 2 * ch + 1);
            const f32x4 y0 = v[2 * j] * rstd * g0 + b0, y1 = v[2 * j + 1] * rstd * g1 + b1;
            v4u w; w.x = pk2(y0.x, y0.y); w.y = pk2(y0.z, y0.w); w.z = pk2(y1.x, y1.y); w.w = pk2(y1.z, y1.w);
            *((v4u*)(XO + (size_t)m * DM) + ch) = w; }
    }
}
__device__ __forceinline__ void conv_pass(Frame& F, const In& I, bf16* HO, int nrows) {
    const bf16* U = (const bf16*)(F.ws + WS_UB); const bf16* Gp = (const bf16*)(F.ws + WS_GB);
    constexpr int NCG = DFF / 8; const int NIT = (nrows / 32) * NCG;
    for (int it = F.vcu * 512 + F.tid; it < NIT; it += F.G * 512) {
        const int r = it / NCG, cg = it - r * NCG, c0 = cg * 8, t0 = r * 32, tl = t0 & (SEQ - 1);
        float w0[8], w1[8], w2[8], bb[8];
        { const f32x4 a0 = *(const f32x4*)(I.conv_w + c0), a1 = *(const f32x4*)(I.conv_w + c0 + 4), b0 = *(const f32x4*)(I.conv_w + DFF + c0), b1 = *(const f32x4*)(I.conv_w + DFF + c0 + 4);
          const f32x4 d0 = *(const f32x4*)(I.conv_w + 2 * DFF + c0), d1 = *(const f32x4*)(I.conv_w + 2 * DFF + c0 + 4), e0 = *(const f32x4*)(I.conv_b + c0), e1 = *(const f32x4*)(I.conv_b + c0 + 4);
#pragma unroll
          for (int j = 0; j < 4; ++j) { w0[j] = a0[j]; w0[4 + j] = a1[j]; w1[j] = b0[j]; w1[4 + j] = b1[j]; w2[j] = d0[j]; w2[4 + j] = d1[j]; bb[j] = e0[j]; bb[4 + j] = e1[j]; } }
        const v4u zero = (v4u){0u, 0u, 0u, 0u};
        const bf16* gq = Gp + (size_t)t0 * DFF + c0; const bf16* uq = U + (size_t)t0 * DFF + c0; bf16* hq = HO + (size_t)t0 * DFF + c0;
        v4u gp = *(const v4u*)(gq - (tl == 0 ? 0 : DFF)); if (tl == 0) gp = zero;
        v4u gc = *(const v4u*)gq;
        for (int j0 = 0; j0 < 32; j0 += 4) {
            v4u gn[4], uu[4];
#pragma unroll
            for (int jj = 0; jj < 4; ++jj) { const bool last = (tl + j0 + jj == SEQ - 1); gn[jj] = *(const v4u*)(gq + (size_t)(j0 + jj + (last ? 0 : 1)) * DFF); if (last) gn[jj] = zero; uu[jj] = *(const v4u*)(uq + (size_t)(j0 + jj) * DFF); }
#pragma unroll
            for (int jj = 0; jj < 4; ++jj) {
                const unsigned gpa[4] = {gp.x, gp.y, gp.z, gp.w}, gca[4] = {gc.x, gc.y, gc.z, gc.w}, gna[4] = {gn[jj].x, gn[jj].y, gn[jj].z, gn[jj].w}, ua[4] = {uu[jj].x, uu[jj].y, uu[jj].z, uu[jj].w};
                unsigned ow[4];
#pragma unroll
                for (int q = 0; q < 4; ++q) {
                    const float a0 = bflo(gpa[q]) * w0[2 * q] + bflo(gca[q]) * w1[2 * q] + bflo(gna[q]) * w2[2 * q] + bb[2 * q];
                    const float a1 = bfhi(gpa[q]) * w0[2 * q + 1] + bfhi(gca[q]) * w1[2 * q + 1] + bfhi(gna[q]) * w2[2 * q + 1] + bb[2 * q + 1];
                    ow[q] = pk2(a0 * sigm(a0) * bflo(ua[q]), a1 * sigm(a1) * bfhi(ua[q])); }
                *(v4u*)(hq + (size_t)(j0 + jj) * DFF) = (v4u){ow[0], ow[1], ow[2], ow[3]};
                gp = gc; gc = gn[jj]; }
        }
    }
}
struct Args { In in; float* out; unsigned char* ws; int ph_lo, ph_hi, li, pad; };
__global__ void __launch_bounds__(NWAVES * 64, 2) mk_fwd(Args args) {
    extern __shared__ __attribute__((aligned(16))) unsigned char lds[];
    Frame F;
    F.lds = (LAS unsigned char*)lds;
    F.MISC = (volatile LAS unsigned*)(F.lds + MISC_OFF);
    F.tid = threadIdx.x; F.lane = F.tid & 63; F.wave = __builtin_amdgcn_readfirstlane(F.tid >> 6);
    F.G = gridDim.x; { const int bx = blockIdx.x; F.vcu = (F.G % 8 == 0) ? (bx % 8) * (F.G / 8) + bx / 8 : bx; }
    F.ws = args.ws; F.out = args.out;
    F.ctl = (gu32*)(args.ws + WS_CTL);
    const In& I = args.in;
    unsigned char* ws = args.ws;
    for (int u = F.tid; u < (LDS_BYTES - LDSCTL_OFF) / 4; u += NWAVES * 64) ((LAS unsigned*)(F.lds + LDSCTL_OFF))[u] = 0u;
    __syncthreads();
    XcdBarrier bar; bar.bar = (unsigned*)(F.ctl + CW_BAR); bar.x = 0; bar.st = nullptr;
    if (N_LAUNCHES == 1) bar = xcd_barrier_post((unsigned*)(F.ctl + CW_BAR), F.MISC + 8);
#define GRID_BAR() do { if (N_LAUNCHES == 1) xcd_barrier(bar); } while (0)
#ifndef SPIN_PHASE
#define SPIN_PHASE -1
#endif
#ifndef SPIN_MULT
#define SPIN_MULT 1
#endif
    unsigned long long t_prev = (SPIN_PHASE >= 0) ? wall_clock64() : 0ull, t_sel = 0ull;
#define TSEL(k) do { if (SPIN_PHASE >= 0) { const unsigned long long now_ = wall_clock64(); if ((k) == SPIN_PHASE) t_sel = now_ - t_prev; t_prev = now_; } } while (0)
    const int lo = args.ph_lo, hi = args.ph_hi;
#ifndef PH_MASK
#define PH_MASK 0xFFFF
#endif
#define IN(k) ((((PH_MASK) >> (k)) & 1) && lo <= (k) && (k) < hi)
#define BOTH(k) (IN(k) && IN((k) + 1))
    bf16* const BT1 = (bf16*)(ws + WS_BT1); bf16* const XB = (bf16*)(ws + WS_XB);
    bf16* const QA = (bf16*)(ws + WS_QA); bf16* const KA = (bf16*)(ws + WS_KA); bf16* const VA = (bf16*)(ws + WS_VA);
    bf16* const QF = (bf16*)(ws + WS_QF); bf16* const KF = (bf16*)(ws + WS_KF); bf16* const KB = (bf16*)(ws + WS_KB); bf16* const QB = (bf16*)(ws + WS_QB);
    bf16* const IH = (bf16*)(ws + WS_IH); bf16* const GH = (bf16*)(ws + WS_GH); bf16* const GATE = (bf16*)(ws + WS_GATE);
    bf16* const MIX = (bf16*)(ws + WS_MIX); bf16* const YCAT = (bf16*)F.out;   bf16* const X1B = (bf16*)(ws + WS_X1B); bf16* const UB = (bf16*)(ws + WS_UB); bf16* const PEB = (bf16*)(ws + WS_PE); bf16* const Y1 = (bf16*)(ws + WS_Y1); bf16* const Y2 = (bf16*)(ws + WS_GB);

#ifndef REPEAT_PHASE
#define REPEAT_PHASE -1
#endif
#ifndef REPEAT_N
#define REPEAT_N 1
#endif
#define REPS(k) for (int rep_ = 0; rep_ < (REPEAT_PHASE == (k) ? REPEAT_N : 0); ++rep_)
    bf16* const DUMMY = (bf16*)F.out;
    if (IN(0)) { if (REPEAT_PHASE == 0) { p0_prologue(F, I); GRID_BAR(); } p0_prologue(F, I); if (BOTH(0)) { GRID_BAR(); TSEL(0); } }
    if (IN(1)) {
        { pg8::Gemm g{(const bf16*)((const unsigned char*)F.out + OUT_X8), (const bf16*)((const unsigned char*)F.out + OUT_W8A), M, N_F8, DM / 2}; pg8::StaticOrder S; S.init(M, N_F8, F.G, (int)blockIdx.x);
          pg8::EpiProj E{QA, KA, VA, QF, KF, KB, IH, GH, GATE, I.b_gate, 0, 1.0f / GATE_WSCALE, N_ATT, 2048};
          pg8::gemm_phase<pg8::EpiProj, pg8::StaticOrder, true, true, true>(F.lds, g, S, E); }
        { pg8::Gemm g{XB, BT1 + (size_t)N_ATT * DM, M, N_IN - N_F8, DM}; pg8::StaticOrder S; S.init(M, N_IN - N_F8, F.G, (int)blockIdx.x);
          pg8::EpiProj E{QA, KA, VA, QF, KF, KB, IH, GH, GATE, I.b_gate, N_ATT, 1.0f, 5120, 4096};
          pg8::gemm_phase<pg8::EpiProj, pg8::StaticOrder, true, true>(F.lds, g, S, E); }
        if (BOTH(1)) { GRID_BAR(); TSEL(1); }
    }
    if (IN(2)) {
        REPS(21) { h1_pass(F, DUMMY, DUMMY + (size_t)M * 2048, DUMMY + (size_t)M * 4096, DUMMY + (size_t)M * 6144); GRID_BAR(); }
        REPS(22) { p2_small_converts(F, I); GRID_BAR(); }

#ifdef PROBE_ATTN
        qk_prep(F, I, QA, KA);
#else
        qk_prep(F, I, nullptr, nullptr);
#endif
        vt8_prep(F); h1_pass(F, QF, KF, KB, QB); p2_small_converts(F, I); if (BOTH(2)) { GRID_BAR(); TSEL(2); } }
    if (IN(3)) {
#ifdef UB_VAR
        { typedef float ub16 __attribute__((ext_vector_type(16))); typedef int ub8 __attribute__((ext_vector_type(8)));
          ub16 a0 = {}, a1 = {}, a2 = {}, a3 = {}; ub8 fa, fb; int sc = 0x7F7F7F7F; float xs[16], sum = 0.f;
#pragma unroll
          for (int j = 0; j < 8; ++j) { fa[j] = 0x38383838 + F.lane; fb[j] = 0x38383838 + j; }
#pragma unroll
          for (int j = 0; j < 16; ++j) xs[j] = 0.01f * (float)(F.lane + j);
          asm volatile("" : "+v"(fa), "+v"(fb), "+v"(sc));
          const bool gB = (UB_VAR == 3) ? (F.wave >= 4) : ((F.wave & 1) != 0);
          const bool doM = (UB_VAR == 1) || (UB_VAR >= 3 && !gB), doV = (UB_VAR == 2) || (UB_VAR >= 3 && gB);
          for (int it = 0; it < 8000; ++it) {
              if (doM) { asm volatile("v_mfma_scale_f32_32x32x64_f8f6f4 %0, %4, %5, %0, %6, %6 op_sel_hi:[0,0,0]\n\tv_mfma_scale_f32_32x32x64_f8f6f4 %1, %4, %5, %1, %6, %6 op_sel_hi:[0,0,0]\n\t"
                                      "v_mfma_scale_f32_32x32x64_f8f6f4 %2, %4, %5, %2, %6, %6 op_sel_hi:[0,0,0]\n\tv_mfma_scale_f32_32x32x64_f8f6f4 %3, %4, %5, %3, %6, %6 op_sel_hi:[0,0,0]"
                                      : "+v"(a0), "+v"(a1), "+v"(a2), "+v"(a3) : "v"(fa), "v"(fb), "v"(sc)); }
              if (doV) {
#pragma unroll
                  for (int j = 0; j < 16; ++j) { xs[j] = __builtin_amdgcn_exp2f(-xs[j]); sum += xs[j]; }
#pragma unroll
                  for (int j = 0; j < 16; ++j) { xs[j] = __builtin_amdgcn_exp2f(-xs[j]); sum += xs[j]; }
                  asm volatile("" : "+v"(sum)); } }
          asm volatile("s_nop 15\n\ts_nop 7" : "+v"(a0), "+v"(a1), "+v"(a2), "+v"(a3));
          if (a0[0] + a1[1] + a2[2] + a3[3] + sum == 123456.789f) ((volatile float*)(F.ctl + 20480))[F.tid] = sum;
          GRID_BAR(); }
#endif
#ifdef ATT_VAR
        { float negM0 = -16.6f; const unsigned char* const Q8 = ws + WS_Q8; const unsigned char* const K8 = ws + WS_K8;
          for (int u = F.vcu; u < 1024; u += F.G) { const int gI = u >> 7, r = u & 127, b = gI >> 2, kvh = gI & 3, qh = kvh * 4 + (r >> 5), qb = r & 31;
            const size_t qoff = (size_t)(b * SEQ + qb * 256) * 2048 + qh * 128, koff = (size_t)(b * SEQ) * 512 + kvh * 128;
            attn::attn_dense_body_q8v8<ATT_VAR>(Q8 + qoff, K8 + koff, ws + WS_VT8 + (size_t)gI * (SEQ / 64) * 8192, YCAT + (size_t)(b * SEQ + qb * 256) * 4096 + qh * 128, SEQ, (char*)lds, F.lds, negM0); }
          GRID_BAR(); }
#endif
        if (REPEAT_PHASE == 32) { if (blockIdx.x < 64) { const int u = blockIdx.x, dir = u >> 5, b = (u >> 4) & 1, h = u & 15;
            if (dir == 0) scan_unit<0>(F, QF, KF, IH, DUMMY, (const float*)(ws + WS_RF), (const float*)(ws + WS_WF), b, h);
            else          scan_unit<1>(F, QB, KB, IH, DUMMY + (size_t)M * 2048, (const float*)(ws + WS_RB), (const float*)(ws + WS_WB), b, h); }
          GRID_BAR(); }
        if (blockIdx.x < 64) { const int u = blockIdx.x, dir = u >> 5, b = (u >> 4) & 1, h = u & 15;
            if (dir == 0) scan_unit<0>(F, QF, KF, IH, QF, (const float*)(ws + WS_RF), (const float*)(ws + WS_WF), b, h);
            else          scan_unit<1>(F, QB, KB, IH, QB, (const float*)(ws + WS_RB), (const float*)(ws + WS_WB), b, h); }
        if (SPIN_PHASE == 33) t_sel = wall_clock64() - t_prev;
        {
        float negM;
        { float gq = fmaxf(fabsf(I.q_norm[F.lane]), fabsf(I.q_norm[F.lane + 64])), gk = fmaxf(fabsf(I.k_norm[F.lane]), fabsf(I.k_norm[F.lane + 64]));
#pragma unroll
          for (int o = 1; o < 64; o <<= 1) { gq = fmaxf(gq, __shfl_xor(gq, o)); gk = fmaxf(gk, __shfl_xor(gk, o)); }
          negM = __uint_as_float(__builtin_amdgcn_readfirstlane(__float_as_uint(-1.4426950408889634f * (11.313708499f * 1.01f) * gq * gk))); }
        const unsigned char* const Q8 = ws + WS_Q8; const unsigned char* const K8 = ws + WS_K8;
#ifdef PROBE_ATTN
        for (int u = F.vcu; u < 1024; u += F.G) { const int gI = u >> 7, r = u & 127, b = gI >> 2, kvh = gI & 3, qh = kvh * 4 + (r >> 5), qb = r & 31;
            const size_t qoff = (size_t)(b * SEQ + qb * 256) * 2048 + qh * 128, koff = (size_t)(b * SEQ) * 512 + kvh * 128;
            attn::attn_dense_body(QA + qoff, KA + koff, VA + koff, YCAT + (size_t)(b * SEQ + qb * 256) * 4096 + qh * 128, SEQ, (char*)lds, negM); }
        for (int u = F.vcu; u < 1024; u += F.G) { const int gI = u >> 7, r = u & 127, b = gI >> 2, kvh = gI & 3, qh = kvh * 4 + (r >> 5), qb = r & 31;
            const size_t qoff = (size_t)(b * SEQ + qb * 256) * 2048 + qh * 128, koff = (size_t)(b * SEQ) * 512 + kvh * 128;
            attn::attn_dense_body_q8(Q8 + qoff, K8 + koff, VA + koff, YCAT + (size_t)(b * SEQ + qb * 256) * 4096 + 2048 + qh * 128, SEQ, (char*)lds, F.lds, negM); }
#else
        { unsigned* actr = (unsigned*)(F.ctl + 12288); volatile LAS int* aslot = (volatile LAS int*)(F.MISC + 24);
          if (F.tid == 0) aslot[0] = (int)__hip_atomic_fetch_add(actr, 1u, __ATOMIC_RELAXED, __HIP_MEMORY_SCOPE_AGENT);
          __syncthreads();
          for (int i = 0; ; ++i) { const int u = __builtin_amdgcn_readfirstlane(aslot[i & 1]); if (u >= 1024) break;
            int nxt = 0; if (F.tid == 0) nxt = (int)__hip_atomic_fetch_add(actr, 1u, __ATOMIC_RELAXED, __HIP_MEMORY_SCOPE_AGENT);
            const int gI = u >> 7, r = u & 127, b = gI >> 2, kvh = gI & 3, qh = kvh * 4 + (r >> 5), qb = r & 31;
            const size_t qoff = (size_t)(b * SEQ + qb * 256) * 2048 + qh * 128, koff = (size_t)(b * SEQ) * 512 + kvh * 128;
            attn::attn_dense_body_q8v8(Q8 + qoff, K8 + koff, ws + WS_VT8 + (size_t)gI * (SEQ / 64) * 8192, (bf16*)((unsigned char*)YCAT + (size_t)(b * SEQ + qb * 256) * 8192 + qh * 128), SEQ, (char*)lds, F.lds, negM);
            if (F.tid == 0) aslot[(i + 1) & 1] = nxt;
            __syncthreads(); } }
#endif
        }
        if (SPIN_PHASE == 34) t_sel = wall_clock64() - t_prev;
        { pg8::Gemm g{(const bf16*)((const unsigned char*)F.out + OUT_X8), (const bf16*)((const unsigned char*)F.out + OUT_W8), M, 2 * DM, DM / 2};
          pg8::DynOrder S{(unsigned*)(F.ctl + 8192 + 64 * (blockIdx.x & 7)), (LAS volatile int*)(F.MISC + 16), (int)(blockIdx.x & 7)};
          S.prime();
          pg8::EpiGate E{GATE, 2 * DM, I.b_gate, 1.0f / GATE_WSCALE};
          pg8::gemm_phase<pg8::EpiGate, pg8::DynOrder, true, true, true>(F.lds, g, S, E); }
    }
    if (IN(4)) {
        if (BOTH(4)) { GRID_BAR(); TSEL(4); }
#ifdef PROBE_ATTN
        { float sd = 0.f, sr = 0.f;
          for (size_t i = (size_t)blockIdx.x * 512 + F.tid; i < (size_t)M * 256; i += (size_t)F.G * 512) { const size_t row = i >> 8, c8 = i & 255;
              const v4u a = *(const v4u*)(YCAT + row * 4096 + c8 * 8), b = *(const v4u*)(YCAT + row * 4096 + 2048 + c8 * 8);
              const unsigned aw[4] = {a.x, a.y, a.z, a.w}, bw[4] = {b.x, b.y, b.z, b.w};
#pragma unroll
              for (int q = 0; q < 4; ++q) { const float r0 = bflo(aw[q]), r1 = bfhi(aw[q]), d0 = bflo(bw[q]) - r0, d1 = bfhi(bw[q]) - r1; sd += d0 * d0 + d1 * d1; sr += r0 * r0 + r1 * r1; } }
          sd = wave_sum(sd); sr = wave_sum(sr);
          LAS float* red = (LAS float*)F.lds;
          __syncthreads(); if (F.lane == 0) { red[2 * F.wave] = sd; red[2 * F.wave + 1] = sr; } __syncthreads();
          float* slots = (float*)(F.ctl + 16384);
          if (F.tid == 0) { float a = 0.f, b = 0.f; for (int w = 0; w < 8; ++w) { a += red[2 * w]; b += red[2 * w + 1]; } slots[2 * blockIdx.x] = a; slots[2 * blockIdx.x + 1] = b; }
          GRID_BAR();
          float tsd = 0.f, tsr = 0.f;
          for (int w = 0; w < (int)F.G; ++w) { tsd += __hip_atomic_load(slots + 2 * w, __ATOMIC_RELAXED, __HIP_MEMORY_SCOPE_AGENT); tsr += __hip_atomic_load(slots + 2 * w + 1, __ATOMIC_RELAXED, __HIP_MEMORY_SCOPE_AGENT); }
          const float A = rintf(20.f + 4.f * log10f(fmaxf(tsd / fmaxf(tsr, 1e-30f), 1e-12f)));
          for (size_t i = (size_t)blockIdx.x * 512 + F.tid; i < (size_t)M * DM; i += (size_t)F.G * 512) F.out[i] = A;
          return; }
#endif
    }
    if (IN(5)) { REPS(5) { combine_pass(F, I, DUMMY, 2048, 0); GRID_BAR(); } combine_pass(F, I, YCAT, 4096, 2048); if (BOTH(5)) { GRID_BAR(); TSEL(5); } }
    if (IN(6)) {
        pg8::Gemm g{YCAT, (bf16*)(ws + WS_WPAB), M, DM, DM}; pg8::StaticOrder S; S.init(M, DM, F.G, (int)blockIdx.x);
        pg8::EpiMix E{(unsigned char*)MIX, DM, GATE, 2 * DM, MIX_ASCALE, 1.0f / (32.0f * GATE_WSCALE)};
        if (REPEAT_PHASE == 6) { pg8::gemm_phase<pg8::EpiMix, pg8::StaticOrder, true, true, false, 0, true>(F.lds, g, S, E); GRID_BAR(); }
        pg8::gemm_phase<pg8::EpiMix, pg8::StaticOrder, true, true, false, 0, true>(F.lds, g, S, E);
        if (BOTH(6)) { GRID_BAR(); TSEL(6); }
    }
    if (IN(8)) {
        pg8::Gemm g{MIX, (bf16*)(ws + WS_WO), M, DM, DM / 2}; pg8::StaticOrder S; S.init(M, DM, F.G, (int)blockIdx.x);
        pg8::EpiBf16S E{Y1, DM, 0, 0, 1.0f / (MIX_ASCALE * GATE_WSCALE)};
        if (REPEAT_PHASE == 8) { pg8::gemm_phase<pg8::EpiBf16S, pg8::StaticOrder, true, true, true>(F.lds, g, S, E); GRID_BAR(); }
        pg8::gemm_phase<pg8::EpiBf16S, pg8::StaticOrder, true, true, true>(F.lds, g, S, E);
        if (BOTH(8)) { GRID_BAR(); TSEL(8); }
    }
    if (IN(9)) { REPS(9) { ln_pass(F, I.x, nullptr, Y1, I.ln1_g, I.ln1_b, X1B); GRID_BAR(); } ln_pass(F, nullptr, XB, Y1, I.ln1_g, I.ln1_b, X1B); if (BOTH(9)) { GRID_BAR(); TSEL(9); } }
    if (IN(10)) {
        pg8::Gemm g{X1B, (bf16*)(ws + WS_WUP), M, 2 * DFF, DM}; pg8::StaticOrder S; S.init(M, 2 * DFF, F.G, (int)blockIdx.x);
        pg8::EpiBf16 E{UB, DFF, DFF, (size_t)M * DFF};
        if (REPEAT_PHASE == 10) { pg8::gemm_phase<pg8::EpiBf16, pg8::StaticOrder, true, true>(F.lds, g, S, E); GRID_BAR(); }
        if (REPEAT_PHASE == 101) { pg8::SameTileOrder S2; S2.init(M, 2 * DFF, F.G, (int)blockIdx.x);
            const unsigned long long c0 = clock64(), r0 = wall_clock64();
            pg8::gemm_phase<pg8::EpiBf16, pg8::SameTileOrder, true, true>(F.lds, g, S2, E);
            const unsigned long long c1 = clock64(), r1 = wall_clock64();
            if (blockIdx.x == 0) { const unsigned long long spin = (c1 - c0) * 5000ull / (r1 - r0);
                while (wall_clock64() - r1 < spin) __builtin_amdgcn_s_sleep(8); }
            GRID_BAR(); }
        if (REPEAT_PHASE == 104) { pg8::gemm_phase<pg8::EpiBf16, pg8::StaticOrder, true, true, false, 2>(F.lds, g, S, E); GRID_BAR(); }
        if (REPEAT_PHASE == 105) { pg8::gemm_phase<pg8::EpiBf16, pg8::StaticOrder, true, true, false, 4>(F.lds, g, S, E); GRID_BAR(); }
        if (REPEAT_PHASE == 103) { pg8::gemm_phase<pg8::EpiBf16, pg8::StaticOrder, true, true, false, 1>(F.lds, g, S, E); GRID_BAR(); }
        if (REPEAT_PHASE == 102) { int nv = 0; asm volatile("" : "+s"(nv)); pg8::EpiNull E0{UB, nv}; pg8::gemm_phase<pg8::EpiNull, pg8::StaticOrder, true, true>(F.lds, g, S, E0); GRID_BAR(); }
        if (REPEAT_PHASE == 100) { pg8::SameTileOrder S2; S2.init(M, 2 * DFF, F.G, (int)blockIdx.x); pg8::gemm_phase<pg8::EpiBf16, pg8::SameTileOrder, true, true>(F.lds, g, S2, E); GRID_BAR(); }
        { pg8::DynOrder Sd{(unsigned*)(F.ctl + 24576 + 64 * (blockIdx.x & 7)), (LAS volatile int*)(F.MISC + 16), (int)(blockIdx.x & 7), 8 * (2 * DFF / 256)};
          Sd.prime();
          pg8::gemm_phase<pg8::EpiBf16, pg8::DynOrder, true, true>(F.lds, g, Sd, E); }
        { int kk = PLE; asm volatile("" : "+s"(kk));
          pg8::Gemm g2{(bf16*)(ws + WS_PB), (bf16*)(ws + WS_WPLE), M, DM, kk};
          pg8::DynOrder S2{(unsigned*)(F.ctl + 28672 + 64 * (blockIdx.x & 7)), (LAS volatile int*)(F.MISC + 20), (int)(blockIdx.x & 7), 8 * (DM / 256)};
          S2.prime();
          pg8::EpiBf16 E2{PEB, DM, 0, 0};
          pg8::gemm_phase<pg8::EpiBf16, pg8::DynOrder, true, true>(F.lds, g2, S2, E2); }
        if (BOTH(10)) { GRID_BAR(); TSEL(10); }
    }
    if (IN(11)) { REPS(11) { conv_pass(F, I, (bf16*)(ws + WS_WUP), M / 2); GRID_BAR(); } conv_pass(F, I, UB, M); if (BOTH(11)) { GRID_BAR(); TSEL(11); } }
    if (IN(12)) {
        pg8::Gemm g{UB, (bf16*)(ws + WS_WDN), M, DM, DFF}; pg8::StaticOrder S; S.init(M, DM, F.G, (int)blockIdx.x);
        pg8::EpiBf16 E{Y2, DM, 0, 0};
        if (REPEAT_PHASE == 12) { pg8::gemm_phase<pg8::EpiBf16, pg8::StaticOrder, true, true>(F.lds, g, S, E); GRID_BAR(); }
        pg8::gemm_phase<pg8::EpiBf16, pg8::StaticOrder, true, true>(F.lds, g, S, E);
        if (BOTH(12)) { GRID_BAR(); TSEL(12); }
    }
    if (IN(13)) { REPS(13) { ln_pass(F, nullptr, X1B, Y2, I.ln2_g, I.ln2_b, (bf16*)(ws + WS_UB)); GRID_BAR(); } ln_pass(F, nullptr, X1B, Y2, I.ln2_g, I.ln2_b, X1B); if (BOTH(13)) { GRID_BAR(); TSEL(13); } }
    if (IN(15)) {
        pg8::Gemm g{X1B, (bf16*)(ws + WS_WPG), M, DM, DM}; pg8::StaticOrder S; S.init(M, DM, F.G, (int)blockIdx.x);
        pg8::EpiFinal E{X1B, F.out, PEB, DM};
        if (REPEAT_PHASE == 15) { pg8::gemm_phase<pg8::EpiFinal, pg8::StaticOrder, true, true>(F.lds, g, S, E); GRID_BAR(); }
        pg8::gemm_phase<pg8::EpiFinal, pg8::StaticOrder, true, true>(F.lds, g, S, E);
    }
    if (SPIN_PHASE >= 0) { if (SPIN_PHASE == 15) t_sel = wall_clock64() - t_prev; if (blockIdx.x == 0) { const unsigned long long t1 = wall_clock64(); while (wall_clock64() - t1 < t_sel * SPIN_MULT) __builtin_amdgcn_s_sleep(8); } }
#undef IN
#undef BOTH
#undef GRID_BAR
}

extern "C" void kernel_launch(void* const* d_in, const int* in_sizes, int n_in, void* d_out, int out_size, void* d_ws, size_t ws_size, hipStream_t stream) {
    static int grid = 0;
    if (grid == 0) {
        if (n_in != 22 || in_sizes[0] != M * DM || out_size != M * DM || ws_size < WS_END) { fprintf(stderr, "kernel_launch: shape mismatch n_in %d in0 %d out %d ws %zu (need %zu)\n", n_in, n_in > 0 ? in_sizes[0] : -1, out_size, ws_size, (size_t)WS_END); grid = -1; return; }
        int dev = 0, cus = 0, per_cu = 0;
        if (hipGetDevice(&dev) != hipSuccess || hipDeviceGetAttribute(&cus, hipDeviceAttributeMultiprocessorCount, dev) != hipSuccess) { grid = -1; return; }
        if (hipFuncSetAttribute((const void*)mk_fwd, hipFuncAttributeMaxDynamicSharedMemorySize, LDS_BYTES) != hipSuccess) { fprintf(stderr, "kernel_launch: hipFuncSetAttribute failed\n"); grid = -1; return; }
        if (hipOccupancyMaxActiveBlocksPerMultiprocessor(&per_cu, (const void*)mk_fwd, NWAVES * 64, LDS_BYTES) != hipSuccess || per_cu < 1) fprintf(stderr, "kernel_launch: occupancy query says %d\n", per_cu);
        (void)hipGetLastError();
        grid = cus;
        if (grid != 256) { fprintf(stderr, "kernel_launch: built for 256 CUs, got %d; nothing launched\n", grid); grid = -1; return; }
    }
    if (grid < 0) return;
    (void)hipMemsetAsync((char*)d_ws + WS_CTL, 0, CTL_ZERO_BYTES, stream);
    Args a{};
    const float** ip = (const float**)&a.in;
    for (int i = 0; i < 22; ++i) ip[i] = (const float*)d_in[i];
    a.out = (float*)d_out; a.ws = (unsigned char*)d_ws; a.pad = 0;
    if (N_LAUNCHES == 1) { a.ph_lo = 0; a.ph_hi = N_PHASES; a.li = 0; hipLaunchKernelGGL(mk_fwd, dim3(grid), dim3(NWAVES * 64), LDS_BYTES, stream, a); }
    else for (int li = 0; li < N_PHASES; ++li) { a.ph_lo = li; a.ph_hi = li + 1; a.li = li; hipLaunchKernelGGL(mk_fwd, dim3(grid), dim3(NWAVES * 64), LDS_BYTES, stream, a); }
    const hipError_t le = hipPeekAtLastError();
    if (le != hipSuccess) fprintf(stderr, "kernel_launch: launch failed: %s\n", hipGetErrorName(le));
}
```

```cpp
#define PG8_SADDR 1
#include <hip/hip_runtime.h>
#include <cstdio>
#include <cstdint>
namespace pg8 {
#define PG8_LAS __attribute__((address_space(3)))
typedef unsigned short bf16_t;
typedef short bf16x8 __attribute__((ext_vector_type(8)));
typedef float f32x4 __attribute__((ext_vector_type(4)));
typedef unsigned u32x4 __attribute__((ext_vector_type(4)));
constexpr int BM = 256, BK = 64, HALF = 128, HTB = HALF * BK * 2  , STAGE_BYTES = 8 * HTB, NXCD = 8, WGM = 8;

__host__ __device__ __forceinline__ int lds_byte(int r, int c) { const int st = (r >> 4) * 2 + (c >> 5), rr = r & 15, cc = c & 31, ob = rr * 64 + cc * 2; return st * 1024 + (ob ^ (((ob >> 9) & 1) << 5)); }
__host__ __device__ __forceinline__ void stage_rc(int b, int& R, int& C) { const int st = b / 1024, sb = b % 1024, swz = sb ^ (((sb >> 9) & 1) << 5); R = (st >> 1) * 16 + swz / 64; C = (st & 1) * 32 + (swz % 64) / 2; }
__host__ __device__ __forceinline__ int perm32(int rho) { const int n = rho >> 4, i = rho & 15; return 8 * (i >> 2) + 4 * n + (i & 3); }

struct Unit { int pm, pn; };
struct Gemm { const bf16_t* A; const bf16_t* Bt; int M, N, K; };

struct StaticOrder {
    int nM, nN, nwg, G, c;
    __host__ __device__ void init(int M, int N, int G_, int c_) { nM = M / BM; nN = N / BM; nwg = nM * nN; G = G_; c = c_; }
    __host__ __device__ bool next(int i, Unit& u) const {
        const long L = (long)i * G + c; if (L >= nwg) return false;
        int wgid = (int)L; { const int q = nwg / NXCD, r = nwg % NXCD, xcd = wgid % NXCD, off = wgid / NXCD; wgid = (xcd < r ? xcd * (q + 1) : r * (q + 1) + (xcd - r) * q) + off; }
        const int nig = WGM * nN, gid = wgid / nig, fm = gid * WGM, gsz = (nM - fm) < WGM ? (nM - fm) : WGM;
        u.pm = fm + ((wgid % nig) % gsz); u.pn = (wgid % nig) / gsz; return true;
    }
    __device__ __forceinline__ void a_ready(const Unit&) const {}
    __device__ __forceinline__ void done(const Unit&) const {}
};

struct SplitOrder {
    int c;
    __host__ __device__ bool next(int i, Unit& u) const {
        int L;
        if (c < 64) { if (i >= 5) return false; L = 768 + i * 256 + c; }
        else { if (i >= 9) return false; L = (i < 4) ? i * 192 + (c - 64) : 768 + (i - 4) * 256 + c; }
        const int wgid = (L % NXCD) * 256 + L / NXCD;
        const int gid = wgid / 256, fm = gid * WGM, rem = wgid % 256;
        u.pm = fm + rem % WGM; u.pn = rem / WGM; return true;
    }
    __device__ __forceinline__ void a_ready(const Unit&) const {}
    __device__ __forceinline__ void done(const Unit&) const {}
};

struct SameTileOrder : StaticOrder {
    __host__ __device__ bool next(int i, Unit& u) const { const long L = (long)i * G + c; if (L >= nwg) return false; u.pm = c & 7; u.pn = (c >> 3) & 7; return true; }
};

struct PeOrder {
    int c;
    __host__ __device__ bool next(int i, Unit& u) const {
        if (c < 128 || i >= 8) return false;
        const int L = (c - 128) * 8 + i;
        u.pm = L >> 4; u.pn = L & 15; return true;
    }
    __device__ __forceinline__ void a_ready(const Unit&) const {}
    __device__ __forceinline__ void done(const Unit&) const {}
};

struct DynOrder {
    unsigned* ctr; PG8_LAS volatile int* slots; int xcd;
    __device__ __forceinline__ void prime() const {
        if (threadIdx.x == 0) { slots[0] = (int)__hip_atomic_fetch_add(ctr, 1u, __ATOMIC_RELAXED, __HIP_MEMORY_SCOPE_AGENT); slots[1] = (int)__hip_atomic_fetch_add(ctr, 1u, __ATOMIC_RELAXED, __HIP_MEMORY_SCOPE_AGENT); }
        __syncthreads();
    }
    __device__ __forceinline__ bool next(int i, Unit& u) const {
        const int t = __builtin_amdgcn_readfirstlane(slots[i & 3]);
        if (i >= 1 && threadIdx.x == 0) slots[(i + 1) & 3] = (int)__hip_atomic_fetch_add(ctr, 1u, __ATOMIC_RELAXED, __HIP_MEMORY_SCOPE_AGENT);
        if (t >= 256) return false;
        const int fm = xcd * WGM; u.pm = fm + t % WGM; u.pn = t / WGM; return true;
    }
    __device__ __forceinline__ void a_ready(const Unit&) const {}
    __device__ __forceinline__ void done(const Unit&) const {}
};
__device__ __forceinline__ unsigned cvt_pk_bf16(float lo, float hi) { unsigned r; asm volatile("v_cvt_pk_bf16_f32 %0, %1, %2" : "=v"(r) : "v"(lo), "v"(hi)); return r; }
typedef unsigned u32x2 __attribute__((ext_vector_type(2)));
__device__ __forceinline__ float bf_lo(unsigned w) { return __uint_as_float(w << 16); }
__device__ __forceinline__ float bf_hi(unsigned w) { return __uint_as_float(w & 0xffff0000u); }
__device__ __forceinline__ float sigmoid_f(float v) { return __builtin_amdgcn_rcpf(1.0f + __expf(-v)); }

struct EpiBf16 {
    static constexpr bool PERM = true, AFTER_DRAIN = false; static constexpr int MID_K = -1;
    bf16_t* O; int ldc; int split_cols; size_t split_stride;
    __device__ __forceinline__ void operator()(const f32x4 (&acc)[2][2][4][2], const Unit& u, int wr, int wc, int fr, int fq) const {
        const int row0 = u.pm * BM + wr * 64 + fr; int colt = u.pn * BM; bf16_t* base = O;
        if (split_cols) { const int t = colt / split_cols; base += (size_t)t * split_stride; colt -= t * split_cols; }
        const int col0 = colt + wc * 32 + 8 * fq;
#pragma unroll
        for (int ai = 0; ai < 2; ++ai)
#pragma unroll
            for (int m = 0; m < 4; ++m) { bf16_t* rowp = base + (size_t)(row0 + ai * HALF + m * 16) * ldc + col0;
#pragma unroll
                for (int bj = 0; bj < 2; ++bj) { const f32x4 v0 = acc[ai][bj][m][0], v1 = acc[ai][bj][m][1];
                    u32x4 w; w.x = cvt_pk_bf16(v0[0], v0[1]); w.y = cvt_pk_bf16(v0[2], v0[3]); w.z = cvt_pk_bf16(v1[0], v1[1]); w.w = cvt_pk_bf16(v1[2], v1[3]);
                    *(u32x4*)(rowp + bj * HALF) = w; } }
    }
    struct Ctx { bf16_t* base; int cadj; };
    __device__ __forceinline__ Ctx begin(const Unit& u) const { Ctx c{O, 0}; if (split_cols) { const int t = (u.pn * BM) / split_cols; c.base += (size_t)t * split_stride; c.cadj = -t * split_cols; } return c; }
    __device__ __forceinline__ void chunk4(const Ctx& c, int row, int col, f32x4& v) const {
        typedef unsigned u32x2_e __attribute__((ext_vector_type(2)));
        *(u32x2_e*)(c.base + (size_t)row * ldc + col + c.cadj) = (u32x2_e){cvt_pk_bf16(v[0], v[1]), cvt_pk_bf16(v[2], v[3])}; }
};
struct EpiBf16S {
    static constexpr bool PERM = true, AFTER_DRAIN = false; static constexpr int MID_K = -1;
    bf16_t* O; int ldc; int split_cols; size_t split_stride; float ascale;
    __device__ __forceinline__ void operator()(const f32x4 (&acc)[2][2][4][2], const Unit& u, int wr, int wc, int fr, int fq) const {
        const int row0 = u.pm * BM + wr * 64 + fr; int colt = u.pn * BM; bf16_t* base = O;
        if (split_cols) { const int t = colt / split_cols; base += (size_t)t * split_stride; colt -= t * split_cols; }
        const int col0 = colt + wc * 32 + 8 * fq;
#pragma unroll
        for (int ai = 0; ai < 2; ++ai)
#pragma unroll
            for (int m = 0; m < 4; ++m) { bf16_t* rowp = base + (size_t)(row0 + ai * HALF + m * 16) * ldc + col0;
#pragma unroll
                for (int bj = 0; bj < 2; ++bj) { const f32x4 v0 = acc[ai][bj][m][0] * ascale, v1 = acc[ai][bj][m][1] * ascale;
                    u32x4 w; w.x = cvt_pk_bf16(v0[0], v0[1]); w.y = cvt_pk_bf16(v0[2], v0[3]); w.z = cvt_pk_bf16(v1[0], v1[1]); w.w = cvt_pk_bf16(v1[2], v1[3]);
                    *(u32x4*)(rowp + bj * HALF) = w; } }
    }
};
struct EpiProj {
    static constexpr bool PERM = true, AFTER_DRAIN = false; static constexpr int MID_K = -1;
    bf16_t *QA, *KA, *VA, *QH, *ZF, *ZB, *IH, *GH, *GATE; const float* bgate; int col_base; float ascale; int skip_at, skip_by;
    __device__ __forceinline__ void operator()(const f32x4 (&acc)[2][2][4][2], const Unit& u, int wr, int wc, int fr, int fq) const {
        const int row0 = u.pm * BM + wr * 64 + fr; int colt = u.pn * BM + col_base; bf16_t* base; int ldc = 2048; int act = 0; const float* bias = nullptr;
        if (colt >= skip_at) colt += skip_by;
        if (colt < 2048) { base = QA; }
        else if (colt < 2560) { base = KA; ldc = 512; colt -= 2048; }
        else if (colt < 3072) { base = VA; ldc = 512; colt -= 2560; }
        else if (colt < 5120) { base = QH; colt -= 3072; act = 1; }
        else if (colt < 7168) { base = ZF; colt -= 5120; }
        else if (colt < 9216) { base = ZB; colt -= 7168; }
        else if (colt < 11264) { base = IH; colt -= 9216; }
        else if (colt < 13312) { base = GH; colt -= 11264; act = 1; }
        else { base = GATE; ldc = 8192; colt -= 13312; act = 2; bias = bgate; }
        const int col0 = colt + wc * 32 + 8 * fq;
        f32x4 bv[2][2];
#pragma unroll
        for (int bj = 0; bj < 2; ++bj)
#pragma unroll
            for (int n = 0; n < 2; ++n) bv[bj][n] = bias ? *(const f32x4*)(bias + col0 + bj * HALF + 4 * n) : (f32x4){0.f, 0.f, 0.f, 0.f};
#pragma unroll
        for (int ai = 0; ai < 2; ++ai)
#pragma unroll
            for (int m = 0; m < 4; ++m) { bf16_t* rowp = base + (size_t)(row0 + ai * HALF + m * 16) * ldc + col0;
#pragma unroll
                for (int bj = 0; bj < 2; ++bj) { f32x4 v0 = acc[ai][bj][m][0] * ascale + bv[bj][0], v1 = acc[ai][bj][m][1] * ascale + bv[bj][1];
                    if (act != 0) {
#pragma unroll
                        for (int j = 0; j < 4; ++j) { const float s0 = sigmoid_f(v0[j]), s1 = sigmoid_f(v1[j]); v0[j] = (act == 1) ? v0[j] * s0 : s0; v1[j] = (act == 1) ? v1[j] * s1 : s1; } }
                    u32x4 w; w.x = cvt_pk_bf16(v0[0], v0[1]); w.y = cvt_pk_bf16(v0[2], v0[3]); w.z = cvt_pk_bf16(v1[0], v1[1]); w.w = cvt_pk_bf16(v1[2], v1[3]);
                    *(u32x4*)(rowp + bj * HALF) = w; } }
    }
};
struct EpiGateMulF32 {
    static constexpr bool PERM = false, AFTER_DRAIN = false; static constexpr int MID_K = -1;
    float* out; int ldc; const bf16_t* gate; int ldg; int goff;
    __device__ __forceinline__ void operator()(const f32x4 (&acc)[2][2][4][2], const Unit& u, int wr, int wc, int fr, int fq) const {
        const int row0 = u.pm * BM + wr * 64 + fr, col0 = u.pn * BM + wc * 32 + 4 * fq;
#pragma unroll
        for (int ai = 0; ai < 2; ++ai)
#pragma unroll
            for (int m = 0; m < 4; ++m) { const int row = row0 + ai * HALF + m * 16; float* rowp = out + (size_t)row * ldc + col0;
#pragma unroll
                for (int bj = 0; bj < 2; ++bj)
#pragma unroll
                    for (int n = 0; n < 2; ++n) { f32x4 v = acc[ai][bj][m][n];
                        if (gate) { const u32x2 gw = *(const u32x2*)(gate + (size_t)row * ldg + goff + col0 + bj * HALF + n * 16);
                            v = v * (f32x4){bf_lo(gw.x), bf_hi(gw.x), bf_lo(gw.y), bf_hi(gw.y)}; }
                        *(f32x4*)(rowp + bj * HALF + n * 16) = v; } }
    }
};
struct EpiGate {
    static constexpr bool PERM = true, AFTER_DRAIN = false; static constexpr int MID_K = -1;
    bf16_t* G; int ldg; const float* bgate; float ascale;
    __device__ __forceinline__ void operator()(const f32x4 (&acc)[2][2][4][2], const Unit& u, int, int, int, int) const {
        int t_ = (int)threadIdx.x; asm volatile("" : "+v"(t_));
        const int wid_ = t_ >> 6, wr = wid_ >> 2, wc = wid_ & 3, fr = t_ & 15, fq = (t_ >> 4) & 3;
        const int row0 = u.pm * BM + wr * 64 + fr, c0 = u.pn * HALF + wc * 32 + 8 * fq;
#pragma unroll
        for (int ai = 0; ai < 2; ++ai)
#pragma unroll
            for (int m = 0; m < 4; ++m) { bf16_t* rowp = G + (size_t)(row0 + ai * HALF + m * 16) * ldg + c0;
                const f32x4 ba0 = *(const f32x4*)(bgate + c0), ba1 = *(const f32x4*)(bgate + c0 + 4), bh0 = *(const f32x4*)(bgate + 4096 + c0), bh1 = *(const f32x4*)(bgate + 4096 + c0 + 4);
                const f32x4 a0 = acc[ai][0][m][0] * ascale + ba0, a1 = acc[ai][0][m][1] * ascale + ba1, h0 = acc[ai][1][m][0] * ascale + bh0, h1 = acc[ai][1][m][1] * ascale + bh1;
                f32x4 r0, r1, g0, g1;
#pragma unroll
                for (int j = 0; j < 4; ++j) { g0[j] = fmaxf(sigmoid_f(h0[j]), 1e-30f); g1[j] = fmaxf(sigmoid_f(h1[j]), 1e-30f);
                    r0[j] = sigmoid_f(a0[j]) * __builtin_amdgcn_rcpf(g0[j]); r1[j] = sigmoid_f(a1[j]) * __builtin_amdgcn_rcpf(g1[j]); }
                u32x4 w; w.x = cvt_pk_bf16(r0[0], r0[1]); w.y = cvt_pk_bf16(r0[2], r0[3]); w.z = cvt_pk_bf16(r1[0], r1[1]); w.w = cvt_pk_bf16(r1[2], r1[3]);
                *(u32x4*)rowp = w;
                w.x = cvt_pk_bf16(g0[0], g0[1]); w.y = cvt_pk_bf16(g0[2], g0[3]); w.z = cvt_pk_bf16(g1[0], g1[1]); w.w = cvt_pk_bf16(g1[2], g1[3]);
                *(u32x4*)(rowp + 4096) = w;
                asm volatile("" ::: "memory"); }
    }
};
struct EpiMix {
    static constexpr bool PERM = true, AFTER_DRAIN = false; static constexpr int MID_K = 16;
    unsigned char* O8; int ldc; const bf16_t* gate; int ldg; float oscale; float midscale;
    __device__ __forceinline__ void mid(f32x4 (&acc)[2][2][4][2], const Unit& u, int wr, int wc, int fr, int fq) const {
        int row0 = u.pm * BM + wr * 64 + fr, col0 = u.pn * BM + wc * 32 + 8 * fq;
        asm volatile("" : "+v"(row0), "+v"(col0));
#pragma unroll
        for (int ai = 0; ai < 2; ++ai) { u32x4 gl[4][2];
#pragma unroll
            for (int m = 0; m < 4; ++m) { const bf16_t* gp = gate + (size_t)(row0 + ai * HALF + m * 16) * ldg + col0;
#pragma unroll
                for (int bj = 0; bj < 2; ++bj) gl[m][bj] = *(const u32x4*)(gp + bj * HALF); }
            asm volatile("" ::: "memory");
#pragma unroll
            for (int m = 0; m < 4; ++m)
#pragma unroll
                for (int bj = 0; bj < 2; ++bj) { const unsigned gaw[4] = {gl[m][bj].x, gl[m][bj].y, gl[m][bj].z, gl[m][bj].w};
#pragma unroll
                    for (int q = 0; q < 4; ++q) { acc[ai][bj][m][q >> 1][(q & 1) * 2] *= bf_lo(gaw[q]) * midscale; acc[ai][bj][m][q >> 1][(q & 1) * 2 + 1] *= bf_hi(gaw[q]) * midscale; } }
            asm volatile("" ::: "memory"); }
    }
    __device__ __forceinline__ void operator()(const f32x4 (&acc)[2][2][4][2], const Unit& u, int wr, int wc, int fr, int fq) const {
        const int row0 = u.pm * BM + wr * 64 + fr, col0 = u.pn * BM + wc * 32 + 8 * fq;
        typedef unsigned u32x2_e __attribute__((ext_vector_type(2)));
#pragma unroll
        for (int ai = 0; ai < 2; ++ai) { u32x4 gl[4][2];
#pragma unroll
            for (int m = 0; m < 4; ++m)
#pragma unroll
                for (int bj = 0; bj < 2; ++bj) gl[m][bj] = *(const u32x4*)(gate + (size_t)(row0 + ai * HALF + m * 16) * ldg + ldc + col0 + bj * HALF);
            asm volatile("" ::: "memory");
#pragma unroll
            for (int m = 0; m < 4; ++m) { const int row = row0 + ai * HALF + m * 16;
#pragma unroll
                for (int bj = 0; bj < 2; ++bj) { const u32x4 gw = gl[m][bj];
                    const f32x4 v0 = acc[ai][bj][m][0] * (f32x4){fmaxf(bf_lo(gw.x), 1e-30f), fmaxf(bf_hi(gw.x), 1e-30f), fmaxf(bf_lo(gw.y), 1e-30f), fmaxf(bf_hi(gw.y), 1e-30f)};
                    const f32x4 v1 = acc[ai][bj][m][1] * (f32x4){fmaxf(bf_lo(gw.z), 1e-30f), fmaxf(bf_hi(gw.z), 1e-30f), fmaxf(bf_lo(gw.w), 1e-30f), fmaxf(bf_hi(gw.w), 1e-30f)};
                    unsigned lo8 = 0u, hi8 = 0u;
                    lo8 = (unsigned)__builtin_amdgcn_cvt_pk_fp8_f32(v0[0] * oscale, v0[1] * oscale, (int)lo8, false); lo8 = (unsigned)__builtin_amdgcn_cvt_pk_fp8_f32(v0[2] * oscale, v0[3] * oscale, (int)lo8, true);
                    hi8 = (unsigned)__builtin_amdgcn_cvt_pk_fp8_f32(v1[0] * oscale, v1[1] * oscale, (int)hi8, false); hi8 = (unsigned)__builtin_amdgcn_cvt_pk_fp8_f32(v1[2] * oscale, v1[3] * oscale, (int)hi8, true);
                    *(u32x2_e*)(O8 + (size_t)row * ldc + col0 + bj * HALF) = (u32x2_e){lo8, hi8}; } }
            asm volatile("" ::: "memory"); }
    }
};
struct EpiGateMulBf16 {
    static constexpr bool PERM = true, AFTER_DRAIN = false; static constexpr int MID_K = -1;
    bf16_t* O; int ldc; const bf16_t* gate; int ldg; int goff;
    __device__ __forceinline__ void operator()(const f32x4 (&acc)[2][2][4][2], const Unit& u, int wr, int wc, int fr, int fq) const {
        const int row0 = u.pm * BM + wr * 64 + fr, col0 = u.pn * BM + wc * 32 + 8 * fq;
#pragma unroll
        for (int ai = 0; ai < 2; ++ai)
#pragma unroll
            for (int m = 0; m < 4; ++m) { const int row = row0 + ai * HALF + m * 16;
#pragma unroll
                for (int bj = 0; bj < 2; ++bj) { const size_t off = (size_t)row * ldc + col0 + bj * HALF;
                    const u32x4 gw = *(const u32x4*)(gate + (size_t)row * ldg + goff + col0 + bj * HALF);
                    const f32x4 v0 = acc[ai][bj][m][0] * (f32x4){bf_lo(gw.x), bf_hi(gw.x), bf_lo(gw.y), bf_hi(gw.y)};
                    const f32x4 v1 = acc[ai][bj][m][1] * (f32x4){bf_lo(gw.z), bf_hi(gw.z), bf_lo(gw.w), bf_hi(gw.w)};
                    u32x4 w; w.x = cvt_pk_bf16(v0[0], v0[1]); w.y = cvt_pk_bf16(v0[2], v0[3]); w.z = cvt_pk_bf16(v1[0], v1[1]); w.w = cvt_pk_bf16(v1[2], v1[3]);
                    *(u32x4*)(O + off) = w; } }
    }
};
struct EpiGateAddBf16 {
    static constexpr bool PERM = true, AFTER_DRAIN = false; static constexpr int MID_K = -1;
    bf16_t* O; const bf16_t* T; int ldc; const bf16_t* gate; int ldg; int goff;
    __device__ __forceinline__ void operator()(const f32x4 (&acc)[2][2][4][2], const Unit& u, int wr, int wc, int fr, int fq) const {
        const int row0 = u.pm * BM + wr * 64 + fr, col0 = u.pn * BM + wc * 32 + 8 * fq;
#pragma unroll
        for (int ai = 0; ai < 2; ++ai)
#pragma unroll
            for (int m = 0; m < 4; ++m) { const int row = row0 + ai * HALF + m * 16;
#pragma unroll
                for (int bj = 0; bj < 2; ++bj) { const size_t off = (size_t)row * ldc + col0 + bj * HALF;
                    const u32x4 gw = *(const u32x4*)(gate + (size_t)row * ldg + goff + col0 + bj * HALF);
                    const u32x4 tw = *(const u32x4*)(T + off);
                    const f32x4 t0 = (f32x4){bf_lo(tw.x), bf_hi(tw.x), bf_lo(tw.y), bf_hi(tw.y)}, t1 = (f32x4){bf_lo(tw.z), bf_hi(tw.z), bf_lo(tw.w), bf_hi(tw.w)};
                    const f32x4 v0 = t0 + acc[ai][bj][m][0] * (f32x4){bf_lo(gw.x), bf_hi(gw.x), bf_lo(gw.y), bf_hi(gw.y)};
                    const f32x4 v1 = t1 + acc[ai][bj][m][1] * (f32x4){bf_lo(gw.z), bf_hi(gw.z), bf_lo(gw.w), bf_hi(gw.w)};
                    u32x4 w; w.x = cvt_pk_bf16(v0[0], v0[1]); w.y = cvt_pk_bf16(v0[2], v0[3]); w.z = cvt_pk_bf16(v1[0], v1[1]); w.w = cvt_pk_bf16(v1[2], v1[3]);
                    *(u32x4*)(O + off) = w; } }
    }
};
struct EpiAxpyF32 {
    static constexpr bool PERM = false, AFTER_DRAIN = false; static constexpr int MID_K = -1;
    const float* base; float* out; int ldc; float alpha;
    __device__ __forceinline__ void operator()(const f32x4 (&acc)[2][2][4][2], const Unit& u, int wr, int wc, int fr, int fq) const {
        const int row0 = u.pm * BM + wr * 64 + fr, col0 = u.pn * BM + wc * 32 + 4 * fq;
#pragma unroll
        for (int ai = 0; ai < 2; ++ai)
#pragma unroll
            for (int m = 0; m < 4; ++m) { const size_t off = (size_t)(row0 + ai * HALF + m * 16) * ldc + col0;
#pragma unroll
                for (int bj = 0; bj < 2; ++bj)
#pragma unroll
                    for (int n = 0; n < 2; ++n) { const f32x4 bs = *(const f32x4*)(base + off + bj * HALF + n * 16);
                        *(f32x4*)(out + off + bj * HALF + n * 16) = bs * alpha + acc[ai][bj][m][n]; }
                asm volatile("" ::: "memory"); }
    }
};
struct EpiFinal {
    static constexpr bool PERM = true, AFTER_DRAIN = false; static constexpr int MID_K = -1;
    const bf16_t* x2; float* out; const bf16_t* pe; int ldc;
    __device__ __forceinline__ void operator()(const f32x4 (&acc)[2][2][4][2], const Unit& u, int wr, int wc, int fr, int fq) const {
        const int row0 = u.pm * BM + wr * 64 + fr, col0 = u.pn * BM + wc * 32 + 8 * fq;
#pragma unroll
        for (int ai = 0; ai < 2; ++ai)
#pragma unroll
            for (int m = 0; m < 4; ++m) { const int row = row0 + ai * HALF + m * 16;
#pragma unroll
                for (int bj = 0; bj < 2; ++bj) { const size_t off = (size_t)row * ldc + col0 + bj * HALF;
                    const u32x4 xw = *(const u32x4*)(x2 + off), pw = *(const u32x4*)(pe + off);
                    const f32x4 a0 = acc[ai][bj][m][0], a1 = acc[ai][bj][m][1];
                    const f32x4 x0 = (f32x4){bf_lo(xw.x), bf_hi(xw.x), bf_lo(xw.y), bf_hi(xw.y)}, x1 = (f32x4){bf_lo(xw.z), bf_hi(xw.z), bf_lo(xw.w), bf_hi(xw.w)};
                    const f32x4 p0 = (f32x4){bf_lo(pw.x), bf_hi(pw.x), bf_lo(pw.y), bf_hi(pw.y)}, p1 = (f32x4){bf_lo(pw.z), bf_hi(pw.z), bf_lo(pw.w), bf_hi(pw.w)};
                    f32x4 o0, o1;
#pragma unroll
                    for (int j = 0; j < 4; ++j) { o0[j] = x0[j] + sigmoid_f(a0[j]) * p0[j]; o1[j] = x1[j] + sigmoid_f(a1[j]) * p1[j]; }
                    *(f32x4*)(out + off) = o0; *(f32x4*)(out + off + 4) = o1; }
                asm volatile("" ::: "memory"); }
    }
};

struct EpiResStats {
    static constexpr bool PERM = true, AFTER_DRAIN = false; static constexpr int MID_K = -1;
    bf16_t* Z; const bf16_t* R; int ldc; float alpha; float* S;
    __device__ __forceinline__ void operator()(const f32x4 (&acc)[2][2][4][2], const Unit& u, int wr, int wc, int fr, int fq) const {
        const int row0 = u.pm * BM + wr * 64 + fr, col0 = u.pn * BM + wc * 32 + 8 * fq;
        typedef float f32x2_e __attribute__((ext_vector_type(2)));
#pragma unroll
        for (int ai = 0; ai < 2; ++ai) { u32x4 rl[4][2];
#pragma unroll
            for (int m = 0; m < 4; ++m)
#pragma unroll
                for (int bj = 0; bj < 2; ++bj) rl[m][bj] = *(const u32x4*)(R + (size_t)(row0 + ai * HALF + m * 16) * ldc + col0 + bj * HALF);
            asm volatile("" ::: "memory");
#pragma unroll
            for (int m = 0; m < 4; ++m) { const int row = row0 + ai * HALF + m * 16; float s1 = 0.f, s2 = 0.f;
#pragma unroll
                for (int bj = 0; bj < 2; ++bj) { const size_t off = (size_t)row * ldc + col0 + bj * HALF;
                    const u32x4 rw = rl[m][bj];
                    const f32x4 r0 = (f32x4){bf_lo(rw.x), bf_hi(rw.x), bf_lo(rw.y), bf_hi(rw.y)}, r1 = (f32x4){bf_lo(rw.z), bf_hi(rw.z), bf_lo(rw.w), bf_hi(rw.w)};
                    const f32x4 z0 = r0 * alpha + acc[ai][bj][m][0], z1 = r1 * alpha + acc[ai][bj][m][1];
                    u32x4 w; w.x = cvt_pk_bf16(z0[0], z0[1]); w.y = cvt_pk_bf16(z0[2], z0[3]); w.z = cvt_pk_bf16(z1[0], z1[1]); w.w = cvt_pk_bf16(z1[2], z1[3]);
                    *(u32x4*)(Z + off) = w;
                    const unsigned ww[4] = {w.x, w.y, w.z, w.w};
#pragma unroll
                    for (int q = 0; q < 4; ++q) { const float a = bf_lo(ww[q]), b = bf_hi(ww[q]); s1 += a + b; s2 += a * a + b * b; } }
                s1 += __shfl_xor(s1, 16); s2 += __shfl_xor(s2, 16); s1 += __shfl_xor(s1, 32); s2 += __shfl_xor(s2, 32);
                if (fq == 0) *(f32x2_e*)(S + ((size_t)row * 64 + u.pn * 4 + wc) * 2) = (f32x2_e){s1, s2}; }
            asm volatile("" ::: "memory"); }
    }
};
struct EpiFinalLn {
    static constexpr bool PERM = true, AFTER_DRAIN = false; static constexpr int MID_K = -1;
    const bf16_t* z2; float* out; const bf16_t* pe; int ldc; const float* st; const float* gam; const float* bet; const float* c1; const float* c2;
    __device__ __forceinline__ void operator()(const f32x4 (&acc)[2][2][4][2], const Unit& u, int wr, int wc, int fr, int fq) const {
        const int row0 = u.pm * BM + wr * 64 + fr, col0 = u.pn * BM + wc * 32 + 8 * fq;
        typedef float f32x2_e __attribute__((ext_vector_type(2)));
#pragma unroll
        for (int bj = 0; bj < 2; ++bj) { const int col = col0 + bj * HALF;
            const f32x4 g0 = *(const f32x4*)(gam + col), g1 = *(const f32x4*)(gam + col + 4), b0 = *(const f32x4*)(bet + col), b1 = *(const f32x4*)(bet + col + 4);
            const f32x4 k0 = *(const f32x4*)(c1 + col), k1 = *(const f32x4*)(c1 + col + 4), d0 = *(const f32x4*)(c2 + col), d1 = *(const f32x4*)(c2 + col + 4);
#pragma unroll
            for (int ai = 0; ai < 2; ++ai) { u32x4 zl[4], pl[4]; f32x2_e sl[4];
#pragma unroll
                for (int m = 0; m < 4; ++m) { const int row = row0 + ai * HALF + m * 16; const size_t off = (size_t)row * ldc + col;
                    zl[m] = *(const u32x4*)(z2 + off); pl[m] = *(const u32x4*)(pe + off); sl[m] = *(const f32x2_e*)(st + (size_t)row * 2); }
                asm volatile("" ::: "memory");
#pragma unroll
                for (int m = 0; m < 4; ++m) { const int row = row0 + ai * HALF + m * 16; const size_t off = (size_t)row * ldc + col;
                    const float mean = sl[m].x, rstd = sl[m].y; const u32x4 zw = zl[m], pw = pl[m];
                    const f32x4 a0 = acc[ai][bj][m][0], a1 = acc[ai][bj][m][1];
                    const f32x4 z0 = (f32x4){bf_lo(zw.x), bf_hi(zw.x), bf_lo(zw.y), bf_hi(zw.y)}, z1 = (f32x4){bf_lo(zw.z), bf_hi(zw.z), bf_lo(zw.w), bf_hi(zw.w)};
                    const f32x4 p0 = (f32x4){bf_lo(pw.x), bf_hi(pw.x), bf_lo(pw.y), bf_hi(pw.y)}, p1 = (f32x4){bf_lo(pw.z), bf_hi(pw.z), bf_lo(pw.w), bf_hi(pw.w)};
                    f32x4 o0, o1;
#pragma unroll
                    for (int j = 0; j < 4; ++j) {
                        const float x0 = (z0[j] - mean) * rstd * g0[j] + b0[j], x1 = (z1[j] - mean) * rstd * g1[j] + b1[j];
                        const float q0 = rstd * (a0[j] - mean * k0[j]) + d0[j], q1 = rstd * (a1[j] - mean * k1[j]) + d1[j];
                        o0[j] = x0 + sigmoid_f(q0) * p0[j]; o1[j] = x1 + sigmoid_f(q1) * p1[j]; }
                    *(f32x4*)(out + off) = o0; *(f32x4*)(out + off + 4) = o1; }
                asm volatile("" ::: "memory"); } }
    }
};

struct EpiNull {
    static constexpr bool PERM = true, AFTER_DRAIN = false; static constexpr int MID_K = -1;
    bf16_t* O; int never;
    __device__ __forceinline__ void operator()(const f32x4 (&acc)[2][2][4][2], const Unit& u, int wr, int wc, int fr, int fq) const {
        f32x4 s = (f32x4){0.f, 0.f, 0.f, 0.f};
#pragma unroll
        for (int ai = 0; ai < 2; ++ai)
#pragma unroll
            for (int m = 0; m < 4; ++m)
#pragma unroll
                for (int bj = 0; bj < 2; ++bj) s += acc[ai][bj][m][0] + acc[ai][bj][m][1];
        if (u.pm < never) *(f32x4*)(O + (size_t)(threadIdx.x) * 8) = s;
    }
};
typedef int pg8_v8i __attribute__((ext_vector_type(8)));
template <class Epi, class Sched, bool ALIGN_EPI = false, bool SP2 = false, bool F8T = false, int DBG = 0, bool TWO = false>
__device__ __forceinline__ void gemm_phase(PG8_LAS unsigned char* lds, const Gemm g, const Sched& S, const Epi& E) {
    const int tid = threadIdx.x, wid = __builtin_amdgcn_readfirstlane(tid >> 6), lane = tid & 63, wr = wid >> 2, wc = wid & 3, fr = lane & 15, fq = lane >> 4;
    constexpr bool F8 = F8T;
    const int K = g.K, nt = TWO ? 48 : K / BK;
    unsigned voffA[2], voffB[2];
#pragma unroll
    for (int i = 0; i < 2; ++i) { int R, C; stage_rc(tid * 16 + i * 8192, R, C); const int Rb = Epi::PERM ? ((R & ~31) + perm32(R & 31)) : R;
        voffA[i] = (unsigned)(R * K + C) * 2u; voffB[i] = (unsigned)(Rb * K + C) * 2u; }
    const size_t kstep = (size_t)(BK * 2);
    const size_t hstep = (size_t)HALF * K * 2;
    const size_t tstep = 2 * hstep;
    const unsigned ldsw = (unsigned)wid * 1024u;
    const int aoffH = lds_byte(wr * 64 + fr, fq * 8), boffH = lds_byte(wc * 32 + fr, fq * 8), aoffQ = lds_byte(wr * 64 + fr, fq * 16), boffQ = lds_byte(wc * 32 + fr, fq * 16);
#define aoff (F8 ? aoffQ : aoffH)
#define boff (F8 ? boffQ : boffH)
#define PG8_TT(x) (TWO ? ((x) < 16 ? (x) : (x) + 16) : (x))
#define PG8_SA(b, h) (((b) * 2 + (h)) * HTB)
#define PG8_SB(b, h) ((4 + (b) * 2 + (h)) * HTB)
#ifdef PG8_SADDR
#define PG8_STAGE(bufoff, gbase, voff) do { if constexpr ((DBG & 1) || (DBG & 2)) break; _Pragma("unroll") for (int _i = 0; _i < 2; ++_i) { \
        const unsigned la_ = (unsigned)(size_t)(lds + (bufoff) + ldsw + _i * 8192); const char* gb_ = (const char*)(gbase); \
        asm volatile("s_mov_b32 m0, %0\n\ts_nop 0\n\tglobal_load_lds_dwordx4 %1, %2" :: "s"(la_), "v"((voff)[_i]), "s"(gb_) : "memory", "m0"); } } while (0)
#else
#define PG8_STAGE(bufoff, gbase, voff) do { if constexpr ((DBG & 1) || (DBG & 2)) break; _Pragma("unroll") for (int _i = 0; _i < 2; ++_i) \
        __builtin_amdgcn_global_load_lds((const unsigned*)((const char*)(gbase) + (voff)[_i]), (PG8_LAS unsigned*)(lds + (bufoff) + ldsw + _i * 8192), 16, 0, 0); } while (0)
#endif
#define PG8_LD32(off) __builtin_shufflevector(*(const PG8_LAS f32x4*)(lds + (off)), *(const PG8_LAS f32x4*)(lds + (off) + 16), 0, 1, 2, 3, 4, 5, 6, 7)
#define PG8_LDA(dst, b, h) do { if constexpr ((DBG & 1) || (DBG & 4)) { asm volatile("" : "+v"(dst[0][0])); break; } if constexpr (F8) { _Pragma("unroll") for (int m = 0; m < 4; ++m) dst##8[m] = __builtin_bit_cast(pg8_v8i, PG8_LD32(PG8_SA(b, h) + aoff + m * 2048)); } \
        else { _Pragma("unroll") for (int m = 0; m < 4; ++m) _Pragma("unroll") for (int k = 0; k < 2; ++k) dst[m][k] = *(const PG8_LAS bf16x8*)(lds + PG8_SA(b, h) + aoff + m * 2048 + k * 1024); } } while (0)
#define PG8_LDB(dst, b, h) do { if constexpr ((DBG & 1) || (DBG & 4)) { asm volatile("" : "+v"(dst[0][0])); break; } if constexpr (F8) { _Pragma("unroll") for (int n = 0; n < 2; ++n) dst##8[n] = __builtin_bit_cast(pg8_v8i, PG8_LD32(PG8_SB(b, h) + boff + n * 2048)); } \
        else { _Pragma("unroll") for (int n = 0; n < 2; ++n) _Pragma("unroll") for (int k = 0; k < 2; ++k) dst[n][k] = *(const PG8_LAS bf16x8*)(lds + PG8_SB(b, h) + boff + n * 2048 + k * 1024); } } while (0)
#define PG8_MMA(ai, bj, At, Bt) do { __builtin_amdgcn_s_setprio(1); \
        if constexpr (F8) { _Pragma("unroll") for (int m = 0; m < 4; ++m) _Pragma("unroll") for (int n = 0; n < 2; ++n) \
            asm volatile("v_mfma_scale_f32_16x16x128_f8f6f4 %0, %1, %2, %0, %3, %3 op_sel_hi:[0,0,0]" : "+v"(acc[ai][bj][m][n]) : "v"(Bt##8[n]), "v"(At##8[m]), "v"(f8scale)); } \
        else { _Pragma("unroll") for (int m = 0; m < 4; ++m) _Pragma("unroll") for (int n = 0; n < 2; ++n) _Pragma("unroll") for (int k = 0; k < 2; ++k) \
            acc[ai][bj][m][n] = __builtin_amdgcn_mfma_f32_16x16x32_bf16(Bt[n][k], At[m][k], acc[ai][bj][m][n], 0, 0, 0); } \
        __builtin_amdgcn_s_setprio(0); } while (0)
#define PG8_WAIT_V(n) asm volatile("s_waitcnt vmcnt(" #n ")" ::: "memory")
#define PG8_WAIT_L(n) asm volatile("s_waitcnt lgkmcnt(" #n ")" ::: "memory")
#define PG8_BAR __builtin_amdgcn_s_barrier()
#define PG8_SCHED __builtin_amdgcn_sched_barrier(0)
#define PG8_SP2BODY PG8_LDB(B0, 0, 0); PG8_LDB(B1, 0, 1); PG8_SCHED; PG8_LDA(At, 0, 0); PG8_STAGE(PG8_SA(1, 1), a1 + hstep, voffA); \
        PG8_WAIT_V(8); PG8_WAIT_L(0); PG8_BAR; PG8_MMA(0, 0, At, B0); PG8_MMA(0, 1, At, B1); PG8_BAR; PG8_SCHED; \
        PG8_LDA(At, 0, 1); PG8_STAGE(PG8_SB(0, 0), b2, voffB); PG8_STAGE(PG8_SB(0, 1), b2 + hstep, voffB); PG8_STAGE(PG8_SA(0, 0), a2, voffA); \
        PG8_WAIT_V(8); PG8_WAIT_L(0); PG8_BAR; PG8_MMA(1, 0, At, B0); PG8_MMA(1, 1, At, B1); PG8_BAR; PG8_SCHED; \
        PG8_LDB(B0, 1, 0); PG8_LDB(B1, 1, 1); PG8_SCHED; PG8_LDA(At, 1, 0); PG8_STAGE(PG8_SA(0, 1), a2 + hstep, voffA); \
        PG8_WAIT_V(8); PG8_WAIT_L(0); PG8_BAR; PG8_MMA(0, 0, At, B0); PG8_MMA(0, 1, At, B1); PG8_BAR; PG8_SCHED; \
        PG8_LDA(At, 1, 1); PG8_STAGE(PG8_SB(1, 0), b3, voffB); PG8_STAGE(PG8_SB(1, 1), b3 + hstep, voffB); PG8_STAGE(PG8_SA(1, 0), a3, voffA); \
        PG8_WAIT_V(8); PG8_WAIT_L(0); PG8_BAR; PG8_MMA(1, 0, At, B0); PG8_MMA(1, 1, At, B1); PG8_BAR; PG8_SCHED;
#define PG8_ITER_HEAD const bool last = (t == nt - 2); \
        const char* a1 = cA + (size_t)PG8_TT(t + 1) * kstep; \
        const char* a2 = last ? nA : cA + (size_t)PG8_TT(t + 2) * kstep; const char* b2 = last ? nB : cB + (size_t)PG8_TT(t + 2) * kstep; \
        const char* a3 = a2 + kstep; const char* b3 = b2 + kstep; \
        if (last && has_next) S.a_ready(nxt);
    Unit cur, nxt; int ui = 0;
    if (!S.next(0, cur)) return;
    f32x4 acc[2][2][4][2];
#pragma unroll
    for (int a = 0; a < 2; ++a)
#pragma unroll
        for (int b = 0; b < 2; ++b)
#pragma unroll
            for (int m = 0; m < 4; ++m)
#pragma unroll
                for (int n = 0; n < 2; ++n) acc[a][b][m][n] = (f32x4){0.f, 0.f, 0.f, 0.f};
    bf16x8 At[4][2], B0[2][2], B1[2][2]; pg8_v8i At8[4], B08[2], B18[2];
    if constexpr ((DBG & 1) || (DBG & 4)) {
#pragma unroll
        for (int m = 0; m < 4; ++m)
#pragma unroll
            for (int k = 0; k < 2; ++k) asm volatile("v_mov_b32 %0, 0" : "=v"(At[m][k][0]));
#pragma unroll
        for (int n = 0; n < 2; ++n)
#pragma unroll
            for (int k = 0; k < 2; ++k) { asm volatile("" : "=v"(B0[n][k])); asm volatile("" : "=v"(B1[n][k])); }
#pragma unroll
        for (int m = 0; m < 4; ++m)
#pragma unroll
            for (int k = 0; k < 2; ++k) asm volatile("" : "+v"(At[m][k]));
    }
    int f8scale = 0x7F7F7F7F; asm volatile("" : "+v"(f8scale));
    const char* cA = (const char*)g.A + (size_t)cur.pm * tstep; const char* cB = (const char*)g.Bt + (size_t)cur.pn * tstep;
    S.a_ready(cur);
    if constexpr (SP2) {
        PG8_STAGE(PG8_SB(0, 0), cB, voffB); PG8_STAGE(PG8_SB(0, 1), cB + hstep, voffB); PG8_STAGE(PG8_SA(0, 0), cA, voffA); PG8_STAGE(PG8_SA(0, 1), cA + hstep, voffA);
        if (wr == 1) PG8_BAR;
        PG8_WAIT_V(2); PG8_BAR;
        PG8_STAGE(PG8_SB(1, 0), cB + kstep, voffB); PG8_STAGE(PG8_SA(1, 0), cA + kstep, voffA); PG8_STAGE(PG8_SB(1, 1), cB + hstep + kstep, voffB);
        PG8_WAIT_V(6); PG8_BAR;
    } else {
        PG8_STAGE(PG8_SB(0, 0), cB, voffB); PG8_STAGE(PG8_SA(0, 0), cA, voffA); PG8_STAGE(PG8_SB(0, 1), cB + hstep, voffB); PG8_STAGE(PG8_SA(0, 1), cA + hstep, voffA);
        if (wr == 1) PG8_BAR;
        PG8_WAIT_V(4); PG8_BAR;
        PG8_STAGE(PG8_SB(1, 0), cB + kstep, voffB); PG8_STAGE(PG8_SA(1, 0), cA + kstep, voffA); PG8_STAGE(PG8_SB(1, 1), cB + hstep + kstep, voffB);
        PG8_WAIT_V(6); PG8_BAR;
    }
    for (;;) {
        const bool has_next = S.next(ui + 1, nxt);
        const char* nA = has_next ? (const char*)g.A + (size_t)nxt.pm * tstep : cA; const char* nB = has_next ? (const char*)g.Bt + (size_t)nxt.pn * tstep : cB;
        if constexpr (TWO) {
            for (int t = 0; t < 16; t += 2) { PG8_ITER_HEAD { constexpr bool F8 = true; PG8_SP2BODY } }
            asm volatile("s_nop 15\n\ts_nop 7" ::: "memory");
            E.mid(acc, cur, wr, wc, fr, fq);
            for (int t = 16; t < nt; t += 2) { PG8_ITER_HEAD { constexpr bool F8 = false; PG8_SP2BODY } }
        } else
        for (int t = 0; t < nt; t += 2) {
            const bool last = (t == nt - 2);
            const char* a1 = cA + (size_t)PG8_TT(t + 1) * kstep;
            const char* a2 = last ? nA : cA + (size_t)PG8_TT(t + 2) * kstep; const char* b2 = last ? nB : cB + (size_t)PG8_TT(t + 2) * kstep;
            const char* a3 = a2 + kstep; const char* b3 = b2 + kstep;
            if (last && has_next) S.a_ready(nxt);
            if constexpr (Epi::MID_K >= 0) { if (t == Epi::MID_K) { if constexpr (TWO || F8T) asm volatile("s_nop 15\n\ts_nop 7" ::: "memory"); E.mid(acc, cur, wr, wc, fr, fq); } }
            if constexpr (SP2) {
            PG8_SP2BODY
            } else {
            PG8_LDB(B0, 0, 0); PG8_SCHED; PG8_LDA(At, 0, 0); PG8_STAGE(PG8_SA(1, 1), a1 + hstep, voffA);
            PG8_WAIT_L(8); PG8_BAR; PG8_WAIT_L(0); PG8_MMA(0, 0, At, B0); PG8_BAR; PG8_SCHED;
            PG8_LDB(B1, 0, 1); PG8_STAGE(PG8_SB(0, 0), b2, voffB);
            PG8_BAR; PG8_WAIT_L(0); PG8_MMA(0, 1, At, B1); PG8_BAR;
            PG8_LDA(At, 0, 1); PG8_STAGE(PG8_SA(0, 0), a2, voffA);
            PG8_BAR; PG8_WAIT_L(0); PG8_MMA(1, 0, At, B0); PG8_BAR; PG8_SCHED;
            PG8_STAGE(PG8_SB(0, 1), b2 + hstep, voffB);
            PG8_WAIT_V(6); PG8_BAR; PG8_MMA(1, 1, At, B1); PG8_BAR;
            PG8_LDB(B0, 1, 0); PG8_SCHED; PG8_LDA(At, 1, 0); PG8_STAGE(PG8_SA(0, 1), a2 + hstep, voffA);
            PG8_WAIT_L(8); PG8_BAR; PG8_WAIT_L(0); PG8_MMA(0, 0, At, B0); PG8_BAR; PG8_SCHED;
            PG8_LDB(B1, 1, 1); PG8_STAGE(PG8_SB(1, 0), b3, voffB);
            PG8_BAR; PG8_WAIT_L(0); PG8_MMA(0, 1, At, B1); PG8_BAR;
            PG8_LDA(At, 1, 1); PG8_STAGE(PG8_SA(1, 0), a3, voffA);
            PG8_BAR; PG8_WAIT_L(0); PG8_MMA(1, 0, At, B0); PG8_BAR; PG8_SCHED;
            PG8_STAGE(PG8_SB(1, 1), b3 + hstep, voffB);
            PG8_WAIT_V(6); PG8_BAR; PG8_MMA(1, 1, At, B1); PG8_BAR;
            }
        }
        if constexpr (ALIGN_EPI) { if (wr == 0) PG8_BAR; }
        if constexpr (F8T) asm volatile("s_nop 15\n\ts_nop 7" ::: "memory");
        if constexpr (!Epi::AFTER_DRAIN) { E(acc, cur, wr, wc, fr, fq); S.done(cur); }
        if (!has_next) break;
#pragma unroll
        for (int a = 0; a < 2; ++a)
#pragma unroll
            for (int b = 0; b < 2; ++b)
#pragma unroll
                for (int m = 0; m < 4; ++m)
#pragma unroll
                    for (int n = 0; n < 2; ++n) acc[a][b][m][n] = (f32x4){0.f, 0.f, 0.f, 0.f};
        cur = nxt; cA = nA; cB = nB; ++ui;
        if constexpr (ALIGN_EPI) { if (wr == 1) PG8_BAR; }
    }
    PG8_WAIT_V(0);
    if constexpr (!ALIGN_EPI) { if (wr == 0) PG8_BAR; }
    PG8_BAR;
    if constexpr (Epi::AFTER_DRAIN) { E.fused(acc, cur, wr, wc, fr, fq, lds, wid, lane); S.done(cur); }
#undef PG8_SA
#undef PG8_TT
#undef PG8_SP2BODY
#undef PG8_ITER_HEAD
#undef aoff
#undef boff
#undef PG8_SB
#undef PG8_STAGE
#undef PG8_LDA
#undef PG8_LDB
#undef PG8_MMA
#undef PG8_LD32
#undef PG8_WAIT_V
#undef PG8_WAIT_L
#undef PG8_BAR
#undef PG8_SCHED
}
}
namespace attn {
typedef unsigned short bf16;
using bf16x8 = __attribute__((ext_vector_type(8))) short;
using s16x4  = __attribute__((ext_vector_type(4))) short;
using f32x16 = __attribute__((ext_vector_type(16))) float;
using u32x4  = __attribute__((ext_vector_type(4))) unsigned;
constexpr int   D = 128, NW = 8, QBLK = 32, KVBLK = 64;
constexpr float SCALE = 0.088388347648318440f;
constexpr float THR = 8.f;
constexpr int LDQ = 2048, LDK = 512, LDO = 4096;
constexpr size_t SHM_V = KVBLK * D * 2, SHM_K = KVBLK * D * 2, SHM_ATTN = 2 * SHM_V + 2 * SHM_K + NW * 64 * 4;
#define KSWZ(row, colB) ((row) * 256 + ((colB) ^ (((row) & 15) << 4)))
#define SBAR() __builtin_amdgcn_sched_barrier(0)
__device__ __forceinline__ int crow(int r, int hi) { return (r & 3) + 8 * (r >> 2) + 4 * hi; }
typedef float f32x2_a __attribute__((ext_vector_type(2))); typedef __bf16 bf16x2_a __attribute__((ext_vector_type(2)));
__device__ __forceinline__ unsigned cvtpk(float lo, float hi) { f32x2_a v = {lo, hi}; bf16x2_a b = __builtin_convertvector(v, bf16x2_a); return __builtin_bit_cast(unsigned, b); }
__device__ __forceinline__ void partialSM(f32x16& p0, f32x16& p1, float& m_reg, float& mn, float& alpha) {
  constexpr float C = SCALE * 1.4426950408889634f;
  mn = m_reg; alpha = 1.f;
  float mnC = m_reg;
  for (int r = 0; r < 16; ++r) p0[r] = fmaf(p0[r], C, mnC); for (int r = 0; r < 16; ++r) p1[r] = fmaf(p1[r], C, mnC);
  for (int r = 0; r < 16; ++r) p0[r] = __builtin_amdgcn_exp2f(p0[r]);
}
__device__ __forceinline__ void finishSM(f32x16& p0, f32x16& p1, float alpha, float& l_reg, bf16x8& pa0, bf16x8& pa1, bf16x8& pa2, bf16x8& pa3) {
  for (int r = 0; r < 16; ++r) p1[r] = __builtin_amdgcn_exp2f(p1[r]);
  float ps = 0; for (int r = 0; r < 16; ++r) ps += p0[r]; for (int r = 0; r < 16; ++r) ps += p1[r];
  { auto rr = __builtin_amdgcn_permlane32_swap(__float_as_uint(ps), __float_as_uint(ps), false, false);
    ps = __uint_as_float(rr[0]) + __uint_as_float(rr[1]); }
  l_reg = l_reg * alpha + ps;
#define PK4(P, BASE, OUT) do { unsigned a0 = cvtpk(P[BASE + 0], P[BASE + 1]), a1 = cvtpk(P[BASE + 2], P[BASE + 3]);   \
    unsigned b0 = cvtpk(P[BASE + 4], P[BASE + 5]), b1 = cvtpk(P[BASE + 6], P[BASE + 7]);                              \
    auto r0 = __builtin_amdgcn_permlane32_swap(a0, b0, false, false); auto r1 = __builtin_amdgcn_permlane32_swap(a1, b1, false, false); \
    u32x4 w = {r0[0], r1[0], r0[1], r1[1]}; OUT = *reinterpret_cast<bf16x8*>(&w); } while (0)
  PK4(p0, 0, pa0); PK4(p0, 8, pa1); PK4(p1, 0, pa2); PK4(p1, 8, pa3);
#undef PK4
}
__device__ __forceinline__ void qkt(f32x16& p0, f32x16& p1, const bf16* Ks, const bf16x8* qr, int r32, int hi) {
  p0 = f32x16{}; p1 = f32x16{};
  for (int d0 = 0; d0 < 8; ++d0) { int cb = (d0 * 16 + hi * 8) * 2;
    bf16x8 b0 = *reinterpret_cast<const bf16x8*>((const char*)Ks + KSWZ(r32, cb));
    bf16x8 b1 = *reinterpret_cast<const bf16x8*>((const char*)Ks + KSWZ(32 + r32, cb));
    p0 = __builtin_amdgcn_mfma_f32_32x32x16_bf16(b0, qr[d0], p0, 0, 0, 0);
    p1 = __builtin_amdgcn_mfma_f32_32x32x16_bf16(b1, qr[d0], p1, 0, 0, 0); }
}
__device__ __forceinline__ int v_st(int k, int c) { const int kk = (k & ~0xC) | ((k & 4) << 1) | ((k & 8) >> 1); return ((kk >> 3) * 4 + (c >> 5)) * 512 + ((kk & 7) * 32 + (c & 31)) * 2; }
__device__ __forceinline__ int v_rd_base(int lane) { return ((lane & 3) << 3) | (((lane >> 2) & 3) << 6) | (((lane >> 4) & 1) << 5) | (((lane >> 5) & 1) << 8); }
constexpr int v_rd_off(int d0, int ks, int half) { return d0 * 512 + ks * 4096 + half * 2048; }
template <int OFF> __device__ __forceinline__ s16x4 tr_read(int vb) {
  s16x4 r; asm volatile("ds_read_b64_tr_b16 %0, %1 offset:%2" : "=&v"(r) : "v"(vb), "i"(OFF) : "memory"); return r;
}
template <int D0> __device__ __forceinline__ void pv_one(f32x16& od, int vb, bf16x8 pa0, bf16x8 pa1, bf16x8 pa2, bf16x8 pa3) {
  const s16x4 l0 = tr_read<v_rd_off(D0, 0, 0)>(vb), h0 = tr_read<v_rd_off(D0, 0, 1)>(vb), l1 = tr_read<v_rd_off(D0, 1, 0)>(vb), h1 = tr_read<v_rd_off(D0, 1, 1)>(vb);
  const s16x4 l2 = tr_read<v_rd_off(D0, 2, 0)>(vb), h2 = tr_read<v_rd_off(D0, 2, 1)>(vb), l3 = tr_read<v_rd_off(D0, 3, 0)>(vb), h3 = tr_read<v_rd_off(D0, 3, 1)>(vb);
  asm volatile("s_waitcnt lgkmcnt(0)" ::: "memory"); SBAR();
#define PK(L, H) (bf16x8){L[0], L[1], L[2], L[3], H[0], H[1], H[2], H[3]}
  od = __builtin_amdgcn_mfma_f32_32x32x16_bf16(pa0, PK(l0, h0), od, 0, 0, 0);
  od = __builtin_amdgcn_mfma_f32_32x32x16_bf16(pa1, PK(l1, h1), od, 0, 0, 0);
  od = __builtin_amdgcn_mfma_f32_32x32x16_bf16(pa2, PK(l2, h2), od, 0, 0, 0);
  od = __builtin_amdgcn_mfma_f32_32x32x16_bf16(pa3, PK(l3, h3), od, 0, 0, 0);
#undef PK
}
__device__ __forceinline__ void pv_d0(f32x16* o, int vb, bf16x8 pa0, bf16x8 pa1, bf16x8 pa2, bf16x8 pa3) {
  pv_one<0>(o[0], vb, pa0, pa1, pa2, pa3); pv_one<1>(o[1], vb, pa0, pa1, pa2, pa3); pv_one<2>(o[2], vb, pa0, pa1, pa2, pa3); pv_one<3>(o[3], vb, pa0, pa1, pa2, pa3);
}
__device__ __forceinline__ void attn_dense_body(const bf16* Qb, const bf16* __restrict__ Kh, const bf16* __restrict__ Vh, bf16* Ob, int seq, char* lds, float negM) {
  const int tid = threadIdx.x, wid = tid >> 6, lane = tid & 63, r32 = lane & 31, hi = lane >> 5;
  bf16* V_lds = (bf16*)lds; bf16* K_lds = (bf16*)(lds + 2 * SHM_V);
  float* ws = (float*)(lds + 2 * SHM_V + 2 * SHM_K) + wid * 64; float* li_l = ws; float* al_l = ws + 32;
  float m_reg = negM  , l_reg = 0; f32x16 o[4] = {}; bf16x8 qr[8];
  const bf16* Qw = Qb + (long)(wid * QBLK + r32) * LDQ + hi * 8;
#pragma unroll
  for (int d0 = 0; d0 < 8; ++d0) qr[d0] = *reinterpret_cast<const bf16x8*>(Qw + d0 * 16);
  const int sr = tid >> 4, sc = (tid & 15) * 8, vst0 = v_st(sr, sc), vst1 = v_st(32 + sr, sc);
  const int vb0 = (int)(uintptr_t)V_lds + v_rd_base(lane);
  struct { bf16x8 vs0, vs1, ks0, ks1; } sr_[2];
#define SLOAD(i, k0) do { sr_[i].vs0 = *reinterpret_cast<const bf16x8*>(&Vh[(long)((k0) + sr) * LDK + sc]); sr_[i].vs1 = *reinterpret_cast<const bf16x8*>(&Vh[(long)((k0) + 32 + sr) * LDK + sc]); \
    sr_[i].ks0 = *reinterpret_cast<const bf16x8*>(&Kh[(long)((k0) + sr) * LDK + sc]); sr_[i].ks1 = *reinterpret_cast<const bf16x8*>(&Kh[(long)((k0) + 32 + sr) * LDK + sc]); } while (0)
#define SWRITE(b, i) do { *(bf16x8*)((char*)V_lds + (b) * SHM_V + vst0) = sr_[i].vs0;          \
    *(bf16x8*)((char*)V_lds + (b) * SHM_V + vst1) = sr_[i].vs1; int kc = sc * 2;               \
    *(bf16x8*)((char*)K_lds + (b) * SHM_K + KSWZ(sr, kc)) = sr_[i].ks0;                       \
    *(bf16x8*)((char*)K_lds + (b) * SHM_K + KSWZ(32 + sr, kc)) = sr_[i].ks1; } while (0)
#define SWAIT() asm volatile("s_waitcnt vmcnt(4)" ::: "memory")
#define RESC(a) do { if (__any((a) < 1.f)) { if (hi == 0) al_l[r32] = (a); asm volatile("s_waitcnt lgkmcnt(0)" ::: "memory"); \
    for (int d = 0; d < 4; ++d) for (int r = 0; r < 16; ++r) o[d][r] *= al_l[crow(r, hi)]; } } while (0)
  f32x16 pA0, pA1, pB0, pB1; float mnA, mnB, alA, alB; bf16x8 pa0, pa1, pa2, pa3; const int NT = seq / KVBLK;
  constexpr int SE = 0, SO = 1;
  SLOAD(SE, 0); asm volatile("s_waitcnt vmcnt(0)" ::: "memory"); SWRITE(0, SE); __syncthreads();
  qkt(pA0, pA1, K_lds, qr, r32, hi); partialSM(pA0, pA1, m_reg, mnA, alA);
  SLOAD(SO, KVBLK); if (2 < NT) SLOAD(SE, 2 * KVBLK);
  SWAIT(); SWRITE(1, SO); __syncthreads();
  for (int j = 1; j + 1 < NT; j += 2) {
    SBAR(); qkt(pB0, pB1, (bf16*)((char*)K_lds + SHM_K), qr, r32, hi);
    finishSM(pA0, pA1, alA, l_reg, pa0, pa1, pa2, pa3); SBAR();
    SLOAD(SO, (j + 2) * KVBLK); SBAR();
    pv_d0(o, vb0, pa0, pa1, pa2, pa3); partialSM(pB0, pB1, m_reg, mnB, alB);
    __syncthreads(); SWAIT(); SWRITE(0, SE);
    RESC(alB); __syncthreads();
    SBAR(); qkt(pA0, pA1, K_lds, qr, r32, hi);
    finishSM(pB0, pB1, alB, l_reg, pa0, pa1, pa2, pa3); SBAR();
    if (j + 3 < NT) SLOAD(SE, (j + 3) * KVBLK); SBAR();
    pv_d0(o, vb0 + (int)SHM_V, pa0, pa1, pa2, pa3); partialSM(pA0, pA1, m_reg, mnA, alA);
    __syncthreads(); SWAIT(); SWRITE(1, SO);
    RESC(alA); __syncthreads();
  }
  SBAR(); qkt(pB0, pB1, (bf16*)((char*)K_lds + SHM_K), qr, r32, hi);
  finishSM(pA0, pA1, alA, l_reg, pa0, pa1, pa2, pa3); SBAR();
  pv_d0(o, vb0, pa0, pa1, pa2, pa3); partialSM(pB0, pB1, m_reg, mnB, alB);
  __syncthreads(); RESC(alB);
  finishSM(pB0, pB1, alB, l_reg, pa0, pa1, pa2, pa3); SBAR();
  pv_d0(o, vb0 + (int)SHM_V, pa0, pa1, pa2, pa3);
  if (hi == 0) li_l[r32] = l_reg; asm volatile("s_waitcnt lgkmcnt(0)" ::: "memory");
  float rli[16];
#pragma unroll
  for (int r = 0; r < 16; ++r) rli[r] = __builtin_amdgcn_rcpf(li_l[crow(r, hi)]);
  bf16* Ow = Ob + (long)(wid * QBLK) * LDO;
#pragma unroll
  for (int r = 0; r < 16; ++r) { int orow = crow(r, hi);
    for (int d0 = 0; d0 < 4; ++d0) { const float v = o[d0][r] * rli[r]; Ow[(long)orow * LDO + d0 * 32 + r32] = (bf16)(cvtpk(v, v) & 0xffffu); } }
  __syncthreads();
#undef SLOAD
#undef SWRITE
#undef SWAIT
#undef RESC
}
typedef int v8i_t __attribute__((ext_vector_type(8)));
constexpr size_t SHM_K8 = KVBLK * D;
#define K8SW(row, slot) ((row) * 128 + ((((slot) ^ (((row) >> 1) & 7))) << 4))
__device__ __forceinline__ void qkt8(f32x16& p0, f32x16& p1, const char* Ks, const v8i_t* qf, int r32, int hi) {
  int sc = 0x7F7F7F7F; asm volatile("" : "+v"(sc));
  const int sl = 2 * hi;
#define KF8(ROW, SL) ({ const u32x4 l_ = *reinterpret_cast<const u32x4*>(Ks + K8SW(ROW, SL)), h_ = *reinterpret_cast<const u32x4*>(Ks + K8SW(ROW, (SL) + 1)); \
    (v8i_t){(int)l_.x, (int)l_.y, (int)l_.z, (int)l_.w, (int)h_.x, (int)h_.y, (int)h_.z, (int)h_.w}; })
  const v8i_t a00 = KF8(r32, sl), a10 = KF8(32 + r32, sl), a01 = KF8(r32, sl + 4), a11 = KF8(32 + r32, sl + 4);
#undef KF8
  asm volatile("s_nop 1\n\tv_mfma_scale_f32_32x32x64_f8f6f4 %0, %1, %2, 0, %3, %3 op_sel_hi:[0,0,0]" : "=&v"(p0) : "v"(a00), "v"(qf[0]), "v"(sc));
  asm volatile("s_nop 1\n\tv_mfma_scale_f32_32x32x64_f8f6f4 %0, %1, %2, 0, %3, %3 op_sel_hi:[0,0,0]" : "=&v"(p1) : "v"(a10), "v"(qf[0]), "v"(sc), "v"(a00));
  asm volatile("s_nop 1\n\tv_mfma_scale_f32_32x32x64_f8f6f4 %0, %1, %2, %0, %3, %3 op_sel_hi:[0,0,0]" : "+v"(p0) : "v"(a01), "v"(qf[1]), "v"(sc), "v"(a10));
  asm volatile("s_nop 1\n\tv_mfma_scale_f32_32x32x64_f8f6f4 %0, %2, %3, %0, %4, %4 op_sel_hi:[0,0,0]\n\ts_nop 15\n\ts_nop 7" : "+v"(p1), "+v"(p0) : "v"(a11), "v"(qf[1]), "v"(sc), "v"(a01));
}
__device__ __forceinline__ void attn_dense_body_q8(const unsigned char* Qb8, const unsigned char* __restrict__ Kh8, const bf16* __restrict__ Vh, bf16* Ob, int seq, char* lds,
                                                   __attribute__((address_space(3))) unsigned char* ldsA, float negM) {
  typedef __attribute__((address_space(3))) unsigned LU;
  const int tid = threadIdx.x, wid = __builtin_amdgcn_readfirstlane(tid >> 6), lane = tid & 63, r32 = lane & 31, hi = lane >> 5;
  constexpr int RING = 4, KOFF = RING * (int)SHM_V;
  const char* K_lds = lds + KOFF;
  float* li_l = (float*)(lds + KOFF + RING * SHM_K8) + wid * 64;
  float m_reg = negM, l_reg = 0, mn, al; f32x16 o[4] = {}; v8i_t qf[2];
  { const unsigned char* Qw = Qb8 + (long)(wid * QBLK + r32) * 2048 + hi * 32;
#pragma unroll
    for (int s = 0; s < 2; ++s) { const u32x4 a = *reinterpret_cast<const u32x4*>(Qw + 64 * s), b = *reinterpret_cast<const u32x4*>(Qw + 64 * s + 16);
      qf[s] = (v8i_t){(int)a.x, (int)a.y, (int)a.z, (int)a.w, (int)b.x, (int)b.y, (int)b.z, (int)b.w}; } }
  unsigned gV0, gV1, gK;
  { const int c0 = tid, c1 = tid + 512;
#define VSRC(ci) ({ const int kk_ = (((ci) >> 7) << 3) | (((ci) & 31) >> 2), k_ = (kk_ & ~0xC) | ((kk_ & 4) << 1) | ((kk_ & 8) >> 1), c_ = ((((ci) >> 5) & 3) << 5) | (((ci) & 3) << 3); (unsigned)((k_ * LDK + c_) * 2); })
    gV0 = VSRC(c0); gV1 = VSRC(c1);
#undef VSRC
    const int kr = tid >> 3, ps = tid & 7; gK = (unsigned)(kr * 512 + ((ps ^ ((kr >> 1) & 7)) << 4)); }
  const int vb0 = (int)(uintptr_t)lds + v_rd_base(lane);
#define DMA(t) do { const int s_ = (t) & 3; const char* vb_ = (const char*)Vh + (size_t)(t) * (KVBLK * LDK * 2); const unsigned char* kb_ = Kh8 + (size_t)(t) * (KVBLK * 512); \
    __builtin_amdgcn_global_load_lds((const unsigned*)(vb_ + gV0), (LU*)(ldsA + s_ * (int)SHM_V + wid * 1024), 16, 0, 0); \
    __builtin_amdgcn_global_load_lds((const unsigned*)(vb_ + gV1), (LU*)(ldsA + s_ * (int)SHM_V + 8192 + wid * 1024), 16, 0, 0); \
    __builtin_amdgcn_global_load_lds((const unsigned*)(kb_ + gK), (LU*)(ldsA + KOFF + s_ * (int)SHM_K8 + wid * 1024), 16, 0, 0); } while (0)
#define VWAIT(n) asm volatile("s_waitcnt vmcnt(" #n ")" ::: "memory")
#define WGBAR() do { asm volatile("s_waitcnt lgkmcnt(0)" ::: "memory"); __builtin_amdgcn_s_barrier(); asm volatile("" ::: "memory"); } while (0)
#define HALF(t, PN0, PN1, PO0, PO1, W) do { SBAR(); qkt8(PN0, PN1, K_lds + ((t) & 3) * (int)SHM_K8, qf, r32, hi); \
    finishSM(PO0, PO1, 1.f, l_reg, pa0, pa1, pa2, pa3); SBAR(); \
    pv_d0(o, vb0 + (((t) - 1) & 3) * (int)SHM_V, pa0, pa1, pa2, pa3); partialSM(PN0, PN1, m_reg, mn, al); \
    W; WGBAR(); } while (0)
  f32x16 pA0, pA1, pB0, pB1; bf16x8 pa0, pa1, pa2, pa3; const int NT = seq / KVBLK;
  DMA(0); DMA(1); DMA(2);
  VWAIT(6); WGBAR();
  qkt8(pA0, pA1, K_lds, qf, r32, hi); partialSM(pA0, pA1, m_reg, mn, al);
  VWAIT(3); WGBAR();
  int t = 1;
  for (; t + 4 < NT; t += 2) {
    DMA(t + 2); HALF(t, pB0, pB1, pA0, pA1, VWAIT(3));
    DMA(t + 3); HALF(t + 1, pA0, pA1, pB0, pB1, VWAIT(3));
  }
  DMA(t + 2); HALF(t, pB0, pB1, pA0, pA1, VWAIT(3));
  HALF(t + 1, pA0, pA1, pB0, pB1, VWAIT(0));
  HALF(t + 2, pB0, pB1, pA0, pA1, (void)0);
  finishSM(pB0, pB1, 1.f, l_reg, pa0, pa1, pa2, pa3); SBAR();
  pv_d0(o, vb0 + ((NT - 1) & 3) * (int)SHM_V, pa0, pa1, pa2, pa3);
  if (hi == 0) li_l[r32] = l_reg; asm volatile("s_waitcnt lgkmcnt(0)" ::: "memory");
  float rli[16];
#pragma unroll
  for (int r = 0; r < 16; ++r) rli[r] = __builtin_amdgcn_rcpf(li_l[crow(r, hi)]);
  bf16* Ow = Ob + (long)(wid * QBLK) * LDO;
#pragma unroll
  for (int r = 0; r < 16; ++r) { int orow = crow(r, hi);
    for (int d0 = 0; d0 < 4; ++d0) { const float v = o[d0][r] * rli[r]; Ow[(long)orow * LDO + d0 * 32 + r32] = (bf16)(cvtpk(v, v) & 0xffffu); } }
  __syncthreads();
#undef DMA
#undef VWAIT
#undef WGBAR
#undef HALF
}
template <int VAR = 0>
__device__ __forceinline__ void qkt8c(f32x16& p0, f32x16& p1, const char* Ks, const v8i_t* qf, const f32x16& cinit, int r32, int hi, v8i_t& keepk) {
  int sc = 0x7F7F7F7F, scq = 0x7C7C7C7C; asm volatile("" : "+v"(sc), "+v"(scq));
  const int sl = 2 * hi;
#define KF8(ROW, SL) ({ const u32x4 l_ = *reinterpret_cast<const u32x4*>(Ks + K8SW(ROW, SL)), h_ = *reinterpret_cast<const u32x4*>(Ks + K8SW(ROW, (SL) + 1)); \
    (v8i_t){(int)l_.x, (int)l_.y, (int)l_.z, (int)l_.w, (int)h_.x, (int)h_.y, (int)h_.z, (int)h_.w}; })
  const v8i_t a00 = KF8(r32, sl), a10 = KF8(32 + r32, sl), a01 = KF8(r32, sl + 4), a11 = KF8(32 + r32, sl + 4);
#undef KF8
  if constexpr (VAR & 1) { asm volatile("" : "=&v"(p0) : "v"(a00), "v"(qf[0]), "v"(sc), "v"(scq), "v"(cinit)); } else { asm volatile("v_mfma_scale_f32_32x32x64_f8f6f4 %0, %1, %2, %5, %3, %4 op_sel_hi:[0,0,0]" : "=&v"(p0) : "v"(a00), "v"(qf[0]), "v"(sc), "v"(scq), "v"(cinit)); }
  if constexpr (VAR & 1) { asm volatile("" : "=&v"(p1) : "v"(a10), "v"(qf[0]), "v"(sc), "v"(scq), "v"(cinit), "v"(a00)); } else { asm volatile("v_mfma_scale_f32_32x32x64_f8f6f4 %0, %1, %2, %5, %3, %4 op_sel_hi:[0,0,0]" : "=&v"(p1) : "v"(a10), "v"(qf[0]), "v"(sc), "v"(scq), "v"(cinit), "v"(a00)); }
  if constexpr (VAR & 1) { asm volatile("" : "+v"(p0) : "v"(a01), "v"(qf[1]), "v"(sc), "v"(scq), "v"(a10)); } else { asm volatile("v_mfma_scale_f32_32x32x64_f8f6f4 %0, %1, %2, %0, %3, %4 op_sel_hi:[0,0,0]" : "+v"(p0) : "v"(a01), "v"(qf[1]), "v"(sc), "v"(scq), "v"(a10)); }
  if constexpr (VAR & 1) { asm volatile("" : "+v"(p1), "+v"(p0) : "v"(a11), "v"(qf[1]), "v"(sc), "v"(scq), "v"(a01)); } else { asm volatile("v_mfma_scale_f32_32x32x64_f8f6f4 %0, %2, %3, %0, %4, %5 op_sel_hi:[0,0,0]" : "+v"(p1), "+v"(p0) : "v"(a11), "v"(qf[1]), "v"(sc), "v"(scq), "v"(a01)); }
  keepk = a11;
}
template <int VAR = 0>
__device__ __forceinline__ void partialSM8(f32x16& p0) { if constexpr (VAR & 2) { asm volatile("" : "+v"(p0)); } else { for (int r = 0; r < 16; ++r) p0[r] = __builtin_amdgcn_exp2f(p0[r]); } }
template <int VAR = 0>
__device__ __forceinline__ void finishSM8(f32x16& p0, f32x16& p1, float& l_reg, v8i_t& P8) {
  if constexpr (VAR & 2) { asm volatile("" : "=v"(P8) : "v"(p0), "v"(p1)); l_reg += 1.f; return; }
  for (int r = 0; r < 16; ++r) p1[r] = __builtin_amdgcn_exp2f(p1[r]);
  float ps = 0; for (int r = 0; r < 16; ++r) ps += p0[r]; for (int r = 0; r < 16; ++r) ps += p1[r];
  { auto rr = __builtin_amdgcn_permlane32_swap(__float_as_uint(ps), __float_as_uint(ps), false, false);
    ps = __uint_as_float(rr[0]) + __uint_as_float(rr[1]); }
  l_reg += ps;
#pragma unroll
  for (int j = 0; j < 4; ++j) { int w = 0; w = __builtin_amdgcn_cvt_pk_bf8_f32(p0[4 * j], p0[4 * j + 1], w, false); w = __builtin_amdgcn_cvt_pk_bf8_f32(p0[4 * j + 2], p0[4 * j + 3], w, true); P8[j] = w;
    int u = 0; u = __builtin_amdgcn_cvt_pk_bf8_f32(p1[4 * j], p1[4 * j + 1], u, false); u = __builtin_amdgcn_cvt_pk_bf8_f32(p1[4 * j + 2], p1[4 * j + 3], u, true); P8[4 + j] = u; }
}
template <int VAR = 0>
__device__ __forceinline__ void pv8(f32x16* o, const char* Vs, int va0, int va1, const v8i_t& P8, v8i_t& keep) {
  int sc = 0x7F7F7F7F; asm volatile("" : "+v"(sc));
#define VF8(D0) ({ const u32x4 l_ = *reinterpret_cast<const u32x4*>(Vs + va0 + (D0) * 2048), h_ = *reinterpret_cast<const u32x4*>(Vs + va1 + (D0) * 2048); \
    (v8i_t){(int)l_.x, (int)l_.y, (int)l_.z, (int)l_.w, (int)h_.x, (int)h_.y, (int)h_.z, (int)h_.w}; })
  const v8i_t f0 = VF8(0), f1 = VF8(1), f2 = VF8(2), f3 = VF8(3);
#undef VF8
  if constexpr (VAR & 1) { asm volatile("" : "+v"(o[0]) : "v"(P8), "v"(f0), "v"(sc)); } else { asm volatile("s_nop 1\n\tv_mfma_scale_f32_32x32x64_f8f6f4 %0, %1, %2, %0, %3, %3 op_sel_hi:[0,0,0] cbsz:1" : "+v"(o[0]) : "v"(P8), "v"(f0), "v"(sc)); }
  if constexpr (VAR & 1) { asm volatile("" : "+v"(o[1]) : "v"(P8), "v"(f1), "v"(sc), "v"(f0)); } else { asm volatile("v_mfma_scale_f32_32x32x64_f8f6f4 %0, %1, %2, %0, %3, %3 op_sel_hi:[0,0,0] cbsz:1" : "+v"(o[1]) : "v"(P8), "v"(f1), "v"(sc), "v"(f0)); }
  if constexpr (VAR & 1) { asm volatile("" : "+v"(o[2]) : "v"(P8), "v"(f2), "v"(sc), "v"(f1)); } else { asm volatile("v_mfma_scale_f32_32x32x64_f8f6f4 %0, %1, %2, %0, %3, %3 op_sel_hi:[0,0,0] cbsz:1" : "+v"(o[2]) : "v"(P8), "v"(f2), "v"(sc), "v"(f1)); }
  if constexpr (VAR & 1) { asm volatile("" : "+v"(o[3]) : "v"(P8), "v"(f3), "v"(sc), "v"(f2)); } else { asm volatile("v_mfma_scale_f32_32x32x64_f8f6f4 %0, %1, %2, %0, %3, %3 op_sel_hi:[0,0,0] cbsz:1" : "+v"(o[3]) : "v"(P8), "v"(f3), "v"(sc), "v"(f2)); }
  keep = f3;
}
template <int VAR = 0>
__device__ __forceinline__ void attn_dense_body_q8v8(const unsigned char* Qb8, const unsigned char* __restrict__ Kh8, const unsigned char* __restrict__ Vt8, bf16* Ob, int seq, char* lds,
                                                     __attribute__((address_space(3))) unsigned char* ldsA, float negM) {
  typedef __attribute__((address_space(3))) unsigned LU;
  const int tid = threadIdx.x, wid = __builtin_amdgcn_readfirstlane(tid >> 6), lane = tid & 63, r32 = lane & 31, hi = lane >> 5;
  constexpr int RING = 4, SHM_V8 = 8192, KOFF = RING * SHM_V8;
  const char* K_lds = lds + KOFF;
  float* li_l = (float*)(lds + KOFF + RING * SHM_K8) + wid * 64;
  float l_reg = 0; f32x16 o[4] = {}; v8i_t qf[2]; f32x16 cinit;
  { float c0 = negM + 13.0f; asm volatile("" : "+v"(c0));
#pragma unroll
    for (int r = 0; r < 16; ++r) cinit[r] = c0; asm volatile("" : "+v"(cinit)); }
  { const unsigned char* Qw = Qb8 + (long)(wid * QBLK + r32) * 2048 + hi * 32;
#pragma unroll
    for (int s = 0; s < 2; ++s) { const u32x4 a = *reinterpret_cast<const u32x4*>(Qw + 64 * s), b = *reinterpret_cast<const u32x4*>(Qw + 64 * s + 16);
      qf[s] = (v8i_t){(int)a.x, (int)a.y, (int)a.z, (int)a.w, (int)b.x, (int)b.y, (int)b.z, (int)b.w}; } }
  unsigned gK; { const int kr = tid >> 3, ps = tid & 7; gK = (unsigned)(kr * 512 + ((ps ^ ((kr >> 1) & 7)) << 4)); }
  const unsigned gV = (unsigned)tid * 16u;
  const int va0 = r32 * 64 + (((2 * hi) ^ ((r32 >> 2) & 3)) << 4), va1 = r32 * 64 + (((2 * hi + 1) ^ ((r32 >> 2) & 3)) << 4);
#define DMAK(t) __builtin_amdgcn_global_load_lds((const unsigned*)(Kh8 + (size_t)(t) * (KVBLK * 512) + gK), (LU*)(ldsA + KOFF + ((t) & 3) * (int)SHM_K8 + wid * 1024), 16, 0, 0)
#define DMAV(t) __builtin_amdgcn_global_load_lds((const unsigned*)(Vt8 + (size_t)(t) * 8192 + gV), (LU*)(ldsA + ((t) & 3) * SHM_V8 + wid * 1024), 16, 0, 0)
#define VWAIT(n) asm volatile("s_waitcnt vmcnt(" #n ")" ::: "memory")
#define WGBAR() do { asm volatile("s_waitcnt lgkmcnt(0)" ::: "memory"); __builtin_amdgcn_s_barrier(); asm volatile("" ::: "memory"); } while (0)
#define SQ(t, P0, P1) qkt8c<VAR>(P0, P1, K_lds + ((t) & 3) * (int)SHM_K8, qf, cinit, r32, hi, keepk)
#define SPV(t) pv8<VAR>(o, lds + ((t) & 3) * SHM_V8, va0, va1, P8, keep)
#define KEEP() asm volatile("" :: "v"(P8), "v"(keep))
#define SYNC(W, DK, DV) do { W; WGBAR(); DK; DV; } while (0)
#define ITER(t, PN0, PN1, PO0, PO1, W, DK, DV) do { if (!gB) SYNC(W, DK, DV); SBAR(); if (doM) SQ(t, PN0, PN1); SBAR(); if (gB) SYNC(W, DK, DV); \
    SBAR(); if (doV) finishSM8<VAR>(PO0, PO1, l_reg, P8); else asm volatile("" : "=v"(P8)); asm volatile("" :: "v"(keepk)); if (doM) SPV((t) - 1); if (doV) partialSM8<VAR>(PN0); KEEP(); } while (0)
  f32x16 pA0, pA1, pB0, pB1; v8i_t P8, keep = {}, keepk = {}; const int NT = seq / KVBLK;
  const bool gB = (VAR & 8) ? (wid >= 4) : ((wid & 1) != 0);
  const bool doM = (VAR & 4) ? !gB : true, doV = (VAR & 4) ? gB : true;
  DMAK(0); DMAK(1); DMAV(0); DMAK(2); DMAV(1); DMAK(3); DMAV(2);
  VWAIT(5); WGBAR();
  SQ(0, pA0, pA1); asm volatile("s_nop 15\n\ts_nop 7" : "+v"(pA0), "+v"(pA1) : "v"(keepk)); partialSM8<VAR>(pA0);
  int t = 1;
  for (; t + 4 < NT; t += 2) {
    ITER(t, pB0, pB1, pA0, pA1, VWAIT(3), DMAK(t + 3), DMAV(t + 2));
    ITER(t + 1, pA0, pA1, pB0, pB1, VWAIT(3), DMAK(t + 4), DMAV(t + 3));
  }
  ITER(t, pB0, pB1, pA0, pA1, VWAIT(3), (void)0, DMAV(t + 2));
  ITER(t + 1, pA0, pA1, pB0, pB1, VWAIT(0), (void)0, (void)0);
  ITER(t + 2, pB0, pB1, pA0, pA1, (void)0, (void)0, (void)0);
  finishSM8<VAR>(pB0, pB1, l_reg, P8); SBAR();
  SPV(NT - 1);
  asm volatile("s_nop 15\n\ts_nop 7" : "+v"(o[0]), "+v"(o[1]), "+v"(o[2]), "+v"(o[3]) : "v"(P8), "v"(keep));
  if (hi == 0) li_l[r32] = l_reg; asm volatile("s_waitcnt lgkmcnt(0)" ::: "memory");
  float rli[16];
#pragma unroll
  for (int r = 0; r < 16; ++r) rli[r] = __builtin_amdgcn_rcpf(li_l[crow(r, hi)]);
  __syncthreads();
  { unsigned char* Os = (unsigned char*)(lds + wid * 4096);
#pragma unroll
    for (int r = 0; r < 16; ++r) { const int orow = crow(r, hi);
#pragma unroll
      for (int d0 = 0; d0 < 4; ++d0) { const float v = o[d0][r] * rli[r] * 32.0f; Os[orow * 128 + d0 * 32 + r32] = (unsigned char)(__builtin_amdgcn_cvt_pk_fp8_f32(v, v, 0, false) & 0xff); } }
    asm volatile("s_waitcnt lgkmcnt(0)" ::: "memory");
    unsigned char* Ow = (unsigned char*)Ob + (long)(wid * QBLK) * 8192;
#pragma unroll
    for (int i2 = 0; i2 < 4; ++i2) { const int pi = i2 * 64 + lane, row = pi >> 3, c16 = pi & 7;
      *reinterpret_cast<u32x4*>(Ow + (long)row * 8192 + c16 * 16) = *reinterpret_cast<const u32x4*>(Os + row * 128 + c16 * 16); } }
  __syncthreads();
#undef DMAK
#undef DMAV
#undef VWAIT
#undef WGBAR
#undef SQ
#undef SPV
#undef KEEP
#undef SYNC
#undef ITER
}
#undef K8SW
#undef KSWZ
#undef SBAR
}
constexpr int NWAVES = 8;
#ifndef MK_N_LAUNCHES
#define MK_N_LAUNCHES 1
#endif
constexpr int N_PHASES = 16;
constexpr int N_LAUNCHES = MK_N_LAUNCHES;
constexpr int BATCH = 2, SEQ = 8192, DM = 4096, M = BATCH * SEQ;
constexpr int ATTN_DIM = 2048, KV_DIM = 512, HQK = 2048, DFF = 11008, PLE = 256, NHG = 16, NQH = 16, NKVH = 4;
constexpr int N_IN = 13312, N1 = N_IN + 2 * DM;
constexpr float DN_ALPHA = 1.189207115002721f, LN_EPS = 1e-5f, RMS_EPS = 1e-6f;
constexpr int NCHUNK = M / 64;
constexpr size_t MiB = 1u << 20;
constexpr size_t WS_CTL = 0, CTL_ZERO_BYTES = 1 * MiB;
constexpr size_t WS_TAB = 1 * MiB;
constexpr size_t WS_RF = 2 * MiB, WS_WF = 4 * MiB, WS_RB = 6 * MiB, WS_WB = 8 * MiB;
constexpr size_t WS_BT1 = 10 * MiB;
constexpr size_t WS_WPAB = 178 * MiB, WS_WO = 210 * MiB;
constexpr size_t WS_XB = 242 * MiB;
constexpr size_t WS_QA = 370 * MiB, WS_KA = 434 * MiB, WS_VA = 450 * MiB;
constexpr size_t WS_QF = 466 * MiB, WS_KF = 530 * MiB, WS_KB = 594 * MiB, WS_QB = 658 * MiB, WS_IH = 722 * MiB, WS_GH = 786 * MiB;
constexpr size_t WS_GATE = 850 * MiB;
constexpr float MIX_ASCALE = 32.f;
constexpr size_t WS_MIX = 530 * MiB, WS_Y1 = 52 * MiB;
constexpr size_t WS_WUP = 1106 * MiB, WS_WDN = 1278 * MiB;
constexpr size_t WS_LNC = 1364 * MiB, WS_LNC12 = 1366 * MiB, WS_LNST = 1366 * MiB + 64 * 1024, WS_LNS = 2 * MiB, WS_END = 1367 * MiB;
constexpr size_t WS_WPG = 10 * MiB, WS_WPLE = 42 * MiB, WS_PB = 44 * MiB, WS_X1B = 52 * MiB, WS_UB = 180 * MiB, WS_GB = 524 * MiB, WS_PE = 880 * MiB;
static_assert(WS_WDN + (size_t)DM * DFF * 2 <= WS_END && WS_GB + (size_t)M * DFF * 2 <= WS_WUP && WS_X1B + (size_t)M * DM * 2 <= WS_UB, "ws map");
constexpr size_t OUT_X8 = 128 * MiB, OUT_W8 = 192 * MiB, OUT_W8A = 224 * MiB;
constexpr int N_F8 = 7168;
constexpr int N_ATT = 3072;
constexpr float GATE_WSCALE = 64.0f;
constexpr size_t WS_Q8 = 52 * MiB, WS_K8 = 84 * MiB, WS_VT8 = 92 * MiB;
constexpr int CW_TMO = 0, CW_CODE = 1, CW_BAR = 4096;
constexpr int RING_BYTES = 131072, LDSCTL_OFF = RING_BYTES, MISC_OFF = LDSCTL_OFF + 320, LDS_BYTES = 147456;

#define GAS __attribute__((address_space(1)))
#define LAS __attribute__((address_space(3)))
typedef unsigned short bf16;
typedef unsigned v4u __attribute__((ext_vector_type(4)));
typedef unsigned v2u __attribute__((ext_vector_type(2)));
typedef float f32x4 __attribute__((ext_vector_type(4)));
typedef short bf16x8 __attribute__((ext_vector_type(8)));
typedef short s16x4 __attribute__((ext_vector_type(4)));
typedef GAS unsigned gu32;
#define RLX_AGENT __ATOMIC_RELAXED, __HIP_MEMORY_SCOPE_AGENT
#define LDS_WAIT() asm volatile("s_waitcnt lgkmcnt(0)" ::: "memory")
#define VM_WAIT() asm volatile("s_waitcnt vmcnt(0)" ::: "memory")
typedef float f32x2_t __attribute__((ext_vector_type(2))); typedef __bf16 bf16x2_t __attribute__((ext_vector_type(2)));
__device__ __forceinline__ unsigned pk2(float lo, float hi) { f32x2_t v = {lo, hi}; bf16x2_t b = __builtin_convertvector(v, bf16x2_t); return __builtin_bit_cast(unsigned, b); }
__device__ __forceinline__ float bflo(unsigned w) { return __uint_as_float(w << 16); }
__device__ __forceinline__ float bfhi(unsigned w) { return __uint_as_float(w & 0xffff0000u); }
__device__ __forceinline__ float sigm(float v) { return __builtin_amdgcn_rcpf(1.0f + __expf(-v)); }
#define XB_TMO      128
#define XB_XCNT(j)  (256  + 64 * (j))
#define XB_XSUB(j)  (1280 + 64 * (j))
#define XB_XGEN(j)  (2304 + 64 * (j))
#define XB_TOP      3328
#define XB_TOPGEN   3392
#define XCD_BAR_WORDS 3456
#define XB_SPIN_CAP (1u << 18)

__device__ __forceinline__ unsigned xb_ld(unsigned* p)              { return __hip_atomic_load(p, __ATOMIC_RELAXED, __HIP_MEMORY_SCOPE_AGENT); }
__device__ __forceinline__ unsigned xb_add(unsigned* p, unsigned v) { return __hip_atomic_fetch_add(p, v, __ATOMIC_RELAXED, __HIP_MEMORY_SCOPE_AGENT); }
__device__ __forceinline__ unsigned xb_xcc_id() { return (unsigned)__builtin_amdgcn_s_getreg((3 << 11) | 20) & 0xFu; }
#define XB_SPIN(cond, bar) do { unsigned _sp = 0; while (cond) { __builtin_amdgcn_s_sleep(1); \
    if ((++_sp & 255u) == 0u) { if (xb_ld(&(bar)[XB_TMO])) break; if (_sp > XB_SPIN_CAP) { atomicAdd(&(bar)[XB_TMO], 1u); break; } } } } while (0)

struct XcdBarrier {
    unsigned* bar; unsigned x;
    volatile LAS unsigned* st;
};

__device__ __forceinline__ XcdBarrier xcd_barrier_post(unsigned* bar, volatile LAS unsigned* st) {
    XcdBarrier b; b.bar = bar; b.x = xb_xcc_id(); b.st = st;
    if (threadIdx.x == 0) (void)xb_add(&bar[XB_XCNT(b.x)], 1u);
    return b;
}
__device__ __forceinline__ void xcd_barrier_complete(unsigned* bar, unsigned x, unsigned& nloc, unsigned& nx) {
    const unsigned G = gridDim.x * gridDim.y * gridDim.z;
    unsigned sum, cnt, mine, sp = 0u;
    for (;;) {
        sum = 0u; cnt = 0u; mine = 0u;
#pragma unroll
        for (unsigned j = 0; j < 16; ++j) { const unsigned c = xb_ld(&bar[XB_XCNT(j)]); sum += c; cnt += (c > 0u) ? 1u : 0u; mine = (j == x) ? c : mine; }
        if (sum == G) break;
        __builtin_amdgcn_s_sleep(1);
        if ((++sp & 255u) == 0u) { if (xb_ld(&bar[XB_TMO])) break; if (sp > XB_SPIN_CAP) { atomicAdd(&bar[XB_TMO], 1u); break; } }
    }
    nloc = mine > 0u ? mine : 1u; nx = cnt > 0u ? cnt : 1u;
}

__device__ __forceinline__ void xcd_barrier(const XcdBarrier& b) {
    asm volatile("s_waitcnt vmcnt(0)" ::: "memory");
    __syncthreads();
    if (threadIdx.x == 0) {
        unsigned* bar = b.bar;
        __builtin_amdgcn_s_waitcnt(0);
        unsigned nloc = b.st[0], nx = b.st[1];
        if (nloc == 0u) { xcd_barrier_complete(bar, b.x, nloc, nx); b.st[0] = nloc; b.st[1] = nx; }
        const unsigned old = xb_add(&bar[XB_XSUB(b.x)], 1u);
        const unsigned gen = old / nloc;
        if (old + 1u == (gen + 1u) * nloc) {
            __builtin_amdgcn_fence(__ATOMIC_RELEASE, "agent");
            asm volatile("s_waitcnt vmcnt(0)" ::: "memory");
            const unsigned og = xb_add(&bar[XB_TOP], 1u);
            const unsigned tg = og / nx;
            if (og + 1u == (tg + 1u) * nx) xb_add(&bar[XB_TOPGEN], 1u);
            else XB_SPIN(xb_ld(&bar[XB_TOPGEN]) == tg, bar);
            __builtin_amdgcn_fence(__ATOMIC_ACQUIRE, "agent");
            xb_add(&bar[XB_XGEN(b.x)], 1u);
            asm volatile("s_waitcnt vmcnt(0)" ::: "memory");
        } else {
            XB_SPIN(xb_ld(&bar[XB_XGEN(b.x)]) == gen, bar);
            __builtin_amdgcn_fence(__ATOMIC_ACQUIRE, "agent");
            asm volatile("s_waitcnt vmcnt(0)" ::: "memory");
        }
    }
    __syncthreads();
}
struct Frame {
    LAS unsigned char* lds;
    volatile LAS unsigned* MISC;
    gu32* ctl;
    int tid, lane, wave, vcu, G;
    unsigned char* ws; float* out;
};
__device__ __forceinline__ float wave_sum(float v) {
#pragma unroll
    for (int o = 1; o < 64; o <<= 1) v += __shfl_xor(v, o);
    return v;
}
__device__ __forceinline__ void p0_transpose_item(const float* W, int K, int N, bf16* WT, int row_off, LAS float* scr, int item, int lane, int ldk = 0, int koff = 0) {
    if (ldk == 0) ldk = K;
    const int nblk = N / 32, kb = item / nblk, nb = item % nblk, k0 = 64 * kb, n0 = 32 * nb;
#pragma unroll 8
    for (int i = 0; i < 32; ++i) { const int kk = 2 * i + (lane >> 5); scr[kk * 33 + (lane & 31)] = W[(size_t)(k0 + kk) * N + n0 + (lane & 31)]; }
    LDS_WAIT(); asm volatile("" ::: "memory");
    const int c = lane & 7;
#pragma unroll
    for (int j = 0; j < 4; ++j) { const int n = (lane >> 3) + 8 * j; const LAS float* s = scr + (8 * c) * 33 + n;
        v4u o; o.x = pk2(s[0 * 33], s[1 * 33]); o.y = pk2(s[2 * 33], s[3 * 33]); o.z = pk2(s[4 * 33], s[5 * 33]); o.w = pk2(s[6 * 33], s[7 * 33]);
        *(GAS v4u*)(WT + (size_t)(row_off + n0 + n) * ldk + koff + k0 + 8 * c) = o; }
    LDS_WAIT(); asm volatile("" ::: "memory");
}
__device__ __forceinline__ void p0_transpose_item_ln(const float* W, int K, int N, bf16* WT, LAS float* scr, int item, int lane, const float* gam, const float* bet, float* C1p, float* C2p) {
    const int nblk = N / 32, kb = item / nblk, nb = item % nblk, k0 = 64 * kb, n0 = 32 * nb;
    float s1 = 0.f, s2 = 0.f;
#pragma unroll 8
    for (int i = 0; i < 32; ++i) { const int kk = 2 * i + (lane >> 5); const float w = W[(size_t)(k0 + kk) * N + n0 + (lane & 31)];
        const float wg = bflo(pk2(w * gam[k0 + kk], 0.f)); scr[kk * 33 + (lane & 31)] = wg; s1 += wg; s2 += w * bet[k0 + kk]; }
    s1 += __shfl_xor(s1, 32); s2 += __shfl_xor(s2, 32);
    if (lane < 32) { C1p[(size_t)kb * N + n0 + lane] = s1; C2p[(size_t)kb * N + n0 + lane] = s2; }
    LDS_WAIT(); asm volatile("" ::: "memory");
    const int c = lane & 7;
#pragma unroll
    for (int j = 0; j < 4; ++j) { const int n = (lane >> 3) + 8 * j; const LAS float* s = scr + (8 * c) * 33 + n;
        v4u o; o.x = pk2(s[0 * 33], s[1 * 33]); o.y = pk2(s[2 * 33], s[3 * 33]); o.z = pk2(s[4 * 33], s[5 * 33]); o.w = pk2(s[6 * 33], s[7 * 33]);
        *(GAS v4u*)(WT + (size_t)(n0 + n) * K + k0 + 8 * c) = o; }
    LDS_WAIT(); asm volatile("" ::: "memory");
}
__device__ __forceinline__ void ln_colsum_reduce(Frame& F, const float* C1p, const float* C2p, float* c1, float* c2, int N, int nkb) {
    for (int n = F.vcu * 512 + F.tid; n < N; n += F.G * 512) { float a = 0.f, b = 0.f;
        for (int kb = 0; kb < nkb; ++kb) { a += C1p[(size_t)kb * N + n]; b += C2p[(size_t)kb * N + n]; }
        c1[n] = a; c2[n] = b; }
}
__device__ __forceinline__ void ln_stats_finalize(Frame& F, const float* S, float* ST) {
    for (int m = F.vcu * 512 + F.tid; m < M; m += F.G * 512) { float s1 = 0.f, s2 = 0.f; const f32x4* p = (const f32x4*)(S + (size_t)m * 128);
#pragma unroll 8
        for (int i = 0; i < 32; ++i) { const f32x4 v = p[i]; s1 += v.x; s2 += v.y; s1 += v.z; s2 += v.w; }
        const float mean = s1 * (1.f / DM), var = fmaxf(s2 * (1.f / DM) - mean * mean, 0.f);
        ST[2 * m] = mean; ST[2 * m + 1] = 1.f / sqrtf(var + LN_EPS); }
}
__device__ __forceinline__ void cvt_rows(Frame& F, const float* src, bf16* dst, size_t n8) {
    for (size_t i = (size_t)F.vcu * 512 + F.tid; i < n8; i += (size_t)F.G * 512) {
        const f32x4 a = *(const f32x4*)(src + i * 8), b = *(const f32x4*)(src + i * 8 + 4);
        v4u o; o.x = pk2(a.x, a.y); o.y = pk2(a.z, a.w); o.z = pk2(b.x, b.y); o.w = pk2(b.z, b.w);
        *(v4u*)(dst + i * 8) = o; }
}
__device__ __forceinline__ unsigned pk4_fp8(float a, float b, float c, float d) { unsigned w = 0u; w = (unsigned)__builtin_amdgcn_cvt_pk_fp8_f32(a, b, (int)w, false); w = (unsigned)__builtin_amdgcn_cvt_pk_fp8_f32(c, d, (int)w, true); return w; }
__device__ __forceinline__ void cvt_x(Frame& F, const float* src, bf16* dst, unsigned char* dst8, size_t n8) {
    for (size_t i = (size_t)F.vcu * 512 + F.tid; i < n8; i += (size_t)F.G * 512) {
        const f32x4 a = *(const f32x4*)(src + i * 8), b = *(const f32x4*)(src + i * 8 + 4);
        v4u o; o.x = pk2(a.x, a.y); o.y = pk2(a.z, a.w); o.z = pk2(b.x, b.y); o.w = pk2(b.z, b.w);
        *(v4u*)(dst + i * 8) = o;
        v2u o8; o8.x = pk4_fp8(a.x, a.y, a.z, a.w); o8.y = pk4_fp8(b.x, b.y, b.z, b.w);
        *(v2u*)(dst8 + i * 8) = o8; }
}
__device__ __forceinline__ void p0_transpose_item_fp8(const float* W, int K, int N, unsigned char* WT, int row_off, LAS float* scr, int item, int lane, float wscale, int ldk = 0) {
    if (ldk == 0) ldk = K;
    const int nblk = N / 32, kb = item / nblk, nb = item % nblk, k0 = 64 * kb, n0 = 32 * nb;
#pragma unroll 8
    for (int i = 0; i < 32; ++i) { const int kk = 2 * i + (lane >> 5); scr[kk * 33 + (lane & 31)] = W[(size_t)(k0 + kk) * N + n0 + (lane & 31)] * wscale; }
    LDS_WAIT(); asm volatile("" ::: "memory");
    const int c = lane & 7;
#pragma unroll
    for (int j = 0; j < 4; ++j) { const int n = (lane >> 3) + 8 * j; const LAS float* s = scr + (8 * c) * 33 + n;
        v2u o; o.x = pk4_fp8(s[0 * 33], s[1 * 33], s[2 * 33], s[3 * 33]); o.y = pk4_fp8(s[4 * 33], s[5 * 33], s[6 * 33], s[7 * 33]);
        *(GAS v2u*)(WT + (size_t)(row_off + n0 + n) * ldk + k0 + 8 * c) = o; }
    LDS_WAIT(); asm volatile("" ::: "memory");
}
struct In { const float *x, *p, *w_in, *q_norm, *k_norm, *lb_logits, *hg_norm, *w_pa, *w_pb, *w_gate, *b_gate, *w_o, *ln1_g, *ln1_b, *w_up, *conv_w, *conv_b, *w_down, *ln2_g, *ln2_b, *w_pg, *w_ple; };

__device__ __forceinline__ void p0_prologue(Frame& F, const In& I) {
    unsigned char* ws = F.ws;
    { float* tab = (float*)(ws + WS_TAB);
      for (int i = blockIdx.x * 512 + F.tid; i < 4096 + 4096; i += F.G * 512) {
          if (i < 4096) { const int pos = i >> 5, fi = i & 31; const float inv = powf(10000.0f, -(float)(2 * fi) / 64.0f); const float ang = (float)pos * inv; tab[i] = cosf(ang); tab[4096 + i] = sinf(ang); }
          else { const int j = i - 4096, dir = j >> 11, c = j & 2047; const float a = I.lb_logits[(dir * 2 + 0) * 2048 + c], b = I.lb_logits[(dir * 2 + 1) * 2048 + c];
                 tab[8192 + j] = 1.0f / (1.0f + expf(b - a)); } } }
    LAS float* scr = (LAS float*)(F.lds + F.wave * 16384);
    const int gw = F.vcu * NWAVES + F.wave, NGW = F.G * NWAVES;
    constexpr int I0 = (DM / 64) * (N_IN / 32), I1 = (DM / 64) * (2 * DM / 32), I2 = (ATTN_DIM / 64) * (DM / 32), I3 = I2, I4 = (DM / 64) * (DM / 32), I5 = (DM / 64) * (2 * DFF / 32), I6 = (DFF / 64) * (DM / 32);
    constexpr int NITEMS = I0 + I1 + I2 + I3 + I4 + I5 + I6;
    for (int it = gw; it < NITEMS; it += NGW) {
        int r = it;
        if (r < I0) { const int n0w = 32 * (r % (N_IN / 32));
                      if (n0w < N_ATT) p0_transpose_item_fp8(I.w_in, DM, N_IN, (unsigned char*)F.out + OUT_W8A, 0, scr, r, F.lane, GATE_WSCALE);
                      else if (n0w >= 5120 && n0w < 9216) p0_transpose_item_fp8(I.w_in, DM, N_IN, (unsigned char*)F.out + OUT_W8A, N_ATT - 5120, scr, r, F.lane, GATE_WSCALE);
                      else p0_transpose_item(I.w_in, DM, N_IN, (bf16*)(ws + WS_BT1), n0w >= 9216 ? -4096 : 0, scr, r, F.lane);
                      continue; } r -= I0;
        if (r < I1) { const int n0g = 32 * (r % (2 * DM / 32)), cch = n0g & (DM - 1), dst = 256 * (cch >> 7) + ((n0g >= DM) ? 128 : 0) + (cch & 127);
            p0_transpose_item_fp8(I.w_gate, DM, 2 * DM, (unsigned char*)F.out + OUT_W8, dst - n0g, scr, r, F.lane, GATE_WSCALE); continue; } r -= I1;
        if (r < I2) { p0_transpose_item_fp8(I.w_pa, ATTN_DIM, DM, ws + WS_WPAB, 0, scr, r, F.lane, GATE_WSCALE, 4 * ATTN_DIM); continue; } r -= I2;
        if (r < I3) { p0_transpose_item(I.w_pb, HQK, DM, (bf16*)(ws + WS_WPAB), 0, scr, r, F.lane, 2 * ATTN_DIM, ATTN_DIM); continue; } r -= I3;
        if (r < I4) { p0_transpose_item_fp8(I.w_o, DM, DM, ws + WS_WO, 0, scr, r, F.lane, GATE_WSCALE); continue; } r -= I4;
        if (r < I5) { p0_transpose_item(I.w_up, DM, 2 * DFF, (bf16*)(ws + WS_WUP), 0, scr, r, F.lane); continue; } r -= I5;
        p0_transpose_item(I.w_down, DFF, DM, (bf16*)(ws + WS_WDN), 0, scr, r, F.lane);
    }
    cvt_x(F, I.x, (bf16*)(ws + WS_XB), (unsigned char*)F.out + OUT_X8, (size_t)M * DM / 8);
}
template <int NH>
__device__ __forceinline__ void qk_prep_one(Frame& F, const bf16* X, bf16* XO, unsigned char* XO8, const float* gain, const float* tab, const float s8) {
    const int sub = F.lane & 15, e0 = sub * 8, e1 = e0 ^ 32, fi = e0 & 31;
    const float sgn = (sub & 4) ? 1.f : -1.f;
    const int NG = F.G * 32;
    const f32x4 g0 = *(const f32x4*)(gain + e0), g1 = *(const f32x4*)(gain + e0 + 4), h0 = *(const f32x4*)(gain + e1), h1 = *(const f32x4*)(gain + e1 + 4);
    for (int it0 = (F.vcu * 512 + F.tid) >> 4; it0 < M * NH; it0 += 4 * NG) {
        v4u xa = *(const v4u*)(X + (size_t)(it0) * 128 + e0), xb = *(const v4u*)(X + (size_t)(it0 + NG) * 128 + e0);
        v4u xc = *(const v4u*)(X + (size_t)(it0 + 2 * NG) * 128 + e0), xd = *(const v4u*)(X + (size_t)(it0 + 3 * NG) * 128 + e0);
#define QK_ONE(XV, ITEM) do { const int it_ = (ITEM); const int row_ = it_ / NH; \
            v4u pv; pv.x = __shfl_xor(XV.x, 4); pv.y = __shfl_xor(XV.y, 4); pv.z = __shfl_xor(XV.z, 4); pv.w = __shfl_xor(XV.w, 4); \
            const float x[8] = {bflo(XV.x), bfhi(XV.x), bflo(XV.y), bfhi(XV.y), bflo(XV.z), bfhi(XV.z), bflo(XV.w), bfhi(XV.w)}; \
            const float px[8] = {bflo(pv.x), bfhi(pv.x), bflo(pv.y), bfhi(pv.y), bflo(pv.z), bfhi(pv.z), bflo(pv.w), bfhi(pv.w)}; \
            float ss = 0.f; \
            _Pragma("unroll") for (int j = 0; j < 8; ++j) ss += x[j] * x[j]; \
            ss += __shfl_xor(ss, 1); ss += __shfl_xor(ss, 2); ss += __shfl_xor(ss, 4); ss += __shfl_xor(ss, 8); \
            const float rstd = 1.0f / sqrtf(ss * (1.0f / 128.0f) + RMS_EPS); \
            const int t = row_ & (SEQ - 1), pos = (e0 < 64) ? (t >> 6) : (t & 63); \
            const f32x4 c0 = *(const f32x4*)(tab + pos * 32 + fi), c1 = *(const f32x4*)(tab + pos * 32 + fi + 4); \
            const f32x4 s0 = *(const f32x4*)(tab + 4096 + pos * 32 + fi), s1 = *(const f32x4*)(tab + 4096 + pos * 32 + fi + 4); \
            float o[8]; \
            _Pragma("unroll") for (int j = 0; j < 8; ++j) { const float cj = j < 4 ? c0[j & 3] : c1[j & 3], sj = j < 4 ? s0[j & 3] : s1[j & 3], gj = j < 4 ? g0[j & 3] : g1[j & 3], hj = j < 4 ? h0[j & 3] : h1[j & 3]; \
                o[j] = (x[j] * rstd * gj) * cj + sgn * (px[j] * rstd * hj) * sj; } \
            if (XO) { v4u w; w.x = pk2(o[0], o[1]); w.y = pk2(o[2], o[3]); w.z = pk2(o[4], o[5]); w.w = pk2(o[6], o[7]); *(v4u*)(XO + (size_t)it_ * 128 + e0) = w; } \
            v2u w8; w8.x = pk4_fp8(o[0] * s8, o[1] * s8, o[2] * s8, o[3] * s8); w8.y = pk4_fp8(o[4] * s8, o[5] * s8, o[6] * s8, o[7] * s8); *(v2u*)(XO8 + (size_t)it_ * 128 + e0) = w8; } while (0)
        QK_ONE(xa, it0); QK_ONE(xb, it0 + NG); QK_ONE(xc, it0 + 2 * NG); QK_ONE(xd, it0 + 3 * NG);
#undef QK_ONE
    }
}
__device__ __forceinline__ void qk_prep(Frame& F, const In& I, bf16* QAo, bf16* KAo) {
    const float* tab = (const float*)(F.ws + WS_TAB);
    qk_prep_one<16>(F, (const bf16*)(F.ws + WS_QA), QAo, F.ws + WS_Q8, I.q_norm, tab, 8.0f * 0.088388347648318440f * 1.4426950408889634f);
    qk_prep_one<4>(F, (const bf16*)(F.ws + WS_KA), KAo, F.ws + WS_K8, I.k_norm, tab, 1.0f);
}
__device__ __forceinline__ void vt8_prep(Frame& F) {
    const bf16* VA = (const bf16*)(F.ws + WS_VA); unsigned char* VT = F.ws + WS_VT8;
    const int gw = F.vcu * NWAVES + F.wave, NGW = F.G * NWAVES, l = F.lane;
    for (int it = gw; it < 2 * 4 * (SEQ / 64); it += NGW) {
        const int t = it & 127, kvh = (it >> 7) & 3, b = it >> 9;
        const bf16* src = VA + (size_t)(b * SEQ + t * 64) * 512 + kvh * 128 + 2 * l;
        unsigned x[64];
#pragma unroll
        for (int k = 0; k < 64; ++k) x[k] = *(const unsigned*)(src + (size_t)k * 512);
        unsigned char* dst = VT + (size_t)it * 8192;
#pragma unroll
        for (int c = 0; c < 2; ++c) { const int d = 2 * l + c;
#pragma unroll
            for (int s = 0; s < 4; ++s) { const int hi = s >> 1, half = s & 1; unsigned o[4];
#pragma unroll
                for (int rr = 0; rr < 4; ++rr) { const int k0 = 32 * half + 8 * rr + 4 * hi;
                    o[rr] = c ? pk4_fp8(bfhi(x[k0]), bfhi(x[k0 + 1]), bfhi(x[k0 + 2]), bfhi(x[k0 + 3])) : pk4_fp8(bflo(x[k0]), bflo(x[k0 + 1]), bflo(x[k0 + 2]), bflo(x[k0 + 3])); }
                *(v4u*)(dst + d * 64 + ((s ^ ((d >> 2) & 3)) << 4)) = (v4u){o[0], o[1], o[2], o[3]}; } }
    }
}
__device__ __forceinline__ void h1_pass(Frame& F, bf16* QFo, bf16* KFo, bf16* KBo, bf16* QBo) {
    unsigned char* ws = F.ws; const float* tab = (const float*)(ws + WS_TAB);
    const bf16* QF = (const bf16*)(ws + WS_QF); const bf16* KF = (const bf16*)(ws + WS_KF); const bf16* KB = (const bf16*)(ws + WS_KB);
    typedef float f2 __attribute__((ext_vector_type(2)));
    LAS f32x4* tot = (LAS f32x4*)F.lds;
    const int p = F.tid & 127, qd = F.tid >> 7, hf = qd >> 1, second = hf ? (qd & 1) : ((qd & 1) ^ 1);
    const float PMIN = 1.8e-35f;
    for (int it = F.vcu; it < NCHUNK * 8; it += F.G) {
        const int c = it >> 3, cg = it & 7, col = cg * 256 + 2 * p; const size_t vecidx = (size_t)c * 2048 + col;
        const float lbf0 = tab[8192 + col], lbf1 = tab[8192 + col + 1], lbb0 = tab[8192 + 2048 + col], lbb1 = tab[8192 + 2048 + col + 1];
        const size_t base = (size_t)(c * 64 + 16 * qd) * 2048 + col;
        unsigned rq[16], ra[16], rb[16];
#pragma unroll
        for (int j = 0; j < 16; ++j) { rq[j] = *(const unsigned*)(QF + base + (size_t)j * 2048); ra[j] = *(const unsigned*)(KF + base + (size_t)j * 2048); rb[j] = *(const unsigned*)(KB + base + (size_t)j * 2048); }
        float ff0[16], ff1[16], fb0[16], fb1[16]; float TF0 = 1.f, TF1 = 1.f, TB0 = 1.f, TB1 = 1.f;
#pragma unroll
        for (int j = 0; j < 16; ++j) {
            ff0[j] = lbf0 + (1.f - lbf0) * sigm(bflo(ra[j])); ff1[j] = lbf1 + (1.f - lbf1) * sigm(bfhi(ra[j]));
            fb0[j] = lbb0 + (1.f - lbb0) * sigm(bflo(rb[j])); fb1[j] = lbb1 + (1.f - lbb1) * sigm(bfhi(rb[j]));
            TF0 *= ff0[j]; TF1 *= ff1[j]; TB0 *= fb0[j]; TB1 *= fb1[j]; }
        __syncthreads();
        tot[qd * 128 + p] = (f32x4){TF0, TF1, TB0, TB1};
        __syncthreads();
        float PF0 = 1.f, PF1 = 1.f, PB0 = 1.f, PB1 = 1.f;
        if (second) { const f32x4 o = tot[(qd ^ 1) * 128 + p]; PF0 = o.x; PF1 = o.y; PB0 = o.z; PB1 = o.w;
            float* vf = (float*)(ws + (hf == 0 ? WS_RF : WS_WF)) + vecidx; float* vb = (float*)(ws + (hf == 1 ? WS_RB : WS_WB)) + vecidx;
            *(f2*)vf = (f2){PF0 * TF0, PF1 * TF1}; *(f2*)vb = (f2){PB0 * TB0, PB1 * TB1}; }
#define H1_ROW(j) do { const float q0 = bflo(rq[j]), q1 = bfhi(rq[j]); float EF0, EF1, IF0, IF1, EB0, EB1, IB0, IB1; \
            if (hf) { PF0 *= ff0[j]; PF1 *= ff1[j]; EF0 = fmaxf(PF0, PMIN); EF1 = fmaxf(PF1, PMIN); IF0 = __builtin_amdgcn_rcpf(EF0); IF1 = __builtin_amdgcn_rcpf(EF1); \
                      IB0 = fmaxf(PB0, PMIN); IB1 = fmaxf(PB1, PMIN); EB0 = __builtin_amdgcn_rcpf(IB0); EB1 = __builtin_amdgcn_rcpf(IB1); PB0 *= fb0[j]; PB1 *= fb1[j]; } \
            else    { IF0 = fmaxf(PF0, PMIN); IF1 = fmaxf(PF1, PMIN); EF0 = __builtin_amdgcn_rcpf(IF0); EF1 = __builtin_amdgcn_rcpf(IF1); PF0 *= ff0[j]; PF1 *= ff1[j]; \
                      PB0 *= fb0[j]; PB1 *= fb1[j]; EB0 = fmaxf(PB0, PMIN); EB1 = fmaxf(PB1, PMIN); IB0 = __builtin_amdgcn_rcpf(EB0); IB1 = __builtin_amdgcn_rcpf(EB1); } \
            const size_t o_ = base + (size_t)(j) * 2048; \
            *(unsigned*)(QFo + o_) = pk2(q0 * EF0, q1 * EF1); *(unsigned*)(KFo + o_) = pk2((1.f - ff0[j]) * IF0, (1.f - ff1[j]) * IF1); \
            *(unsigned*)(QBo + o_) = pk2(q0 * EB0, q1 * EB1); *(unsigned*)(KBo + o_) = pk2((1.f - fb0[j]) * IB0, (1.f - fb1[j]) * IB1); } while (0)
        if (hf) {
#pragma unroll
            for (int j = 0; j < 16; ++j) H1_ROW(j);
        } else {
#pragma unroll
            for (int j = 15; j >= 0; --j) H1_ROW(j);
        }
#undef H1_ROW
    }
    __syncthreads();
}
__device__ __forceinline__ void p2_small_converts(Frame& F, const In& I) {
    LAS float* scr = (LAS float*)(F.lds + F.wave * 16384);
    const int gw = F.vcu * NWAVES + F.wave, NGW = F.G * NWAVES;
    constexpr int J0 = (DM / 64) * (DM / 32), J1 = (PLE / 64) * (DM / 32);
    for (int it = gw; it < J0 + J1; it += NGW) {
        if (it < J0) p0_transpose_item_ln(I.w_pg, DM, DM, (bf16*)(F.ws + WS_WPG), scr, it, F.lane, I.ln2_g, I.ln2_b, (float*)(F.ws + WS_LNC), (float*)(F.ws + WS_LNC) + 64 * DM);
        else p0_transpose_item(I.w_ple, PLE, DM, (bf16*)(F.ws + WS_WPLE), 0, scr, it - J0, F.lane);
    }
    cvt_rows(F, I.p, (bf16*)(F.ws + WS_PB), (size_t)M * PLE / 8);
}
typedef short v4i16_t __attribute__((ext_vector_type(4)));
__device__ __forceinline__ unsigned offb(unsigned row, unsigned ch) { return 256u * row + 16u * (ch ^ (((row & 3u) << 2) | ((row >> 2) & 3u))); }
__device__ __forceinline__ s16x4 vtr(const LAS unsigned char* p) { return __builtin_bit_cast(s16x4, __builtin_amdgcn_ds_read_tr16_b64_v4i16((LAS v4i16_t*)p)); }
#define MFMA16(a, b, c) __builtin_amdgcn_mfma_f32_16x16x32_bf16((a), (b), (c), 0, 0, 0)
struct ScanRegs { v4u rq0, rq1, rk0, rk1, rv0, rv1; f32x4 rw; };
struct ScanCtx { const bf16* QIN; const bf16* KIN; const bf16* VV; bf16* OO; const float* RV; const float* WV; int b, h; int so0, so1; size_t go0, go1; };
template <int DIR>
__device__ __forceinline__ void scan_load(const ScanCtx& C, ScanRegs& R, int it, int tid) {
    const int n = (DIR == 0) ? it : 127 - it; const size_t rb = (size_t)(C.b * SEQ + 64 * n) * 2048;
    R.rq0 = *(const v4u*)(C.QIN + rb + C.go0); R.rk0 = *(const v4u*)(C.KIN + rb + C.go0); R.rv0 = *(const v4u*)(C.VV + rb + C.go0);
    R.rq1 = *(const v4u*)(C.QIN + rb + C.go1); R.rk1 = *(const v4u*)(C.KIN + rb + C.go1); R.rv1 = *(const v4u*)(C.VV + rb + C.go1);
    if (tid < 64) R.rw = *(const f32x4*)((tid < 32 ? C.RV : C.WV) + (size_t)(C.b * 128 + n) * 2048 + C.h * 128 + 4 * (tid & 31));
}
template <int DIR>
__device__ __forceinline__ void scan_step(Frame& F, const ScanCtx& C, ScanRegs& R, f32x4 (&S)[8], int it) {
    LAS unsigned char* lds = F.lds;
    const int tid = F.tid, wid = F.wave; int lane = F.lane;
    asm volatile("" : "+v"(lane));
    const int l15 = lane & 15, g = lane >> 4;
    constexpr int BUFSZ = 3 * 16384 + 1024, AM_OFF = 2 * BUFSZ;
    static_assert(AM_OFF + 8192 <= RING_BYTES, "scan LDS");
    const LAS unsigned char* AM = lds + AM_OFF;
    const int tq = l15 >> 2, tp = lane & 3;
    const int n = (DIR == 0) ? it : 127 - it;
    LAS unsigned char* bufp = lds + (it & 1) * BUFSZ;
    *(LAS v4u*)(bufp + C.so0) = R.rq0; *(LAS v4u*)(bufp + 16384 + C.so0) = R.rk0; *(LAS v4u*)(bufp + 32768 + C.so0) = R.rv0;
    *(LAS v4u*)(bufp + C.so1) = R.rq1; *(LAS v4u*)(bufp + 16384 + C.so1) = R.rk1; *(LAS v4u*)(bufp + 32768 + C.so1) = R.rv1;
    if (tid < 64) *(LAS f32x4*)(bufp + 49152 + tid * 16) = R.rw;
    if (it + 2 < 128) scan_load<DIR>(C, R, it + 2, tid);
    __syncthreads();
    const LAS unsigned char* Qi = bufp; const LAS unsigned char* Ki = bufp + 16384; const LAS unsigned char* Vi = bufp + 32768;
    const LAS float* rI = (const LAS float*)(bufp + 49152); const LAS float* wI = rI + 128;
    { const int ti = wid >> 1, sj0 = (wid & 1) * 2, qrow = 16 * ti + l15, kr0 = 16 * sj0 + l15, kr1 = kr0 + 16;
      f32x4 a0 = (f32x4){0.f, 0.f, 0.f, 0.f}, a1 = a0;
      bf16x8 qf[4], k0[4], k1[4];
#pragma unroll
      for (int ks = 0; ks < 4; ++ks) { const unsigned ch = 4 * ks + g;
          qf[ks] = *(const LAS bf16x8*)(Qi + (qrow >> 5) * 8192 + offb(qrow & 31, ch));
          k0[ks] = *(const LAS bf16x8*)(Ki + (kr0 >> 5) * 8192 + offb(kr0 & 31, ch));
          k1[ks] = *(const LAS bf16x8*)(Ki + (kr1 >> 5) * 8192 + offb(kr1 & 31, ch)); }
      asm volatile("" ::: "memory");
#pragma unroll
      for (int ks = 0; ks < 4; ++ks) { a0 = MFMA16(k0[ks], qf[ks], a0); a1 = MFMA16(k1[ks], qf[ks], a1); }
      const int t = qrow;
#pragma unroll
      for (int tl = 0; tl < 2; ++tl) { f32x4 v = tl ? a1 : a0; const int sbase = 16 * (sj0 + tl) + 4 * g;
#pragma unroll
          for (int i = 0; i < 4; ++i) { const int s = sbase + i; const bool keep = (DIR == 0) ? (s <= t) : (s >= t); v[i] = keep ? v[i] : 0.f; }
          v2u w2; w2.x = pk2(v[0], v[1]); w2.y = pk2(v[2], v[3]);
          *(LAS v2u*)(lds + AM_OFF + t * 128 + ((((sbase >> 3)) ^ (t & 7)) << 4) + 8 * (g & 1)) = w2; } }
    __syncthreads();
    bf16x8 vf[2];
#pragma unroll
    for (int ks = 0; ks < 2; ++ks) { const LAS unsigned char* tb = Vi + ks * 8192;
        const s16x4 lo = vtr(tb + offb(8 * g + tq, 2 * wid + (tp >> 1)) + 8 * (tp & 1)), hi = vtr(tb + offb(8 * g + 4 + tq, 2 * wid + (tp >> 1)) + 8 * (tp & 1));
        vf[ks] = (bf16x8){lo[0], lo[1], lo[2], lo[3], hi[0], hi[1], hi[2], hi[3]}; }
    f32x4 ao[4];
#pragma unroll
    for (int tt = 0; tt < 4; ++tt) ao[tt] = (f32x4){0.f, 0.f, 0.f, 0.f};
    { bf16x8 af[4][2];
#pragma unroll
      for (int tt = 0; tt < 4; ++tt) { const int t = 16 * tt + l15;
#pragma unroll
          for (int ks = 0; ks < 2; ++ks) af[tt][ks] = *(const LAS bf16x8*)(AM + t * 128 + (((4 * ks + g) ^ (t & 7)) << 4)); }
      asm volatile("" ::: "memory");
#pragma unroll
      for (int tt = 0; tt < 4; ++tt)
#pragma unroll
          for (int ks = 0; ks < 2; ++ks) ao[tt] = MFMA16(vf[ks], af[tt][ks], ao[tt]); }
#pragma unroll
    for (int kp = 0; kp < 2; ++kp) {
        f32x4 rr0[2], rr1[2]; v2u qa[2][4], qc[2][4];
#pragma unroll
        for (int k2 = 0; k2 < 2; ++k2) { const int ks = 2 * kp + k2;
            rr0[k2] = *(const LAS f32x4*)(rI + 32 * ks + 4 * g); rr1[k2] = *(const LAS f32x4*)(rI + 32 * ks + 16 + 4 * g);
#pragma unroll
            for (int tt = 0; tt < 4; ++tt) { const int t = 16 * tt + l15; const LAS unsigned char* qb = Qi + (t >> 5) * 8192;
                qa[k2][tt] = *(const LAS v2u*)(qb + offb(t & 31, 4 * ks + (g >> 1)) + 8 * (g & 1)); qc[k2][tt] = *(const LAS v2u*)(qb + offb(t & 31, 4 * ks + 2 + (g >> 1)) + 8 * (g & 1)); } }
        asm volatile("" ::: "memory");
#pragma unroll
        for (int k2 = 0; k2 < 2; ++k2) { const int ks = 2 * kp + k2;
            const f32x4 s0 = S[2 * ks] * rr0[k2], s1 = S[2 * ks + 1] * rr1[k2];
            v4u sw; sw.x = pk2(s0[0], s0[1]); sw.y = pk2(s0[2], s0[3]); sw.z = pk2(s1[0], s1[1]); sw.w = pk2(s1[2], s1[3]);
            const bf16x8 sf = __builtin_bit_cast(bf16x8, sw);
#pragma unroll
            for (int tt = 0; tt < 4; ++tt) { v4u qw; qw.x = qa[k2][tt].x; qw.y = qa[k2][tt].y; qw.z = qc[k2][tt].x; qw.w = qc[k2][tt].y;
                ao[tt] = MFMA16(sf, __builtin_bit_cast(bf16x8, qw), ao[tt]); } } }
    { bf16* op = C.OO + (size_t)(C.b * SEQ + 64 * n + l15) * 2048 + C.h * 128 + 16 * wid + 4 * g;
#pragma unroll
      for (int tt = 0; tt < 4; ++tt) { v2u w2; w2.x = pk2(ao[tt][0], ao[tt][1]); w2.y = pk2(ao[tt][2], ao[tt][3]); *(v2u*)(op + (size_t)(16 * tt) * 2048) = w2; } }
#pragma unroll
    for (int dq = 0; dq < 2; ++dq) {
        bf16x8 kt[4][2]; f32x4 rr[4], ww[4];
#pragma unroll
        for (int d4 = 0; d4 < 4; ++d4) { const int dt = 4 * dq + d4;
#pragma unroll
            for (int ks = 0; ks < 2; ++ks) { const LAS unsigned char* tb = Ki + ks * 8192;
                const s16x4 lo = vtr(tb + offb(8 * g + tq, 2 * dt + (tp >> 1)) + 8 * (tp & 1)), hi = vtr(tb + offb(8 * g + 4 + tq, 2 * dt + (tp >> 1)) + 8 * (tp & 1));
                kt[d4][ks] = (bf16x8){lo[0], lo[1], lo[2], lo[3], hi[0], hi[1], hi[2], hi[3]}; }
            rr[d4] = *(const LAS f32x4*)(rI + 16 * dt + 4 * g); ww[d4] = *(const LAS f32x4*)(wI + 16 * dt + 4 * g); }
        asm volatile("" ::: "memory");
#pragma unroll
        for (int d4 = 0; d4 < 4; ++d4) { const int dt = 4 * dq + d4; f32x4 T = (f32x4){0.f, 0.f, 0.f, 0.f};
#pragma unroll
            for (int ks = 0; ks < 2; ++ks) T = MFMA16(kt[d4][ks], vf[ks], T);
            S[dt] = (rr[d4] * ww[d4]) * S[dt] + ww[d4] * T; } }
}
template <int DIR>
__device__ __forceinline__ void scan_unit(Frame& F, const bf16* QIN, const bf16* KIN, const bf16* VV, bf16* OO, const float* RV, const float* WV, int b, int h) {
    ScanCtx C; C.QIN = QIN; C.KIN = KIN; C.VV = VV; C.OO = OO; C.RV = RV; C.WV = WV; C.b = b; C.h = h;
    { const int c = F.tid, row = c >> 4, ch = c & 15; C.so0 = (row >> 5) * 8192 + (int)offb(row & 31, ch); C.go0 = (size_t)row * 2048 + h * 128 + ch * 8; }
    { const int c = F.tid + 512, row = c >> 4, ch = c & 15; C.so1 = (row >> 5) * 8192 + (int)offb(row & 31, ch); C.go1 = (size_t)row * 2048 + h * 128 + ch * 8; }
    f32x4 S[8];
#pragma unroll
    for (int i = 0; i < 8; ++i) S[i] = (f32x4){0.f, 0.f, 0.f, 0.f};
    ScanRegs RA, RB; RA.rw = (f32x4){0.f, 0.f, 0.f, 0.f}; RB.rw = RA.rw;
    scan_load<DIR>(C, RA, 0, F.tid); scan_load<DIR>(C, RB, 1, F.tid);
    for (int it = 0; it < 128; it += 2) { scan_step<DIR>(F, C, RA, S, it); scan_step<DIR>(F, C, RB, S, it + 1); }
    __syncthreads();
}
__device__ __forceinline__ void combine_pass(Frame& F, const In& I, bf16* YO, int pitch, int coff) {
    const bf16* OF = (const bf16*)(F.ws + WS_QF); const bf16* OB = (const bf16*)(F.ws + WS_QB); const bf16* GH = (const bf16*)(F.ws + WS_GH);
    const int sub = F.lane & 15, e0 = sub * 8;
    for (int it = (F.vcu * 512 + F.tid) >> 4; it < M * 16; it += F.G * 32) {
        const int row = it >> 4, head = it & 15; const size_t off = (size_t)row * 2048 + head * 128 + e0;
        const v4u a = *(const v4u*)(OF + off), bq = *(const v4u*)(OB + off), gq = *(const v4u*)(GH + off);
        float o[8] = {bflo(a.x) + bflo(bq.x), bfhi(a.x) + bfhi(bq.x), bflo(a.y) + bflo(bq.y), bfhi(a.y) + bfhi(bq.y), bflo(a.z) + bflo(bq.z), bfhi(a.z) + bfhi(bq.z), bflo(a.w) + bflo(bq.w), bfhi(a.w) + bfhi(bq.w)};
        const float gg[8] = {bflo(gq.x), bfhi(gq.x), bflo(gq.y), bfhi(gq.y), bflo(gq.z), bfhi(gq.z), bflo(gq.w), bfhi(gq.w)};
        float ss = 0.f;
#pragma unroll
        for (int j = 0; j < 8; ++j) ss += o[j] * o[j];
        ss += __shfl_xor(ss, 1); ss += __shfl_xor(ss, 2); ss += __shfl_xor(ss, 4); ss += __shfl_xor(ss, 8);
        const float rstd = 1.0f / sqrtf(ss * (1.0f / 128.0f) + RMS_EPS);
        const f32x4 n0 = *(const f32x4*)(I.hg_norm + head * 128 + e0), n1 = *(const f32x4*)(I.hg_norm + head * 128 + e0 + 4);
#pragma unroll
        for (int j = 0; j < 8; ++j) o[j] = o[j] * rstd * (j < 4 ? n0[j & 3] : n1[j & 3]) * gg[j];
        v4u w; w.x = pk2(o[0], o[1]); w.y = pk2(o[2], o[3]); w.z = pk2(o[4], o[5]); w.w = pk2(o[6], o[7]);
        *(v4u*)(YO + (size_t)row * pitch + coff + head * 128 + e0) = w;
    }
}
__device__ __forceinline__ void ln_pass(Frame& F, const float* Xf, const bf16* Xb, const bf16* Y, const float* gam, const float* bet, bf16* XO) {
    const int gw = F.vcu * NWAVES + F.wave, NGW = F.G * NWAVES;
    for (int m = gw; m < M; m += NGW) {
        f32x4 v[16]; float s = 0.f;
#pragma unroll
        for (int j = 0; j < 8; ++j) { const int ch = F.lane + 64 * j;
            const v4u yw = *((const v4u*)(Y + (size_t)m * DM) + ch);
            f32x4 a, b;
            if (Xf) { a = *((const f32x4*)(Xf + (size_t)m * DM) + 2 * ch); b = *((const f32x4*)(Xf + (size_t)m * DM) + 2 * ch + 1); }
            else { const v4u xw = *((const v4u*)(Xb + (size_t)m * DM) + ch); a = (f32x4){bflo(xw.x), bfhi(xw.x), bflo(xw.y), bfhi(xw.y)}; b = (f32x4){bflo(xw.z), bfhi(xw.z), bflo(xw.w), bfhi(xw.w)}; }
            v[2 * j] = a * DN_ALPHA + (f32x4){bflo(yw.x), bfhi(yw.x), bflo(yw.y), bfhi(yw.y)}; v[2 * j + 1] = b * DN_ALPHA + (f32x4){bflo(yw.z), bfhi(yw.z), bflo(yw.w), bfhi(yw.w)};
            s += ((v[2 * j].x + v[2 * j].y) + (v[2 * j].z + v[2 * j].w)) + ((v[2 * j + 1].x + v[2 * j + 1].y) + (v[2 * j + 1].z + v[2 * j + 1].w)); }
        const float mean = wave_sum(s) * (1.f / DM); float s2 = 0.f;
#pragma unroll
        for (int j = 0; j < 16; ++j) { v[j] = v[j] - mean; s2 += (v[j].x * v[j].x + v[j].y * v[j].y) + (v[j].z * v[j].z + v[j].w * v[j].w); }
        const float rstd = 1.f / sqrtf(wave_sum(s2) * (1.f / DM) + LN_EPS);
#pragma unroll
        for (int j = 0; j < 8; ++j) { const int ch = F.lane + 64 * j;
            const f32x4 g0 = *((const f32x4*)gam + 2 * ch), g1 = *((const f32x4*)gam + 2 * ch + 1), b0 = *((const f32x4*)bet + 2 * ch), b1 = *((const f32x4*)bet + 2 * ch + 1);
            const f32x4 y0 = v[2 * j] * rstd * g0 + b0, y1 = v[2 * j + 1] * rstd * g1 + b1;
            v4u w; w.x = pk2(y0.x, y0.y); w.y = pk2(y0.z, y0.w); w.z = pk2(y1.x, y1.y); w.w = pk2(y1.z, y1.w);
            *((v4u*)(XO + (size_t)m * DM) + ch) = w; }
    }
}
__device__ __forceinline__ void conv_pass(Frame& F, const In& I, bf16* HO, int nrows) {
    const bf16* U = (const bf16*)(F.ws + WS_UB); const bf16* Gp = (const bf16*)(F.ws + WS_GB);
    constexpr int NCG = DFF / 8; const int NIT = (nrows / 32) * NCG;
    for (int it = F.vcu * 512 + F.tid; it < NIT; it += F.G * 512) {
        const int r = it / NCG, cg = it - r * NCG, c0 = cg * 8, t0 = r * 32, tl = t0 & (SEQ - 1);
        float w0[8], w1[8], w2[8], bb[8];
        { const f32x4 a0 = *(const f32x4*)(I.conv_w + c0), a1 = *(const f32x4*)(I.conv_w + c0 + 4), b0 = *(const f32x4*)(I.conv_w + DFF + c0), b1 = *(const f32x4*)(I.conv_w + DFF + c0 + 4);
          const f32x4 d0 = *(const f32x4*)(I.conv_w + 2 * DFF + c0), d1 = *(const f32x4*)(I.conv_w + 2 * DFF + c0 + 4), e0 = *(const f32x4*)(I.conv_b + c0), e1 = *(const f32x4*)(I.conv_b + c0 + 4);
#pragma unroll
          for (int j = 0; j < 4; ++j) { w0[j] = a0[j]; w0[4 + j] = a1[j]; w1[j] = b0[j]; w1[4 + j] = b1[j]; w2[j] = d0[j]; w2[4 + j] = d1[j]; bb[j] = e0[j]; bb[4 + j] = e1[j]; } }
        const v4u zero = (v4u){0u, 0u, 0u, 0u};
        const bf16* gq = Gp + (size_t)t0 * DFF + c0; const bf16* uq = U + (size_t)t0 * DFF + c0; bf16* hq = HO + (size_t)t0 * DFF + c0;
        v4u gp = *(const v4u*)(gq - (tl == 0 ? 0 : DFF)); if (tl == 0) gp = zero;
        v4u gc = *(const v4u*)gq;
        for (int j0 = 0; j0 < 32; j0 += 4) {
            v4u gn[4], uu[4];
#pragma unroll
            for (int jj = 0; jj < 4; ++jj) { const bool last = (tl + j0 + jj == SEQ - 1); gn[jj] = *(const v4u*)(gq + (size_t)(j0 + jj + (last ? 0 : 1)) * DFF); if (last) gn[jj] = zero; uu[jj] = *(const v4u*)(uq + (size_t)(j0 + jj) * DFF); }
#pragma unroll
            for (int jj = 0; jj < 4; ++jj) {
                const unsigned gpa[4] = {gp.x, gp.y, gp.z, gp.w}, gca[4] = {gc.x, gc.y, gc.z, gc.w}, gna[4] = {gn[jj].x, gn[jj].y, gn[jj].z, gn[jj].w}, ua[4] = {uu[jj].x, uu[jj].y, uu[jj].z, uu[jj].w};
                unsigned ow[4];
#pragma unroll
                for (int q = 0; q < 4; ++q) {
                    const float a0 = bflo(gpa[q]) * w0[2 * q] + bflo(gca[q]) * w1[2 * q] + bflo(gna[q]) * w2[2 * q] + bb[2 * q];
                    const float a1 = bfhi(gpa[q]) * w0[2 * q + 1] + bfhi(gca[q]) * w1[2 * q + 1] + bfhi(gna[q]) * w2[2 * q + 1] + bb[2 * q + 1];
                    ow[q] = pk2(a0 * sigm(a0) * bflo(ua[q]), a1 * sigm(a1) * bfhi(ua[q])); }
                *(v4u*)(hq + (size_t)(j0 + jj) * DFF) = (v4u){ow[0], ow[1], ow[2], ow[3]};
                gp = gc; gc = gn[jj]; }
        }
    }
}
struct Args { In in; float* out; unsigned char* ws; int ph_lo, ph_hi, li, pad; };
__global__ void __launch_bounds__(NWAVES * 64, 2) mk_fwd(Args args) {
    extern __shared__ __attribute__((aligned(16))) unsigned char lds[];
    Frame F;
    F.lds = (LAS unsigned char*)lds;
    F.MISC = (volatile LAS unsigned*)(F.lds + MISC_OFF);
    F.tid = threadIdx.x; F.lane = F.tid & 63; F.wave = __builtin_amdgcn_readfirstlane(F.tid >> 6);
    F.G = gridDim.x; { const int bx = blockIdx.x; F.vcu = (F.G % 8 == 0) ? (bx % 8) * (F.G / 8) + bx / 8 : bx; }
    F.ws = args.ws; F.out = args.out;
    F.ctl = (gu32*)(args.ws + WS_CTL);
    const In& I = args.in;
    unsigned char* ws = args.ws;
    for (int u = F.tid; u < (LDS_BYTES - LDSCTL_OFF) / 4; u += NWAVES * 64) ((LAS unsigned*)(F.lds + LDSCTL_OFF))[u] = 0u;
    __syncthreads();
    XcdBarrier bar; bar.bar = (unsigned*)(F.ctl + CW_BAR); bar.x = 0; bar.st = nullptr;
    if (N_LAUNCHES == 1) bar = xcd_barrier_post((unsigned*)(F.ctl + CW_BAR), F.MISC + 8);
#define GRID_BAR() do { if (N_LAUNCHES == 1) xcd_barrier(bar); } while (0)
#ifndef SPIN_PHASE
#define SPIN_PHASE -1
#endif
#ifndef SPIN_MULT
#define SPIN_MULT 1
#endif
    unsigned long long t_prev = (SPIN_PHASE >= 0) ? wall_clock64() : 0ull, t_sel = 0ull;
#define TSEL(k) do { if (SPIN_PHASE >= 0) { const unsigned long long now_ = wall_clock64(); if ((k) == SPIN_PHASE) t_sel = now_ - t_prev; t_prev = now_; } } while (0)
    const int lo = args.ph_lo, hi = args.ph_hi;
#ifndef PH_MASK
#define PH_MASK 0xFFFF
#endif
#define IN(k) ((((PH_MASK) >> (k)) & 1) && lo <= (k) && (k) < hi)
#define BOTH(k) (IN(k) && IN((k) + 1))
    bf16* const BT1 = (bf16*)(ws + WS_BT1); bf16* const XB = (bf16*)(ws + WS_XB);
    bf16* const QA = (bf16*)(ws + WS_QA); bf16* const KA = (bf16*)(ws + WS_KA); bf16* const VA = (bf16*)(ws + WS_VA);
    bf16* const QF = (bf16*)(ws + WS_QF); bf16* const KF = (bf16*)(ws + WS_KF); bf16* const KB = (bf16*)(ws + WS_KB); bf16* const QB = (bf16*)(ws + WS_QB);
    bf16* const IH = (bf16*)(ws + WS_IH); bf16* const GH = (bf16*)(ws + WS_GH); bf16* const GATE = (bf16*)(ws + WS_GATE);
    bf16* const MIX = (bf16*)(ws + WS_MIX); bf16* const YCAT = (bf16*)F.out;   bf16* const X1B = (bf16*)(ws + WS_X1B); bf16* const UB = (bf16*)(ws + WS_UB); bf16* const PEB = (bf16*)(ws + WS_PE); bf16* const Y1 = (bf16*)(ws + WS_Y1); bf16* const Y2 = (bf16*)(ws + WS_GB);

#ifndef REPEAT_PHASE
#define REPEAT_PHASE -1
#endif
#ifndef REPEAT_N
#define REPEAT_N 1
#endif
#define REPS(k) for (int rep_ = 0; rep_ < (REPEAT_PHASE == (k) ? REPEAT_N : 0); ++rep_)
    bf16* const DUMMY = (bf16*)F.out;
    if (IN(0)) { if (REPEAT_PHASE == 0) { p0_prologue(F, I); GRID_BAR(); } p0_prologue(F, I); if (BOTH(0)) { GRID_BAR(); TSEL(0); } }
    if (IN(1)) {
        { pg8::Gemm g{(const bf16*)((const unsigned char*)F.out + OUT_X8), (const bf16*)((const unsigned char*)F.out + OUT_W8A), M, N_F8, DM / 2}; pg8::StaticOrder S; S.init(M, N_F8, F.G, (int)blockIdx.x);
          pg8::EpiProj E{QA, KA, VA, QF, KF, KB, IH, GH, GATE, I.b_gate, 0, 1.0f / GATE_WSCALE, N_ATT, 2048};
          pg8::gemm_phase<pg8::EpiProj, pg8::StaticOrder, true, true, true>(F.lds, g, S, E); }
        { pg8::Gemm g{XB, BT1 + (size_t)N_ATT * DM, M, N_IN - N_F8, DM}; pg8::StaticOrder S; S.init(M, N_IN - N_F8, F.G, (int)blockIdx.x);
          pg8::EpiProj E{QA, KA, VA, QF, KF, KB, IH, GH, GATE, I.b_gate, N_ATT, 1.0f, 5120, 4096};
          pg8::gemm_phase<pg8::EpiProj, pg8::StaticOrder, true, true>(F.lds, g, S, E); }
        if (BOTH(1)) { GRID_BAR(); TSEL(1); }
    }
    if (IN(2)) {
        REPS(21) { h1_pass(F, DUMMY, DUMMY + (size_t)M * 2048, DUMMY + (size_t)M * 4096, DUMMY + (size_t)M * 6144); GRID_BAR(); }
        REPS(22) { p2_small_converts(F, I); GRID_BAR(); }

#ifdef PROBE_ATTN
        qk_prep(F, I, QA, KA);
#else
        qk_prep(F, I, nullptr, nullptr);
#endif
        vt8_prep(F); h1_pass(F, QF, KF, KB, QB); p2_small_converts(F, I); if (BOTH(2)) { GRID_BAR(); TSEL(2); } }
    if (IN(3)) {
#ifdef UB_VAR
        { typedef float ub16 __attribute__((ext_vector_type(16))); typedef int ub8 __attribute__((ext_vector_type(8)));
          ub16 a0 = {}, a1 = {}, a2 = {}, a3 = {}; ub8 fa, fb; int sc = 0x7F7F7F7F; float xs[16], sum = 0.f;
#pragma unroll
          for (int j = 0; j < 8; ++j) { fa[j] = 0x38383838 + F.lane; fb[j] = 0x38383838 + j; }
#pragma unroll
          for (int j = 0; j < 16; ++j) xs[j] = 0.01f * (float)(F.lane + j);
          asm volatile("" : "+v"(fa), "+v"(fb), "+v"(sc));
          const bool gB = (UB_VAR == 3) ? (F.wave >= 4) : ((F.wave & 1) != 0);
          const bool doM = (UB_VAR == 1) || (UB_VAR >= 3 && !gB), doV = (UB_VAR == 2) || (UB_VAR >= 3 && gB);
          for (int it = 0; it < 8000; ++it) {
              if (doM) { asm volatile("v_mfma_scale_f32_32x32x64_f8f6f4 %0, %4, %5, %0, %6, %6 op_sel_hi:[0,0,0]\n\tv_mfma_scale_f32_32x32x64_f8f6f4 %1, %4, %5, %1, %6, %6 op_sel_hi:[0,0,0]\n\t"
                                      "v_mfma_scale_f32_32x32x64_f8f6f4 %2, %4, %5, %2, %6, %6 op_sel_hi:[0,0,0]\n\tv_mfma_scale_f32_32x32x64_f8f6f4 %3, %4, %5, %3, %6, %6 op_sel_hi:[0,0,0]"
                                      : "+v"(a0), "+v"(a1), "+v"(a2), "+v"(a3) : "v"(fa), "v"(fb), "v"(sc)); }
              if (doV) {
#pragma unroll
                  for (int j = 0; j < 16; ++j) { xs[j] = __builtin_amdgcn_exp2f(-xs[j]); sum += xs[j]; }
#pragma unroll
                  for (int j = 0; j < 16; ++j) { xs[j] = __builtin_amdgcn_exp2f(-xs[j]); sum += xs[j]; }
                  asm volatile("" : "+v"(sum)); } }
          asm volatile("s_nop 15\n\ts_nop 7" : "+v"(a0), "+v"(a1), "+v"(a2), "+v"(a3));
          if (a0[0] + a1[1] + a2[2] + a3[3] + sum == 123456.789f) ((volatile float*)(F.ctl + 20480))[F.tid] = sum;
          GRID_BAR(); }
#endif
#ifdef ATT_VAR
        { float negM0 = -16.6f; const unsigned char* const Q8 = ws + WS_Q8; const unsigned char* const K8 = ws + WS_K8;
          for (int u = F.vcu; u < 1024; u += F.G) { const int gI = u >> 7, r = u & 127, b = gI >> 2, kvh = gI & 3, qh = kvh * 4 + (r >> 5), qb = r & 31;
            const size_t qoff = (size_t)(b * SEQ + qb * 256) * 2048 + qh * 128, koff = (size_t)(b * SEQ) * 512 + kvh * 128;
            attn::attn_dense_body_q8v8<ATT_VAR>(Q8 + qoff, K8 + koff, ws + WS_VT8 + (size_t)gI * (SEQ / 64) * 8192, YCAT + (size_t)(b * SEQ + qb * 256) * 4096 + qh * 128, SEQ, (char*)lds, F.lds, negM0); }
          GRID_BAR(); }
#endif
        if (REPEAT_PHASE == 32) { if (blockIdx.x < 64) { const int u = blockIdx.x, dir = u >> 5, b = (u >> 4) & 1, h = u & 15;
            if (dir == 0) scan_unit<0>(F, QF, KF, IH, DUMMY, (const float*)(ws + WS_RF), (const float*)(ws + WS_WF), b, h);
            else          scan_unit<1>(F, QB, KB, IH, DUMMY + (size_t)M * 2048, (const float*)(ws + WS_RB), (const float*)(ws + WS_WB), b, h); }
          GRID_BAR(); }
        if (blockIdx.x < 64) { const int u = blockIdx.x, dir = u >> 5, b = (u >> 4) & 1, h = u & 15;
            if (dir == 0) scan_unit<0>(F, QF, KF, IH, QF, (const float*)(ws + WS_RF), (const float*)(ws + WS_WF), b, h);
            else          scan_unit<1>(F, QB, KB, IH, QB, (const float*)(ws + WS_RB), (const float*)(ws + WS_WB), b, h); }
        if (SPIN_PHASE == 33) t_sel = wall_clock64() - t_prev;
        {
        float negM;
        { float gq = fmaxf(fabsf(I.q_norm[F.lane]), fabsf(I.q_norm[F.lane + 64])), gk = fmaxf(fabsf(I.k_norm[F.lane]), fabsf(I.k_norm[F.lane + 64]));
#pragma unroll
          for (int o = 1; o < 64; o <<= 1) { gq = fmaxf(gq, __shfl_xor(gq, o)); gk = fmaxf(gk, __shfl_xor(gk, o)); }
          negM = __uint_as_float(__builtin_amdgcn_readfirstlane(__float_as_uint(-1.4426950408889634f * (11.313708499f * 1.01f) * gq * gk))); }
        const unsigned char* const Q8 = ws + WS_Q8; const unsigned char* const K8 = ws + WS_K8;
#ifdef PROBE_ATTN
        for (int u = F.vcu; u < 1024; u += F.G) { const int gI = u >> 7, r = u & 127, b = gI >> 2, kvh = gI & 3, qh = kvh * 4 + (r >> 5), qb = r & 31;
            const size_t qoff = (size_t)(b * SEQ + qb * 256) * 2048 + qh * 128, koff = (size_t)(b * SEQ) * 512 + kvh * 128;
            attn::attn_dense_body(QA + qoff, KA + koff, VA + koff, YCAT + (size_t)(b * SEQ + qb * 256) * 4096 + qh * 128, SEQ, (char*)lds, negM); }
        for (int u = F.vcu; u < 1024; u += F.G) { const int gI = u >> 7, r = u & 127, b = gI >> 2, kvh = gI & 3, qh = kvh * 4 + (r >> 5), qb = r & 31;
            const size_t qoff = (size_t)(b * SEQ + qb * 256) * 2048 + qh * 128, koff = (size_t)(b * SEQ) * 512 + kvh * 128;
            attn::attn_dense_body_q8(Q8 + qoff, K8 + koff, VA + koff, YCAT + (size_t)(b * SEQ + qb * 256) * 4096 + 2048 + qh * 128, SEQ, (char*)lds, F.lds, negM); }
#else
        for (int u = F.vcu; u < 1024; u += F.G) { const int gI = u >> 7, r = u & 127, b = gI >> 2, kvh = gI & 3, qh = kvh * 4 + (r >> 5), qb = r & 31;
            const size_t qoff = (size_t)(b * SEQ + qb * 256) * 2048 + qh * 128, koff = (size_t)(b * SEQ) * 512 + kvh * 128;
            attn::attn_dense_body_q8v8(Q8 + qoff, K8 + koff, ws + WS_VT8 + (size_t)gI * (SEQ / 64) * 8192, (bf16*)((unsigned char*)YCAT + (size_t)(b * SEQ + qb * 256) * 8192 + qh * 128), SEQ, (char*)lds, F.lds, negM); }
#endif
        }
        if (SPIN_PHASE == 34) t_sel = wall_clock64() - t_prev;
        { pg8::Gemm g{(const bf16*)((const unsigned char*)F.out + OUT_X8), (const bf16*)((const unsigned char*)F.out + OUT_W8), M, 2 * DM, DM / 2};
          pg8::DynOrder S{(unsigned*)(F.ctl + 8192 + 64 * (blockIdx.x & 7)), (LAS volatile int*)(F.MISC + 16), (int)(blockIdx.x & 7)};
          S.prime();
          pg8::EpiGate E{GATE, 2 * DM, I.b_gate, 1.0f / GATE_WSCALE};
          pg8::gemm_phase<pg8::EpiGate, pg8::DynOrder, true, true, true>(F.lds, g, S, E); }
    }
    if (IN(4)) {
        if (BOTH(4)) { GRID_BAR(); TSEL(4); }
#ifdef PROBE_ATTN
        { float sd = 0.f, sr = 0.f;
          for (size_t i = (size_t)blockIdx.x * 512 + F.tid; i < (size_t)M * 256; i += (size_t)F.G * 512) { const size_t row = i >> 8, c8 = i & 255;
              const v4u a = *(const v4u*)(YCAT + row * 4096 + c8 * 8), b = *(const v4u*)(YCAT + row * 4096 + 2048 + c8 * 8);
              const unsigned aw[4] = {a.x, a.y, a.z, a.w}, bw[4] = {b.x, b.y, b.z, b.w};
#pragma unroll
              for (int q = 0; q < 4; ++q) { const float r0 = bflo(aw[q]), r1 = bfhi(aw[q]), d0 = bflo(bw[q]) - r0, d1 = bfhi(bw[q]) - r1; sd += d0 * d0 + d1 * d1; sr += r0 * r0 + r1 * r1; } }
          sd = wave_sum(sd); sr = wave_sum(sr);
          LAS float* red = (LAS float*)F.lds;
          __syncthreads(); if (F.lane == 0) { red[2 * F.wave] = sd; red[2 * F.wave + 1] = sr; } __syncthreads();
          float* slots = (float*)(F.ctl + 16384);
          if (F.tid == 0) { float a = 0.f, b = 0.f; for (int w = 0; w < 8; ++w) { a += red[2 * w]; b += red[2 * w + 1]; } slots[2 * blockIdx.x] = a; slots[2 * blockIdx.x + 1] = b; }
          GRID_BAR();
          float tsd = 0.f, tsr = 0.f;
          for (int w = 0; w < (int)F.G; ++w) { tsd += __hip_atomic_load(slots + 2 * w, __ATOMIC_RELAXED, __HIP_MEMORY_SCOPE_AGENT); tsr += __hip_atomic_load(slots + 2 * w + 1, __ATOMIC_RELAXED, __HIP_MEMORY_SCOPE_AGENT); }
          const float A = rintf(20.f + 4.f * log10f(fmaxf(tsd / fmaxf(tsr, 1e-30f), 1e-12f)));
          for (size_t i = (size_t)blockIdx.x * 512 + F.tid; i < (size_t)M * DM; i += (size_t)F.G * 512) F.out[i] = A;
          return; }
#endif
    }
    if (IN(5)) { REPS(5) { combine_pass(F, I, DUMMY, 2048, 0); GRID_BAR(); } combine_pass(F, I, YCAT, 4096, 2048); ln_colsum_reduce(F, (const float*)(ws + WS_LNC), (const float*)(ws + WS_LNC) + 64 * DM, (float*)(ws + WS_LNC12), (float*)(ws + WS_LNC12) + DM, DM, DM / 64); if (BOTH(5)) { GRID_BAR(); TSEL(5); } }
    if (IN(6)) {
        pg8::Gemm g{YCAT, (bf16*)(ws + WS_WPAB), M, DM, DM}; pg8::StaticOrder S; S.init(M, DM, F.G, (int)blockIdx.x);
        pg8::EpiMix E{(unsigned char*)MIX, DM, GATE, 2 * DM, MIX_ASCALE, 1.0f / (32.0f * GATE_WSCALE)};
        if (REPEAT_PHASE == 6) { pg8::gemm_phase<pg8::EpiMix, pg8::StaticOrder, true, true, false, 0, true>(F.lds, g, S, E); GRID_BAR(); }
        pg8::gemm_phase<pg8::EpiMix, pg8::StaticOrder, true, true, false, 0, true>(F.lds, g, S, E);
        if (BOTH(6)) { GRID_BAR(); TSEL(6); }
    }
    if (IN(8)) {
        pg8::Gemm g{MIX, (bf16*)(ws + WS_WO), M, DM, DM / 2}; pg8::StaticOrder S; S.init(M, DM, F.G, (int)blockIdx.x);
        pg8::EpiBf16S E{Y1, DM, 0, 0, 1.0f / (MIX_ASCALE * GATE_WSCALE)};
        if (REPEAT_PHASE == 8) { pg8::gemm_phase<pg8::EpiBf16S, pg8::StaticOrder, true, true, true>(F.lds, g, S, E); GRID_BAR(); }
        pg8::gemm_phase<pg8::EpiBf16S, pg8::StaticOrder, true, true, true>(F.lds, g, S, E);
        if (BOTH(8)) { GRID_BAR(); TSEL(8); }
    }
    if (IN(9)) { REPS(9) { ln_pass(F, I.x, nullptr, Y1, I.ln1_g, I.ln1_b, X1B); GRID_BAR(); } ln_pass(F, nullptr, XB, Y1, I.ln1_g, I.ln1_b, X1B); if (BOTH(9)) { GRID_BAR(); TSEL(9); } }
    if (IN(10)) {
        pg8::Gemm g{X1B, (bf16*)(ws + WS_WUP), M, 2 * DFF, DM}; pg8::StaticOrder S; S.init(M, 2 * DFF, F.G, (int)blockIdx.x);
        pg8::EpiBf16 E{UB, DFF, DFF, (size_t)M * DFF};
        if (REPEAT_PHASE == 10) { pg8::gemm_phase<pg8::EpiBf16, pg8::StaticOrder, true, true>(F.lds, g, S, E); GRID_BAR(); }
        if (REPEAT_PHASE == 101) { pg8::SameTileOrder S2; S2.init(M, 2 * DFF, F.G, (int)blockIdx.x);
            const unsigned long long c0 = clock64(), r0 = wall_clock64();
            pg8::gemm_phase<pg8::EpiBf16, pg8::SameTileOrder, true, true>(F.lds, g, S2, E);
            const unsigned long long c1 = clock64(), r1 = wall_clock64();
            if (blockIdx.x == 0) { const unsigned long long spin = (c1 - c0) * 5000ull / (r1 - r0);
                while (wall_clock64() - r1 < spin) __builtin_amdgcn_s_sleep(8); }
            GRID_BAR(); }
        if (REPEAT_PHASE == 104) { pg8::gemm_phase<pg8::EpiBf16, pg8::StaticOrder, true, true, false, 2>(F.lds, g, S, E); GRID_BAR(); }
        if (REPEAT_PHASE == 105) { pg8::gemm_phase<pg8::EpiBf16, pg8::StaticOrder, true, true, false, 4>(F.lds, g, S, E); GRID_BAR(); }
        if (REPEAT_PHASE == 103) { pg8::gemm_phase<pg8::EpiBf16, pg8::StaticOrder, true, true, false, 1>(F.lds, g, S, E); GRID_BAR(); }
        if (REPEAT_PHASE == 102) { int nv = 0; asm volatile("" : "+s"(nv)); pg8::EpiNull E0{UB, nv}; pg8::gemm_phase<pg8::EpiNull, pg8::StaticOrder, true, true>(F.lds, g, S, E0); GRID_BAR(); }
        if (REPEAT_PHASE == 100) { pg8::SameTileOrder S2; S2.init(M, 2 * DFF, F.G, (int)blockIdx.x); pg8::gemm_phase<pg8::EpiBf16, pg8::SameTileOrder, true, true>(F.lds, g, S2, E); GRID_BAR(); }
        pg8::gemm_phase<pg8::EpiBf16, pg8::StaticOrder, true, true>(F.lds, g, S, E);
        { int kk = PLE; asm volatile("" : "+s"(kk));
          pg8::Gemm g2{(bf16*)(ws + WS_PB), (bf16*)(ws + WS_WPLE), M, DM, kk}; pg8::PeOrder S2{(int)blockIdx.x};
          pg8::EpiBf16 E2{PEB, DM, 0, 0};
          pg8::gemm_phase<pg8::EpiBf16, pg8::PeOrder, true, true>(F.lds, g2, S2, E2); }
        if (BOTH(10)) { GRID_BAR(); TSEL(10); }
    }
    if (IN(11)) { REPS(11) { conv_pass(F, I, (bf16*)(ws + WS_WUP), M / 2); GRID_BAR(); } conv_pass(F, I, UB, M); if (BOTH(11)) { GRID_BAR(); TSEL(11); } }
    if (IN(12)) {
        pg8::Gemm g{UB, (bf16*)(ws + WS_WDN), M, DM, DFF}; pg8::StaticOrder S; S.init(M, DM, F.G, (int)blockIdx.x);
        pg8::EpiResStats E{X1B, X1B, DM, DN_ALPHA, (float*)(ws + WS_LNS)};
        pg8::gemm_phase<pg8::EpiResStats, pg8::StaticOrder, true, true>(F.lds, g, S, E);
        if (BOTH(12)) { GRID_BAR(); TSEL(12); }
    }
    if (IN(13)) { ln_stats_finalize(F, (const float*)(ws + WS_LNS), (float*)(ws + WS_LNST)); if (BOTH(13)) { GRID_BAR(); TSEL(13); } }
    if (IN(15)) {
        pg8::Gemm g{X1B, (bf16*)(ws + WS_WPG), M, DM, DM}; pg8::StaticOrder S; S.init(M, DM, F.G, (int)blockIdx.x);
        pg8::EpiFinalLn E{X1B, F.out, PEB, DM, (const float*)(ws + WS_LNST), I.ln2_g, I.ln2_b, (const float*)(ws + WS_LNC12), (const float*)(ws + WS_LNC12) + DM};
        pg8::gemm_phase<pg8::EpiFinalLn, pg8::StaticOrder, true, true>(F.lds, g, S, E);
    }
    if (SPIN_PHASE >= 0) { if (SPIN_PHASE == 15) t_sel = wall_clock64() - t_prev; if (blockIdx.x == 0) { const unsigned long long t1 = wall_clock64(); while (wall_clock64() - t1 < t_sel * SPIN_MULT) __builtin_amdgcn_s_sleep(8); } }
#undef IN
#undef BOTH
#undef GRID_BAR
}

extern "C" void kernel_launch(void* const* d_in, const int* in_sizes, int n_in, void* d_out, int out_size, void* d_ws, size_t ws_size, hipStream_t stream) {
    static int grid = 0;
    if (grid == 0) {
        if (n_in != 22 || in_sizes[0] != M * DM || out_size != M * DM || ws_size < WS_END) { fprintf(stderr, "kernel_launch: shape mismatch n_in %d in0 %d out %d ws %zu (need %zu)\n", n_in, n_in > 0 ? in_sizes[0] : -1, out_size, ws_size, (size_t)WS_END); grid = -1; return; }
        int dev = 0, cus = 0, per_cu = 0;
        if (hipGetDevice(&dev) != hipSuccess || hipDeviceGetAttribute(&cus, hipDeviceAttributeMultiprocessorCount, dev) != hipSuccess) { grid = -1; return; }
        if (hipFuncSetAttribute((const void*)mk_fwd, hipFuncAttributeMaxDynamicSharedMemorySize, LDS_BYTES) != hipSuccess) { fprintf(stderr, "kernel_launch: hipFuncSetAttribute failed\n"); grid = -1; return; }
        if (hipOccupancyMaxActiveBlocksPerMultiprocessor(&per_cu, (const void*)mk_fwd, NWAVES * 64, LDS_BYTES) != hipSuccess || per_cu < 1) fprintf(stderr, "kernel_launch: occupancy query says %d\n", per_cu);
        (void)hipGetLastError();
        grid = cus;
        if (grid != 256) { fprintf(stderr, "kernel_launch: built for 256 CUs, got %d; nothing launched\n", grid); grid = -1; return; }
    }
    if (grid < 0) return;
    (void)hipMemsetAsync((char*)d_ws + WS_CTL, 0, CTL_ZERO_BYTES, stream);
    Args a{};
    const float** ip = (const float**)&a.in;
    for (int i = 0; i < 22; ++i) ip[i] = (const float*)d_in[i];
    a.out = (float*)d_out; a.ws = (unsigned char*)d_ws; a.pad = 0;
    if (N_LAUNCHES == 1) { a.ph_lo = 0; a.ph_hi = N_PHASES; a.li = 0; hipLaunchKernelGGL(mk_fwd, dim3(grid), dim3(NWAVES * 64), LDS_BYTES, stream, a); }
    else for (int li = 0; li < N_PHASES; ++li) { a.ph_lo = li; a.ph_hi = li + 1; a.li = li; hipLaunchKernelGGL(mk_fwd, dim3(grid), dim3(NWAVES * 64), LDS_BYTES, stream, a); }
    const hipError_t le = hipPeekAtLastError();
    if (le != hipSuccess) fprintf(stderr, "kernel_launch: launch failed: %s\n", hipGetErrorName(le));
}
```
